# Optimizing an MI355X kernel written in HIP

```python
import math
import jax
import jax.numpy as jnp
from jax import lax
import numpy as np

D_MODEL = 1024
BATCH = 8
SEQ = 2048
DEPTH = 2
DEC_BATCH = 128
DEC_SEQ = 4
PAST_LEN = 16384
PAGE_SIZE = 128

EPS = 1e-6
CHUNK = 64
CONV_W = 4
N_BRANCH = 3
BRANCH_W = D_MODEL // 2

GLA_DK = 128
GLA_DV = 128
GLA_HEADS = BRANCH_W // GLA_DV
GLA_RANK = 16
GLA_GATE_TEMP = 16.0

SSD_HEADDIM = 64
SSD_HEADS = BRANCH_W // SSD_HEADDIM
SSD_GROUPS = 2
SSD_REP = SSD_HEADS // SSD_GROUPS
SSD_STATE = 128
SSD_INNER = SSD_HEADS * SSD_HEADDIM
SSD_CONV_CH = SSD_INNER + 2 * SSD_GROUPS * SSD_STATE

GDN_DK = 128
GDN_DV = 128
GDN_HEADS = BRANCH_W // GDN_DV
GDN_CONV_CH = GDN_HEADS * (2 * GDN_DK + GDN_DV)

FFN_HIDDEN = -(-(8 * D_MODEL) // (3 * 256)) * 256

IN_WIDTHS = (GLA_HEADS * GLA_DK, GLA_HEADS * GLA_DK, GLA_HEADS * GLA_DV, GLA_HEADS * GLA_DV, GLA_RANK,
             SSD_INNER, SSD_CONV_CH, SSD_HEADS,
             GDN_CONV_CH, GDN_HEADS, GDN_HEADS, GDN_HEADS * GDN_DV,
             N_BRANCH * D_MODEL)
N_IN = sum(IN_WIDTHS)
SPLIT_IDX = tuple(sum(IN_WIDTHS[:i + 1]) for i in range(len(IN_WIDTHS) - 1))

kernel_name = 'hybrid_gla_ssd_gdn_decoder_step'


def _rms_norm(x, g):
    xf = x.astype(jnp.float32)
    y = xf * lax.rsqrt(jnp.mean(xf * xf, axis=-1, keepdims=True) + EPS)
    return (y * g.astype(jnp.float32)).astype(x.dtype)


def _l2_norm(x):
    return x * lax.rsqrt(jnp.sum(x * x, axis=-1, keepdims=True) + EPS)


def _causal_conv(x, buf, w, b=None):
    L = x.shape[1]
    xp = jnp.concatenate([buf.astype(x.dtype), x], axis=1)
    y = xp[:, 0:L] * w[0]
    for j in range(1, CONV_W):
        y = y + xp[:, j:j + L] * w[j]
    if b is not None:
        y = y + b
    return y, xp[:, L:]


def _to_chunks(t, c):
    return jnp.moveaxis(t.reshape(t.shape[0], t.shape[1] // c, c, *t.shape[2:]), 1, 0)


def _from_chunks(t):
    t = jnp.moveaxis(t, 0, 1)
    return t.reshape(t.shape[0], t.shape[1] * t.shape[2], *t.shape[3:])


def _gla_chunked(q, k, v, log_a, S0):
    C = math.gcd(q.shape[1], CHUNK)
    mask = jnp.tril(jnp.ones((C, C), bool))

    def step(S, inp):
        qi, ki, vi, gi = inp
        b = jnp.cumsum(gi, axis=1)
        qd = qi * jnp.exp(b)
        kd = ki * jnp.exp(-b)
        A = jnp.where(mask, jnp.einsum('bthk,bshk->bhts', qd, kd), 0.0)
        o = jnp.einsum('bhts,bshv->bthv', A, vi) + jnp.einsum('bthk,bhkv->bthv', qd, S)
        bl = b[:, -1]
        S = S * jnp.exp(bl)[..., None] + jnp.einsum('bshk,bshv->bhkv', ki * jnp.exp(bl[:, None] - b), vi)
        return S, o

    S, o = lax.scan(step, S0.astype(jnp.float32), tuple(_to_chunks(t, C) for t in (q, k, v, log_a)))
    return _from_chunks(o), S


def _ssd_chunked(x, dt, A, Bm, Cm, S0):
    C = math.gcd(x.shape[1], CHUNK)
    mask = jnp.tril(jnp.ones((C, C), bool))[None, :, :, None, None]

    def step(S, inp):
        xi, dti, Bi, Ci = inp
        cum = jnp.cumsum(dti * A, axis=1)
        seg = cum[:, :, None] - cum[:, None, :]
        Lm = jnp.exp(jnp.where(mask, seg, -jnp.inf))
        CB = jnp.einsum('btgn,bsgn->btsg', Ci, Bi)
        M = CB[..., None] * Lm * dti[:, None]
        y = jnp.einsum('btsgr,bsgrp->btgrp', M, xi)
        y = y + jnp.einsum('btgn,bgrpn->btgrp', Ci, S) * jnp.exp(cum)[..., None]
        last = cum[:, -1]
        wts = jnp.exp(last[:, None] - cum) * dti
        S = S * jnp.exp(last)[..., None, None] + jnp.einsum('bsgn,bsgr,bsgrp->bgrpn', Bi, wts, xi)
        return S, y

    S, y = lax.scan(step, S0.astype(jnp.float32), tuple(_to_chunks(t, C) for t in (x, dt, Bm, Cm)))
    return _from_chunks(y), S


def _gdn_chunked(q, k, v, g, beta, S0):
    C = math.gcd(q.shape[1], CHUNK)
    V = v.shape[-1]
    mask = jnp.tril(jnp.ones((C, C), bool))
    strict = jnp.tril(jnp.ones((C, C), bool), k=-1)
    eye = jnp.eye(C, dtype=jnp.float32)

    def step(S, inp):
        qi, ki, vi, gi, bi = inp
        cum = jnp.cumsum(gi, axis=1)
        cum_h = jnp.swapaxes(cum, 1, 2)
        seg = cum_h[..., :, None] - cum_h[..., None, :]
        Lm = jnp.exp(jnp.where(mask, seg, -jnp.inf))
        Akk = jnp.where(strict, jnp.einsum('bthk,bshk,bsh->bhts', ki, ki, bi) * Lm, 0.0)
        Akk = jnp.einsum('bhts,bth->bhts', Akk, bi)
        IA = Akk + eye
        vb = jnp.einsum('bthv,bth->bhtv', vi, bi)
        kbd = jnp.einsum('bthk,bth->bhtk', ki, bi * jnp.exp(cum))
        sol = lax.linalg.triangular_solve(IA, jnp.concatenate([vb, kbd], axis=-1),
                                          left_side=True, lower=True, unit_diagonal=True)
        U, W = sol[..., :V], sol[..., V:]
        vnew = U - jnp.einsum('bhtk,bhkv->bhtv', W, S)
        Aqk = jnp.where(mask, jnp.einsum('bthk,bshk->bhts', qi, ki) * Lm, 0.0)
        o = (jnp.einsum('bthk,bhkv->bthv', qi * jnp.exp(cum)[..., None], S)
             + jnp.einsum('bhts,bhsv->bthv', Aqk, vnew))
        last = cum_h[..., -1]
        S = (S * jnp.exp(last)[..., None, None]
             + jnp.einsum('bshk,bhs,bhsv->bhkv', ki, jnp.exp(last[..., None] - cum_h), vnew))
        return S, o

    S, o = lax.scan(step, S0.astype(jnp.float32), tuple(_to_chunks(t, C) for t in (q, k, v, g, beta)))
    return _from_chunks(o), S


def _token_mixers(h, p, l, st):
    s_gla, s_ssd, cv_ssd, s_gdn, cv_gdn = st
    Bn, L, _ = h.shape
    u = jnp.einsum('bld,dn->bln', h, p['w_in'][l]).astype(jnp.float32)
    (gq, gk, gv, gr, glr, sz, sxbc, sdt, dqkv, da, db, dg, mg) = jnp.split(u, SPLIT_IDX, axis=-1)

    q = gq.reshape(Bn, L, GLA_HEADS, GLA_DK) * (GLA_DK ** -0.5)
    k = gk.reshape(Bn, L, GLA_HEADS, GLA_DK)
    v = gv.reshape(Bn, L, GLA_HEADS, GLA_DV)
    logit = jnp.einsum('blr,rn->bln', glr, p['w_gla_gate'][l]) + p['b_gla_gate'][l]
    log_a = (jax.nn.log_sigmoid(logit.astype(jnp.float32)) / GLA_GATE_TEMP).reshape(Bn, L, GLA_HEADS, GLA_DK)
    o, s_gla_new = _gla_chunked(q, k, v, log_a, s_gla)
    y_gla = (_rms_norm(o, p['g_gla_norm'][l]) * jax.nn.silu(gr.reshape(Bn, L, GLA_HEADS, GLA_DV))).reshape(Bn, L, BRANCH_W)

    xbc, cv_ssd_new = _causal_conv(sxbc, cv_ssd, p['w_ssd_conv'][l], p['b_ssd_conv'][l])
    xbc = jax.nn.silu(xbc)
    sx, sB, sC = jnp.split(xbc, (SSD_INNER, SSD_INNER + SSD_GROUPS * SSD_STATE), axis=-1)
    xs = sx.reshape(Bn, L, SSD_GROUPS, SSD_REP, SSD_HEADDIM)
    Bm = sB.reshape(Bn, L, SSD_GROUPS, SSD_STATE)
    Cm = sC.reshape(Bn, L, SSD_GROUPS, SSD_STATE)
    dt = jax.nn.softplus(sdt + p['ssd_dt_bias'][l]).reshape(Bn, L, SSD_GROUPS, SSD_REP)
    A = -jnp.exp(p['ssd_a_log'][l].astype(jnp.float32)).reshape(SSD_GROUPS, SSD_REP)
    S0 = s_ssd.reshape(Bn, SSD_GROUPS, SSD_REP, SSD_HEADDIM, SSD_STATE)
    ys, S_new = _ssd_chunked(xs, dt, A, Bm, Cm, S0)
    ys = ys + xs * p['ssd_d'][l].reshape(SSD_GROUPS, SSD_REP)[..., None]
    ys = ys * jax.nn.silu(sz.reshape(Bn, L, SSD_GROUPS, SSD_REP, SSD_HEADDIM))
    ys = _rms_norm(ys.reshape(Bn, L, SSD_GROUPS, SSD_REP * SSD_HEADDIM),
                   p['g_ssd_norm'][l].reshape(SSD_GROUPS, SSD_REP * SSD_HEADDIM))
    y_ssd = ys.reshape(Bn, L, BRANCH_W)
    s_ssd_new = S_new.reshape(Bn, SSD_HEADS, SSD_HEADDIM, SSD_STATE)

    qkv, cv_gdn_new = _causal_conv(dqkv, cv_gdn, p['w_gdn_conv'][l])
    qkv = jax.nn.silu(qkv)
    dq, dk, dv = jnp.split(qkv, (GDN_HEADS * GDN_DK, 2 * GDN_HEADS * GDN_DK), axis=-1)
    qd = _l2_norm(dq.reshape(Bn, L, GDN_HEADS, GDN_DK)) * (GDN_DK ** -0.5)
    kd = _l2_norm(dk.reshape(Bn, L, GDN_HEADS, GDN_DK))
    vd = dv.reshape(Bn, L, GDN_HEADS, GDN_DV)
    g = -jnp.exp(p['gdn_a_log'][l].astype(jnp.float32)) * jax.nn.softplus(da + p['gdn_dt_bias'][l])
    beta = jax.nn.sigmoid(db)
    od, s_gdn_new = _gdn_chunked(qd, kd, vd, g, beta, s_gdn)
    y_gdn = (_rms_norm(od, p['g_gdn_norm'][l]) * jax.nn.silu(dg.reshape(Bn, L, GDN_HEADS, GDN_DV))).reshape(Bn, L, BRANCH_W)

    ys_all = jnp.stack([y_gla, y_ssd, y_gdn]).astype(h.dtype)
    yb = jnp.einsum('nblw,nwd->nbld', ys_all, p['w_branch'][l])
    gates = jax.nn.sigmoid(mg).reshape(Bn, L, N_BRANCH, D_MODEL).astype(h.dtype)
    merged = jnp.einsum('blnd,nbld->bld', gates, yb)
    out = jnp.einsum('bld,de->ble', merged, p['w_out'][l])
    return out, (s_gla_new, s_ssd_new, cv_ssd_new, s_gdn_new, cv_gdn_new)


def _layer(x, c, p, l, st):
    mod = jnp.einsum('bd,de->be', jax.nn.silu(c), p['w_ada'][l]) + p['b_ada'][l]
    sh_m, sc_m, gt_m, sh_f, sc_f, gt_f = jnp.split(mod[:, None, :], 6, axis=-1)
    h = _rms_norm(x, p['g_pre_mix'][l]) * (1.0 + sc_m) + sh_m
    mix, new_st = _token_mixers(h, p, l, st)
    x = x + gt_m * _rms_norm(mix, p['g_post_mix'][l])
    h = _rms_norm(x, p['g_pre_ffn'][l]) * (1.0 + sc_f) + sh_f
    a, b = jnp.split(jnp.einsum('bld,df->blf', h, p['w_ffn_in'][l]), 2, axis=-1)
    f = jnp.einsum('blf,fd->bld', jax.nn.silu(a) * b, p['w_ffn_out'][l])
    x = x + gt_f * _rms_norm(f, p['g_post_ffn'][l])
    return x, new_st


def _trunk(x, c, p, states):
    outs = ([], [], [], [], [])
    for l in range(DEPTH):
        x, ns = _layer(x, c, p, l, tuple(s[l] for s in states))
        for lst, s in zip(outs, ns):
            lst.append(s)
    return x, tuple(jnp.stack(lst) for lst in outs)


def _zero_states(n):
    f = jnp.float32
    return (jnp.zeros((DEPTH, n, GLA_HEADS, GLA_DK, GLA_DV), f),
            jnp.zeros((DEPTH, n, SSD_HEADS, SSD_HEADDIM, SSD_STATE), f),
            jnp.zeros((DEPTH, n, CONV_W - 1, SSD_CONV_CH), f),
            jnp.zeros((DEPTH, n, GDN_HEADS, GDN_DK, GDN_DV), f),
            jnp.zeros((DEPTH, n, CONV_W - 1, GDN_CONV_CH), f))


def setup_inputs(seed: int = 0) -> dict:
    key = jax.random.key(seed)
    kit = iter(jax.random.split(key, 64))
    f32 = jnp.float32
    D = D_MODEL

    def nrm(shape, scale):
        return jax.random.normal(next(kit), shape, f32) * scale

    def gain(shape):
        return 1.0 + nrm(shape, 0.05)

    def a_log(shape):
        return jnp.log(jax.random.uniform(next(kit), shape, f32, 1.0, 16.0))

    def dt_bias(shape):
        u = jax.random.uniform(next(kit), shape, f32)
        dt = jnp.exp(u * (math.log(0.1) - math.log(0.001)) + math.log(0.001))
        return dt + jnp.log(-jnp.expm1(-dt))

    return {
        'x_prompt': nrm((BATCH, SEQ, D), 1.0),
        'x_sample': nrm((DEC_BATCH, DEC_SEQ, D), 1.0),
        'state_gla': nrm((DEPTH, DEC_BATCH, GLA_HEADS, GLA_DK, GLA_DV), 0.5),
        'state_ssd': nrm((DEPTH, DEC_BATCH, SSD_HEADS, SSD_HEADDIM, SSD_STATE), 0.5),
        'cache_ssd_conv': nrm((DEPTH, DEC_BATCH, CONV_W - 1, SSD_CONV_CH), 1.0),
        'state_gdn': nrm((DEPTH, DEC_BATCH, GDN_HEADS, GDN_DK, GDN_DV), 0.5),
        'cache_gdn_conv': nrm((DEPTH, DEC_BATCH, CONV_W - 1, GDN_CONV_CH), 1.0),
        'c_prompt': nrm((BATCH, D), 1.0),
        'c_sample': nrm((DEC_BATCH, D), 1.0),
        'w_ada': nrm((DEPTH, D, 6 * D), 0.5 * D ** -0.5),
        'b_ada': nrm((DEPTH, 6 * D), 0.02),
        'g_pre_mix': gain((DEPTH, D)),
        'g_post_mix': gain((DEPTH, D)),
        'g_pre_ffn': gain((DEPTH, D)),
        'g_post_ffn': gain((DEPTH, D)),
        'w_in': nrm((DEPTH, D, N_IN), D ** -0.5),
        'w_gla_gate': nrm((DEPTH, GLA_RANK, GLA_HEADS * GLA_DK), GLA_RANK ** -0.5),
        'b_gla_gate': nrm((DEPTH, GLA_HEADS * GLA_DK), 0.1),
        'g_gla_norm': gain((DEPTH, GLA_DV)),
        'w_ssd_conv': nrm((DEPTH, CONV_W, SSD_CONV_CH), CONV_W ** -0.5),
        'b_ssd_conv': nrm((DEPTH, SSD_CONV_CH), 0.05),
        'ssd_dt_bias': dt_bias((DEPTH, SSD_HEADS)),
        'ssd_a_log': a_log((DEPTH, SSD_HEADS)),
        'ssd_d': gain((DEPTH, SSD_HEADS)),
        'g_ssd_norm': gain((DEPTH, SSD_INNER)),
        'w_gdn_conv': nrm((DEPTH, CONV_W, GDN_CONV_CH), CONV_W ** -0.5),
        'gdn_dt_bias': dt_bias((DEPTH, GDN_HEADS)),
        'gdn_a_log': a_log((DEPTH, GDN_HEADS)),
        'g_gdn_norm': gain((DEPTH, GDN_DV)),
        'w_branch': nrm((DEPTH, N_BRANCH, BRANCH_W, D), BRANCH_W ** -0.5),
        'w_out': nrm((DEPTH, D, D), D ** -0.5),
        'w_ffn_in': nrm((DEPTH, D, 2 * FFN_HIDDEN), D ** -0.5),
        'w_ffn_out': nrm((DEPTH, FFN_HIDDEN, D), FFN_HIDDEN ** -0.5),
    }


def reference(x_prompt, x_sample, state_gla, state_ssd, cache_ssd_conv, state_gdn, cache_gdn_conv,
              c_prompt, c_sample, w_ada, b_ada, g_pre_mix, g_post_mix, g_pre_ffn, g_post_ffn,
              w_in, w_gla_gate, b_gla_gate, g_gla_norm, w_ssd_conv, b_ssd_conv, ssd_dt_bias,
              ssd_a_log, ssd_d, g_ssd_norm, w_gdn_conv, gdn_dt_bias, gdn_a_log, g_gdn_norm,
              w_branch, w_out, w_ffn_in, w_ffn_out):
    p = dict(w_ada=w_ada, b_ada=b_ada, g_pre_mix=g_pre_mix, g_post_mix=g_post_mix,
             g_pre_ffn=g_pre_ffn, g_post_ffn=g_post_ffn, w_in=w_in, w_gla_gate=w_gla_gate,
             b_gla_gate=b_gla_gate, g_gla_norm=g_gla_norm, w_ssd_conv=w_ssd_conv,
             b_ssd_conv=b_ssd_conv, ssd_dt_bias=ssd_dt_bias, ssd_a_log=ssd_a_log, ssd_d=ssd_d,
             g_ssd_norm=g_ssd_norm, w_gdn_conv=w_gdn_conv, gdn_dt_bias=gdn_dt_bias,
             gdn_a_log=gdn_a_log, g_gdn_norm=g_gdn_norm, w_branch=w_branch, w_out=w_out,
             w_ffn_in=w_ffn_in, w_ffn_out=w_ffn_out)
    y_prompt, (pg, ps, pcs, pd, pcd) = _trunk(x_prompt, c_prompt, p, _zero_states(x_prompt.shape[0]))
    y_sample, (sg, ss, scs, sd, scd) = _trunk(
        x_sample, c_sample, p, (state_gla, state_ssd, cache_ssd_conv, state_gdn, cache_gdn_conv))
    return (y_prompt, y_sample, pg, ps, pcs, pd, pcd, sg, ss, scs, sd, scd)
```

```cpp
#include <hip/hip_runtime.h>
#include <hip/hip_cooperative_groups.h>
#include <cstdio>
#include <cstdint>
namespace cg = cooperative_groups;
#ifndef MK_MULTI
#define MK_MULTI 0
#endif
#ifndef PROBE_GEMM
#define PROBE_GEMM 0
#endif
#ifndef PROBE_PRE
#define PROBE_PRE 0
#endif
#ifndef PROBE_SCAN
#define PROBE_SCAN 0
#endif
#ifndef PROBE_SAMPLE
#define PROBE_SAMPLE 0
#endif
#ifndef PROBE_ROWS
#define PROBE_ROWS 0
#endif
#ifndef PROBE_PRO
#define PROBE_PRO 0
#endif
namespace pg8 {
#define PG8_LAS __attribute__((address_space(3)))
typedef unsigned short bf16_t;
typedef short bf16x8 __attribute__((ext_vector_type(8)));
typedef float f32x4 __attribute__((ext_vector_type(4)));
typedef unsigned u32x4 __attribute__((ext_vector_type(4)));
typedef int i32x8 __attribute__((ext_vector_type(8)));
typedef int i32x4 __attribute__((ext_vector_type(4)));
constexpr int BM = 256, BK = 64, HALF = 128, HTB = HALF * BK * 2  , STAGE_BYTES = 8 * HTB, NXCD = 8, WGM = 8;

__host__ __device__ __forceinline__ int lds_byte(int r, int c) { const int st = (r >> 4) * 2 + (c >> 5), rr = r & 15, cc = c & 31, ob = rr * 64 + cc * 2; return st * 1024 + (ob ^ (((ob >> 9) & 1) << 5)); }
__host__ __device__ __forceinline__ void stage_rc(int b, int& R, int& C) { const int st = b / 1024, sb = b % 1024, swz = sb ^ (((sb >> 9) & 1) << 5); R = (st >> 1) * 16 + swz / 64; C = (st & 1) * 32 + (swz % 64) / 2; }
__host__ __device__ __forceinline__ int perm32(int rho) { const int n = rho >> 4, i = rho & 15; return 8 * (i >> 2) + 4 * n + (i & 3); }

struct Unit { int pm, pn, kz; };
struct Gemm { const bf16_t* A; const bf16_t* Bt; int M, N, K; long a_z, b_z; int ld = 0; };

struct StaticOrder {
    int nM, nN, nwg, G, c;
    __host__ __device__ void init(int M, int N, int G_, int c_) { nM = M / BM; nN = N / BM; nwg = nM * nN; G = G_; c = c_; }
    __host__ __device__ bool next(int i, Unit& u) const {
        const long L = (long)i * G + c; if (L >= nwg) return false;
        int wgid = (int)L; { const int q = nwg / NXCD, r = nwg % NXCD, xcd = wgid % NXCD, off = wgid / NXCD; wgid = (xcd < r ? xcd * (q + 1) : r * (q + 1) + (xcd - r) * q) + off; }
        const int nig = WGM * nN, gid = wgid / nig, fm = gid * WGM, gsz = (nM - fm) < WGM ? (nM - fm) : WGM;
        u.pm = fm + ((wgid % nig) % gsz); u.pn = (wgid % nig) / gsz; u.kz = 0; return true;
    }
    __device__ __forceinline__ void a_ready(const Unit&) const {}
    __device__ __forceinline__ void done(const Unit&) const {}
};


__device__ __forceinline__ unsigned cvt_pk_bf16(float lo, float hi) { unsigned r; asm volatile("v_cvt_pk_bf16_f32 %0, %1, %2" : "=v"(r) : "v"(lo), "v"(hi)); return r; }
__device__ __forceinline__ float sigm(float x) { return __builtin_amdgcn_rcpf(1.f + __builtin_amdgcn_exp2f(-1.4426950408889634f * x)); }
__device__ __forceinline__ float bf_lo(unsigned u) { return __uint_as_float(u << 16); }
__device__ __forceinline__ float bf_hi(unsigned u) { return __uint_as_float(u & 0xffff0000u); }
template <int ACT  , bool PRE = false  > struct EpiStore {
    static constexpr bool PERM = true, CHAIN = false;
    bf16_t* O; int ldc; float pre = 1.f;
    __device__ __forceinline__ void operator()(const f32x4 (&acc)[2][2][4][2], const Unit& u, int wr, int wc, int fr, int fq) const {
        int row0 = u.pm * BM + wr * 64 + fr; asm volatile("" : "+v"(row0)); const int col0 = u.pn * BM + wc * 32 + 8 * fq;
#pragma unroll
        for (int ai = 0; ai < 2; ++ai)
#pragma unroll
            for (int m = 0; m < 4; ++m) { bf16_t* rowp = O + (size_t)(row0 + ai * HALF + m * 16) * ldc + col0;
#pragma unroll
                for (int bj = 0; bj < 2; ++bj) { f32x4 v0 = acc[ai][bj][m][0], v1 = acc[ai][bj][m][1]; if (PRE) { v0 = v0 * pre; v1 = v1 * pre; }
                    if (ACT == 1) {
#pragma unroll
                        for (int j = 0; j < 4; ++j) { v0[j] = fmaxf(sigm(v0[j]), 1e-30f); v1[j] = fmaxf(sigm(v1[j]), 1e-30f); } }
                    u32x4 w; w.x = cvt_pk_bf16(v0[0], v0[1]); w.y = cvt_pk_bf16(v0[2], v0[3]); w.z = cvt_pk_bf16(v1[0], v1[1]); w.w = cvt_pk_bf16(v1[2], v1[3]);
                    *(u32x4*)(rowp + bj * HALF) = w; } }
    }
};
struct EpiSwiGLU {
    static constexpr bool PERM = true, CHAIN = false;
    unsigned char* O8; bf16_t* Os; int ldc; float s8;
    __device__ __forceinline__ void operator()(const f32x4 (&acc)[2][2][4][2], const Unit& u, int wr, int wc, int fr, int fq) const {
        int row0 = u.pm * BM + wr * 64 + fr; asm volatile("" : "+v"(row0)); const int col0 = u.pn * HALF + wc * 32 + 8 * fq; const bool samp = u.pm >= 64;
#pragma unroll
        for (int ai = 0; ai < 2; ++ai)
#pragma unroll
            for (int m = 0; m < 4; ++m) { const unsigned r = (unsigned)(row0 + ai * HALF + m * 16);
                f32x4 v0, v1;
#pragma unroll
                for (int j = 0; j < 4; ++j) { const float a0 = acc[ai][0][m][0][j], a1 = acc[ai][0][m][1][j]; v0[j] = a0 * sigm(a0) * acc[ai][1][m][0][j]; v1[j] = a1 * sigm(a1) * acc[ai][1][m][1][j]; }
                if (samp) { u32x4 w; w.x = cvt_pk_bf16(v0[0], v0[1]); w.y = cvt_pk_bf16(v0[2], v0[3]); w.z = cvt_pk_bf16(v1[0], v1[1]); w.w = cvt_pk_bf16(v1[2], v1[3]); *(u32x4*)((char*)Os + ((r - 16384u) * (unsigned)ldc + (unsigned)col0) * 2u) = w; }
                else {
#pragma unroll
                    for (int j = 0; j < 4; ++j) { v0[j] = __builtin_amdgcn_fmed3f(v0[j] * s8, -448.f, 448.f); v1[j] = __builtin_amdgcn_fmed3f(v1[j] * s8, -448.f, 448.f); }
                    unsigned w0 = 0u, w1 = 0u; w0 = __builtin_amdgcn_cvt_pk_fp8_f32(v0[0], v0[1], w0, false); w0 = __builtin_amdgcn_cvt_pk_fp8_f32(v0[2], v0[3], w0, true);
                    w1 = __builtin_amdgcn_cvt_pk_fp8_f32(v1[0], v1[1], w1, false); w1 = __builtin_amdgcn_cvt_pk_fp8_f32(v1[2], v1[3], w1, true);
                    typedef unsigned u32x2 __attribute__((ext_vector_type(2))); u32x2 q; q.x = w0; q.y = w1; *(u32x2*)((char*)O8 + (r * (unsigned)ldc + (unsigned)col0)) = q; } }
    }
};
struct EpiGates {
    static constexpr bool PERM = true, CHAIN = false;
    bf16_t* O; int ldc; float pre;
    __device__ __forceinline__ void operator()(const f32x4 (&acc)[2][2][4][2], const Unit& u, int wr, int wc, int fr, int fq) const {
        int row0 = u.pm * BM + wr * 64 + fr; asm volatile("" : "+v"(row0));
        if (u.pn < 8) { const int ch0 = u.pn * HALF + wc * 32 + 8 * fq;
#pragma unroll
            for (int ai = 0; ai < 2; ++ai)
#pragma unroll
                for (int m = 0; m < 4; ++m) { bf16_t* rowp = O + (size_t)(row0 + ai * HALF + m * 16) * ldc + ch0; float q[8], d[8];
#pragma unroll
                    for (int j = 0; j < 4; ++j) {
                        const float pk = -1.4426950408889634f * pre; const float da0 = 1.f + __builtin_amdgcn_exp2f(pk * acc[ai][0][m][0][j]), da1 = 1.f + __builtin_amdgcn_exp2f(pk * acc[ai][0][m][1][j]);
                        const float db0 = 1.f + __builtin_amdgcn_exp2f(pk * acc[ai][1][m][0][j]), db1 = 1.f + __builtin_amdgcn_exp2f(pk * acc[ai][1][m][1][j]);
                        d[j] = fmaxf(__builtin_amdgcn_rcpf(db0), 1e-30f); d[4 + j] = fmaxf(__builtin_amdgcn_rcpf(db1), 1e-30f);
                        q[j] = fmaxf(__builtin_amdgcn_rcpf(da0), 1e-30f) * fminf(db0, 1e30f); q[4 + j] = fmaxf(__builtin_amdgcn_rcpf(da1), 1e-30f) * fminf(db1, 1e30f); }
                    u32x4 w; w.x = cvt_pk_bf16(q[0], q[1]); w.y = cvt_pk_bf16(q[2], q[3]); w.z = cvt_pk_bf16(q[4], q[5]); w.w = cvt_pk_bf16(q[6], q[7]); *(u32x4*)rowp = w;
                    w.x = cvt_pk_bf16(d[0], d[1]); w.y = cvt_pk_bf16(d[2], d[3]); w.z = cvt_pk_bf16(d[4], d[5]); w.w = cvt_pk_bf16(d[6], d[7]); *(u32x4*)(rowp + 2048) = w; asm volatile("" ::: "memory"); } }
        else { const int col0 = 1024 + (u.pn - 8) * BM + wc * 32 + 8 * fq;
#pragma unroll
            for (int ai = 0; ai < 2; ++ai)
#pragma unroll
                for (int m = 0; m < 4; ++m) { bf16_t* rowp = O + (size_t)(row0 + ai * HALF + m * 16) * ldc + col0;
#pragma unroll
                    for (int bj = 0; bj < 2; ++bj) { f32x4 v0 = acc[ai][bj][m][0], v1 = acc[ai][bj][m][1];
#pragma unroll
                        for (int j = 0; j < 4; ++j) { v0[j] = fmaxf(sigm(pre * v0[j]), 1e-30f); v1[j] = fmaxf(sigm(pre * v1[j]), 1e-30f); }
                        u32x4 w; w.x = cvt_pk_bf16(v0[0], v0[1]); w.y = cvt_pk_bf16(v0[2], v0[3]); w.z = cvt_pk_bf16(v1[0], v1[1]); w.w = cvt_pk_bf16(v1[2], v1[3]);
                        *(u32x4*)(rowp + bj * HALF) = w; } asm volatile("" ::: "memory"); } }
    }
};
struct EpiChain {
    static constexpr bool PERM = true, CHAIN = true;
    const bf16_t* G; int ldg; bf16_t* O; int ldc; const float* rsd; long a1, a2, b1, b2;
    __device__ __forceinline__ long a_off(int kz) const { return kz == 0 ? 0 : (kz == 1 ? a1 : (kz == 2 ? a2 : a2 + 256)); }
    __device__ __forceinline__ long b_off(int kz) const { return kz == 0 ? 0 : (kz == 1 ? b1 : (kz == 2 ? b2 : b2 + 256)); }
    __device__ __forceinline__ int n_ktiles(int kz) const { return kz < 2 ? 8 : 4; }
    __device__ __forceinline__ bool restart(int kz) const { return kz == 3; }
    __device__ __forceinline__ void operator()(f32x4 (&acc)[2][2][4][2], const Unit& u, int wr, int wc, int fr, int fq) const {
        int row0 = u.pm * BM + wr * 64 + fr; const int col0 = u.pn * BM + wc * 32 + 8 * fq; const int kz = u.kz, npass = kz == 1 ? 2 : 1;
#pragma unroll 1
        for (int p = 0; p < npass; ++p) {
            const int goff = kz == 0 ? 0 : ((kz == 1 && p == 0) ? 2048 : 1024), code = kz == 0 ? 0 : (kz == 1 ? p : kz);
            const bool tile = kz != 2, inv = kz == 1 && p == 1, store = kz == 3;
            u32x4 ga[2][4][2]; float rs[2][4]; asm volatile("" : "+v"(row0));
#pragma unroll
            for (int ai = 0; ai < 2; ++ai)
#pragma unroll
                for (int m = 0; m < 4; ++m) { const unsigned r = (unsigned)(row0 + ai * HALF + m * 16); const char* gp = (const char*)G + (r * (unsigned)ldg + (unsigned)(goff + col0)) * 2u;
                    ga[ai][m][0] = (u32x4){0x3f803f80u, 0x3f803f80u, 0x3f803f80u, 0x3f803f80u}; ga[ai][m][1] = ga[ai][m][0];
                    if (tile) { ga[ai][m][0] = *(const u32x4*)gp; ga[ai][m][1] = *(const u32x4*)(gp + HALF * 2); }
                    const float r0 = *(const float*)((const char*)rsd + r * 8u), r1 = *(const float*)((const char*)rsd + r * 8u + 4u);
                    rs[ai][m] = code == 0 ? 1.f : (code == 1 ? r0 : (code == 2 ? r0 * __builtin_amdgcn_rcpf(r1) : r1)); }
#pragma unroll
            for (int ai = 0; ai < 2; ++ai)
#pragma unroll
                for (int m = 0; m < 4; ++m) { bf16_t* rowp = (bf16_t*)((char*)O + ((unsigned)(row0 + ai * HALF + m * 16) * (unsigned)ldc + (unsigned)col0) * 2u);
#pragma unroll
                    for (int bj = 0; bj < 2; ++bj) { float fa[8];
#pragma unroll
                        for (int q = 0; q < 4; ++q) { fa[2 * q] = bf_lo(ga[ai][m][bj][q]) * rs[ai][m]; fa[2 * q + 1] = bf_hi(ga[ai][m][bj][q]) * rs[ai][m]; }
                        if (inv) {
#pragma unroll
                            for (int q = 0; q < 8; ++q) fa[q] = __builtin_amdgcn_rcpf(fa[q]); }
                        f32x4 v0 = acc[ai][bj][m][0], v1 = acc[ai][bj][m][1];
#pragma unroll
                        for (int j = 0; j < 4; ++j) { v0[j] *= fa[j]; v1[j] *= fa[4 + j]; }
                        acc[ai][bj][m][0] = v0; acc[ai][bj][m][1] = v1;
                        if (store) { u32x4 w; w.x = cvt_pk_bf16(v0[0], v0[1]); w.y = cvt_pk_bf16(v0[2], v0[3]); w.z = cvt_pk_bf16(v1[0], v1[1]); w.w = cvt_pk_bf16(v1[2], v1[3]); *(u32x4*)(rowp + bj * HALF) = w; } } }
            asm volatile("" ::: "memory"); }
    }
};
struct Chain4Order {
    StaticOrder so;
    __device__ void init(int M, int N, int G_, int c_) { so.init(M, N, G_, c_); }
    __device__ bool next(int i, Unit& u) const { if (!so.next(i >> 2, u)) return false; u.kz = i & 3; return true; }
    __device__ __forceinline__ void a_ready(const Unit&) const {}
    __device__ __forceinline__ void done(const Unit&) const {}
};
template <class Epi> __device__ __forceinline__ size_t unit_aoff(const Epi& E, const Gemm& g, const Unit& u) { if constexpr (Epi::CHAIN) return (size_t)E.a_off(u.kz) * 2; else return (size_t)u.kz * (size_t)g.a_z * 2; }
template <class Epi> __device__ __forceinline__ size_t unit_boff(const Epi& E, const Gemm& g, const Unit& u) { if constexpr (Epi::CHAIN) return (size_t)E.b_off(u.kz) * 2; else return (size_t)u.kz * (size_t)g.b_z * 2; }
template <class Epi> __device__ __forceinline__ int unit_ktiles(const Epi& E, int nt, const Unit& u) { if constexpr (Epi::CHAIN) return E.n_ktiles(u.kz); else return nt; }
template <class Epi> __device__ __forceinline__ bool unit_restart(const Epi& E, const Unit& u) { if constexpr (Epi::CHAIN) return E.restart(u.kz); else return true; }
template <class Epi, class Sched, bool ALIGN_EPI = false, bool SP2 = false, bool WARM = false, bool FP8 = false>
__device__ __forceinline__ void gemm_phase(PG8_LAS unsigned char* lds, const Gemm g, const Sched& S, const Epi& E, const int wave_id) {
    int tid_; asm volatile("v_mbcnt_lo_u32_b32 %0, -1, 0\n\tv_mbcnt_hi_u32_b32 %0, -1, %0" : "=v"(tid_)); tid_ += 64 * wave_id;
    const int tid = tid_, wid = __builtin_amdgcn_readfirstlane(tid >> 6), lane = tid & 63, wr = wid >> 2, wc = wid & 3, fr = lane & 15, fq = lane >> 4;
    const int K = g.K, nt = K / BK, ld = g.ld ? g.ld : K;
    unsigned voffA[2], voffB[2];
#pragma unroll
    for (int i = 0; i < 2; ++i) { int R, C; stage_rc(tid * 16 + i * 8192, R, C); const int Rb = Epi::PERM ? ((R & ~31) + perm32(R & 31)) : R;
        voffA[i] = (unsigned)(R * ld + C) * 2u; voffB[i] = (unsigned)(Rb * ld + C) * 2u; }
    const size_t kstep = (size_t)(BK * 2);
    const size_t hstep = (size_t)HALF * ld * 2;
    const size_t tstep = 2 * hstep;
    const unsigned ldsw = (unsigned)wid * 1024u;
    const int aoff = lds_byte(wr * 64 + fr, fq * 8), boff = lds_byte(wc * 32 + fr, fq * 8);
#define PG8_SA(b, h) (((b) * 2 + (h)) * HTB)
#define PG8_SB(b, h) ((4 + (b) * 2 + (h)) * HTB)
#define PG8_STAGE(bufoff, gbase, voff) do { _Pragma("unroll") for (int _i = 0; _i < 2; ++_i) \
        __builtin_amdgcn_global_load_lds((const unsigned*)((const char*)(gbase) + (voff)[_i]), (PG8_LAS unsigned*)(lds + (bufoff) + ldsw + _i * 8192), 16, 0, 0); } while (0)
#define PG8_LDA(dst, b, h) do { _Pragma("unroll") for (int m = 0; m < 4; ++m) _Pragma("unroll") for (int k = 0; k < 2; ++k) dst[m][k] = *(const PG8_LAS bf16x8*)(lds + PG8_SA(b, h) + aoff + m * 2048 + k * 1024); } while (0)
#define PG8_LDB(dst, b, h) do { _Pragma("unroll") for (int n = 0; n < 2; ++n) _Pragma("unroll") for (int k = 0; k < 2; ++k) dst[n][k] = *(const PG8_LAS bf16x8*)(lds + PG8_SB(b, h) + boff + n * 2048 + k * 1024); } while (0)
#define PG8_MMA(ai, bj, At, Bt) do { __builtin_amdgcn_s_setprio(1); _Pragma("unroll") for (int m = 0; m < 4; ++m) _Pragma("unroll") for (int n = 0; n < 2; ++n) { \
        if constexpr (FP8) { const i32x8 a8_ = __builtin_shufflevector(__builtin_bit_cast(i32x4, At[m][0]), __builtin_bit_cast(i32x4, At[m][1]), 0, 1, 2, 3, 4, 5, 6, 7), \
                                            b8_ = __builtin_shufflevector(__builtin_bit_cast(i32x4, Bt[n][0]), __builtin_bit_cast(i32x4, Bt[n][1]), 0, 1, 2, 3, 4, 5, 6, 7); \
            asm volatile("v_mfma_f32_16x16x128_f8f6f4 %0, %1, %2, %0" : "+v"(acc[ai][bj][m][n]) : "v"(b8_), "v"(a8_)); }   \
        else { _Pragma("unroll") for (int k = 0; k < 2; ++k) acc[ai][bj][m][n] = __builtin_amdgcn_mfma_f32_16x16x32_bf16(Bt[n][k], At[m][k], acc[ai][bj][m][n], 0, 0, 0); } } \
        __builtin_amdgcn_s_setprio(0); } while (0)
#define PG8_WAIT_V(n) asm volatile("s_waitcnt vmcnt(" #n ")" ::: "memory")
#define PG8_WAIT_L(n) asm volatile("s_waitcnt lgkmcnt(" #n ")" ::: "memory")
#define PG8_BAR __builtin_amdgcn_s_barrier()
#define PG8_SCHED __builtin_amdgcn_sched_barrier(0)
    Unit cur, nxt; int ui = 0;
    if (!S.next(0, cur)) return;
    f32x4 acc[2][2][4][2];
#pragma unroll
    for (int a = 0; a < 2; ++a)
#pragma unroll
        for (int b = 0; b < 2; ++b)
#pragma unroll
            for (int m = 0; m < 4; ++m)
#pragma unroll
                for (int n = 0; n < 2; ++n) acc[a][b][m][n] = (f32x4){0.f, 0.f, 0.f, 0.f};
    bf16x8 At[4][2], B0[2][2], B1[2][2];
#define PG8_AOFF(u) unit_aoff(E, g, u)
#define PG8_BOFF(u) unit_boff(E, g, u)
    const char* cA = (const char*)g.A + (size_t)cur.pm * tstep + PG8_AOFF(cur); const char* cB = (const char*)g.Bt + (size_t)cur.pn * tstep + PG8_BOFF(cur);
    S.a_ready(cur);
    if constexpr (WARM) {
#pragma unroll 4
        for (int i = tid; i < 256 * K * 2 / 128; i += 512) { const unsigned x = *(const unsigned*)(cA + (size_t)i * 128); asm volatile("" :: "v"(x)); } }
    if constexpr (SP2) {
        PG8_STAGE(PG8_SB(0, 0), cB, voffB); PG8_STAGE(PG8_SB(0, 1), cB + hstep, voffB); PG8_STAGE(PG8_SA(0, 0), cA, voffA); PG8_STAGE(PG8_SA(0, 1), cA + hstep, voffA);
        if (wr == 1) PG8_BAR;
        PG8_WAIT_V(2); PG8_BAR;
        PG8_STAGE(PG8_SB(1, 0), cB + kstep, voffB); PG8_STAGE(PG8_SA(1, 0), cA + kstep, voffA); PG8_STAGE(PG8_SB(1, 1), cB + hstep + kstep, voffB);
        PG8_WAIT_V(6); PG8_BAR;
    } else {
        PG8_STAGE(PG8_SB(0, 0), cB, voffB); PG8_STAGE(PG8_SA(0, 0), cA, voffA); PG8_STAGE(PG8_SB(0, 1), cB + hstep, voffB); PG8_STAGE(PG8_SA(0, 1), cA + hstep, voffA);
        if (wr == 1) PG8_BAR;
        PG8_WAIT_V(4); PG8_BAR;
        PG8_STAGE(PG8_SB(1, 0), cB + kstep, voffB); PG8_STAGE(PG8_SA(1, 0), cA + kstep, voffA); PG8_STAGE(PG8_SB(1, 1), cB + hstep + kstep, voffB);
        PG8_WAIT_V(6); PG8_BAR;
    }
    for (;;) {
        const bool has_next = S.next(ui + 1, nxt);
        const char* nA = has_next ? (const char*)g.A + (size_t)nxt.pm * tstep + PG8_AOFF(nxt) : cA; const char* nB = has_next ? (const char*)g.Bt + (size_t)nxt.pn * tstep + PG8_BOFF(nxt) : cB;
        const int nt_u = unit_ktiles(E, nt, cur);
        for (int t = 0; t < nt_u; t += 2) {
            const bool last = (t == nt_u - 2);
            const char* a1 = cA + (size_t)(t + 1) * kstep;
            const char* a2 = last ? nA : cA + (size_t)(t + 2) * kstep; const char* b2 = last ? nB : cB + (size_t)(t + 2) * kstep;
            const char* a3 = a2 + kstep; const char* b3 = b2 + kstep;
            if (last && has_next) S.a_ready(nxt);
            if constexpr (SP2) {
            PG8_LDB(B0, 0, 0); PG8_LDB(B1, 0, 1); PG8_SCHED; PG8_LDA(At, 0, 0); PG8_STAGE(PG8_SA(1, 1), a1 + hstep, voffA);
            PG8_WAIT_V(8); PG8_WAIT_L(0); PG8_BAR; PG8_MMA(0, 0, At, B0); PG8_MMA(0, 1, At, B1); PG8_BAR; PG8_SCHED;
            PG8_LDA(At, 0, 1); PG8_STAGE(PG8_SB(0, 0), b2, voffB); PG8_STAGE(PG8_SB(0, 1), b2 + hstep, voffB); PG8_STAGE(PG8_SA(0, 0), a2, voffA);
            PG8_WAIT_V(8); PG8_WAIT_L(0); PG8_BAR; PG8_MMA(1, 0, At, B0); PG8_MMA(1, 1, At, B1); PG8_BAR; PG8_SCHED;
            PG8_LDB(B0, 1, 0); PG8_LDB(B1, 1, 1); PG8_SCHED; PG8_LDA(At, 1, 0); PG8_STAGE(PG8_SA(0, 1), a2 + hstep, voffA);
            PG8_WAIT_V(8); PG8_WAIT_L(0); PG8_BAR; PG8_MMA(0, 0, At, B0); PG8_MMA(0, 1, At, B1); PG8_BAR; PG8_SCHED;
            PG8_LDA(At, 1, 1); PG8_STAGE(PG8_SB(1, 0), b3, voffB); PG8_STAGE(PG8_SB(1, 1), b3 + hstep, voffB); PG8_STAGE(PG8_SA(1, 0), a3, voffA);
            PG8_WAIT_V(8); PG8_WAIT_L(0); PG8_BAR; PG8_MMA(1, 0, At, B0); PG8_MMA(1, 1, At, B1); PG8_BAR; PG8_SCHED;
            } else {
            PG8_LDB(B0, 0, 0); PG8_SCHED; PG8_LDA(At, 0, 0); PG8_STAGE(PG8_SA(1, 1), a1 + hstep, voffA);
            PG8_WAIT_L(8); PG8_BAR; PG8_WAIT_L(0); PG8_MMA(0, 0, At, B0); PG8_BAR; PG8_SCHED;
            PG8_LDB(B1, 0, 1); PG8_STAGE(PG8_SB(0, 0), b2, voffB);
            PG8_BAR; PG8_WAIT_L(0); PG8_MMA(0, 1, At, B1); PG8_BAR;
            PG8_LDA(At, 0, 1); PG8_STAGE(PG8_SA(0, 0), a2, voffA);
            PG8_BAR; PG8_WAIT_L(0); PG8_MMA(1, 0, At, B0); PG8_BAR; PG8_SCHED;
            PG8_STAGE(PG8_SB(0, 1), b2 + hstep, voffB);
            PG8_WAIT_V(6); PG8_BAR; PG8_MMA(1, 1, At, B1); PG8_BAR;
            PG8_LDB(B0, 1, 0); PG8_SCHED; PG8_LDA(At, 1, 0); PG8_STAGE(PG8_SA(0, 1), a2 + hstep, voffA);
            PG8_WAIT_L(8); PG8_BAR; PG8_WAIT_L(0); PG8_MMA(0, 0, At, B0); PG8_BAR; PG8_SCHED;
            PG8_LDB(B1, 1, 1); PG8_STAGE(PG8_SB(1, 0), b3, voffB);
            PG8_BAR; PG8_WAIT_L(0); PG8_MMA(0, 1, At, B1); PG8_BAR;
            PG8_LDA(At, 1, 1); PG8_STAGE(PG8_SA(1, 0), a3, voffA);
            PG8_BAR; PG8_WAIT_L(0); PG8_MMA(1, 0, At, B0); PG8_BAR; PG8_SCHED;
            PG8_STAGE(PG8_SB(1, 1), b3 + hstep, voffB);
            PG8_WAIT_V(6); PG8_BAR; PG8_MMA(1, 1, At, B1); PG8_BAR;
            }
        }
        if constexpr (ALIGN_EPI) { if (wr == 0) PG8_BAR; }
        if constexpr (FP8) { asm volatile("s_nop 15\n\ts_nop 15" ::: "memory");
#pragma unroll
            for (int a = 0; a < 2; ++a)
#pragma unroll
                for (int b = 0; b < 2; ++b)
#pragma unroll
                    for (int m = 0; m < 4; ++m) asm volatile("" : "+v"(acc[a][b][m][0]), "+v"(acc[a][b][m][1])); }
        E(acc, cur, wr, wc, fr, fq);
        S.done(cur);
        if (!has_next) break;
        if (unit_restart(E, cur)) {
#pragma unroll
        for (int a = 0; a < 2; ++a)
#pragma unroll
            for (int b = 0; b < 2; ++b)
#pragma unroll
                for (int m = 0; m < 4; ++m)
#pragma unroll
                    for (int n = 0; n < 2; ++n) acc[a][b][m][n] = (f32x4){0.f, 0.f, 0.f, 0.f};
        }
        cur = nxt; cA = nA; cB = nB; ++ui;
        if constexpr (ALIGN_EPI) { if (wr == 1) PG8_BAR; }
    }
    PG8_WAIT_V(0);
    if constexpr (!ALIGN_EPI) { if (wr == 0) PG8_BAR; }
    PG8_BAR;
#undef PG8_AOFF
#undef PG8_BOFF
#undef PG8_SA
#undef PG8_SB
#undef PG8_STAGE
#undef PG8_LDA
#undef PG8_LDB
#undef PG8_MMA
#undef PG8_WAIT_V
#undef PG8_WAIT_L
#undef PG8_BAR
#undef PG8_SCHED
}
}

constexpr int T_ALL = 16896, T_P = 16384, T_S = 512, DM = 1024, NBC = 136;
constexpr int SEQ = 2048, NCH = 32, CH = 64;
constexpr int NU = 5888, NUV = 5664, NG = 3072, NF1 = 5632, FH = 2816, NIN = 8736;
constexpr int C_GQ = 0, C_GK = 512, C_GV = 1024, C_GR = 1536, C_GLR = 2048, C_SZ = 2064, C_SXBC = 2576, C_SDT = 3600, C_DQKV = 3608, C_DA = 5144, C_DB = 5148, C_DG = 5152;
constexpr float EPS = 1e-6f;
constexpr size_t MiB = 1u << 20;
constexpr size_t WS_CTL = 0, CTL_ZERO_BYTES = 65536;
constexpr size_t WS_MOD = 1 * MiB;
constexpr size_t WS_W = 8 * MiB;
constexpr size_t W_IN = 0, W_G = W_IN + (size_t)NU * DM * 2, W_B = W_G + (size_t)NG * DM * 2, W_O = W_B + (size_t)3 * DM * 512 * 2, W_F1 = W_O + (size_t)DM * DM * 2, W_F2 = W_F1 + (size_t)NF1 * DM * 2, W_END = W_F2 + (size_t)DM * FH * 2;
static_assert(W_END <= 40 * MiB, "weights");
constexpr size_t WS_H = 48 * MiB;
constexpr size_t WS_YS = 81 * MiB;
constexpr size_t WS_U = 131 * MiB;
constexpr size_t WS_G = WS_U, WS_MERGED = WS_U + 100 * MiB, WS_MIX = WS_U + 134 * MiB, WS_HID = WS_U, WS_HIDS = WS_U + 48 * MiB, WS_F = WS_U + 100 * MiB;
constexpr size_t WS_SCR = 321 * MiB;
constexpr size_t WS_END = 467 * MiB;
constexpr size_t WS_F2Q = 321 * MiB;
static_assert(WS_H + (size_t)T_ALL * DM * 2 <= WS_YS && WS_YS + (size_t)3 * T_ALL * 512 * 2 <= WS_U && WS_U + (size_t)T_ALL * NU * 2 <= WS_SCR, "ws map");
static_assert((size_t)T_ALL * NG * 2 <= 100 * MiB && (size_t)T_ALL * DM * 2 <= 34 * MiB && (size_t)T_ALL * FH * 2 <= 100 * MiB && WS_MIX + 34 * MiB <= WS_SCR, "overlays");
constexpr size_t O_Y = 0, O_YS = (size_t)T_P * DM, O_PGLA = O_YS + (size_t)T_S * DM, O_PSSD = O_PGLA + 1048576, O_PCS = O_PSSD + 1048576, O_PGDN = O_PCS + 49152, O_PCD = O_PGDN + 1048576,
                 O_SGLA = O_PCD + 73728, O_SSSD = O_SGLA + 16777216, O_SCS = O_SSSD + 16777216, O_SGDN = O_SCS + 786432, O_SCD = O_SGDN + 16777216, O_END = O_SCD + 1179648;
constexpr int CW_BAR = 4096;
constexpr int RING_BYTES = 131072, LDS_BYTES = 147456, LDSCTL_OFF = LDS_BYTES - 2048, MISC_OFF = LDSCTL_OFF + 320;
constexpr int NWAVES = 8, NTHR = 512;
#define GAS __attribute__((address_space(1)))
#define LAS __attribute__((address_space(3)))
typedef unsigned short bf16;
typedef unsigned v4u __attribute__((ext_vector_type(4)));
typedef unsigned v2u __attribute__((ext_vector_type(2)));
typedef float f32x4 __attribute__((ext_vector_type(4)));
typedef float f32x16 __attribute__((ext_vector_type(16)));
typedef short bf16x8 __attribute__((ext_vector_type(8)));
typedef GAS unsigned gu32;
#define RLX_AGENT __ATOMIC_RELAXED, __HIP_MEMORY_SCOPE_AGENT
#define LDS_WAIT() asm volatile("s_waitcnt lgkmcnt(0)" ::: "memory")
#define LBAR() do { asm volatile("s_waitcnt lgkmcnt(0)" ::: "memory"); __builtin_amdgcn_s_barrier(); asm volatile("" ::: "memory"); } while (0)
#define VM_WAIT() asm volatile("s_waitcnt vmcnt(0)" ::: "memory")
__device__ __forceinline__ unsigned f2bf(float f) { unsigned u = __builtin_bit_cast(unsigned, f); return (u + 0x7fffu + ((u >> 16) & 1u)) >> 16; }
__device__ __forceinline__ unsigned pk2(float lo, float hi) { return f2bf(lo) | (f2bf(hi) << 16); }
__device__ __forceinline__ float bf2f(bf16 x) { return __uint_as_float((unsigned)x << 16); }
__device__ __forceinline__ float blo(unsigned u) { return __uint_as_float(u << 16); }
__device__ __forceinline__ float bhi(unsigned u) { return __uint_as_float(u & 0xffff0000u); }
__device__ __forceinline__ float sigmoid_f(float x) { return __builtin_amdgcn_rcpf(1.f + __expf(-x)); }
__device__ __forceinline__ float silu_f(float x) { return x * __builtin_amdgcn_rcpf(1.f + __expf(-x)); }
__device__ __forceinline__ float softplus_f(float x) { return x > 20.f ? x : __logf(1.f + __expf(x)); }
__device__ __forceinline__ float logsigmoid_f(float x) { return fminf(x, 0.f) - __logf(1.f + __expf(-fabsf(x))); }
#define SWZ_XOR(x, SH) __int_as_float(__builtin_amdgcn_ds_swizzle(__float_as_int(x), 0x1f | ((SH) << 10)))
__device__ __forceinline__ float wave_sum(float v) {
    v += SWZ_XOR(v, 1); v += SWZ_XOR(v, 2); v += SWZ_XOR(v, 4); v += SWZ_XOR(v, 8); v += SWZ_XOR(v, 16);
    return __int_as_float(__builtin_amdgcn_readlane(__float_as_int(v), 0)) + __int_as_float(__builtin_amdgcn_readlane(__float_as_int(v), 32));
}
__device__ __forceinline__ float wave_incl_scan(LAS float* buf, float x, int lane) {
    buf[lane] = x; asm volatile("s_waitcnt lgkmcnt(0)" ::: "memory"); f32x4 v[16];
#pragma unroll
    for (int q = 0; q < 16; ++q) v[q] = *(const LAS f32x4*)(buf + 4 * q);
    float acc = 0.f;
#pragma unroll
    for (int j = 0; j < 64; ++j) acc += (j <= lane) ? v[j >> 2][j & 3] : 0.f;
    return acc;
}

#define XB_TMO      128
#define XB_XCNT(j)  (256  + 64 * (j))
#define XB_XSUB(j)  (1280 + 64 * (j))
#define XB_XGEN(j)  (2304 + 64 * (j))
#define XB_TOP      3328
#define XB_TOPGEN   3392
#define XCD_BAR_WORDS 3456
#define XB_SPIN_CAP (1u << 18)

__device__ __forceinline__ unsigned xb_ld(unsigned* p)              { return __hip_atomic_load(p, __ATOMIC_RELAXED, __HIP_MEMORY_SCOPE_AGENT); }
__device__ __forceinline__ unsigned xb_add(unsigned* p, unsigned v) { return __hip_atomic_fetch_add(p, v, __ATOMIC_RELAXED, __HIP_MEMORY_SCOPE_AGENT); }
__device__ __forceinline__ unsigned xb_xcc_id() { return (unsigned)__builtin_amdgcn_s_getreg((3 << 11) | 20) & 0xFu; }
#define XB_SPIN(cond, bar) do { unsigned _sp = 0; while (cond) { __builtin_amdgcn_s_sleep(1); \
    if ((++_sp & 255u) == 0u) { if (xb_ld(&(bar)[XB_TMO])) break; if (_sp > XB_SPIN_CAP) { atomicAdd(&(bar)[XB_TMO], 1u); break; } } } } while (0)

struct XcdBarrier {
    unsigned* bar; unsigned x;
    volatile LAS unsigned* st;
};

__device__ __forceinline__ XcdBarrier xcd_barrier_post(unsigned* bar, volatile LAS unsigned* st, bool leader) {
    XcdBarrier b; b.bar = bar; b.x = xb_xcc_id(); b.st = st;
    if (leader) (void)xb_add(&bar[XB_XCNT(b.x)], 1u);
    return b;
}
__device__ __forceinline__ void xcd_barrier_complete(unsigned* bar, unsigned x, unsigned& nloc, unsigned& nx) {
    const unsigned G = gridDim.x * gridDim.y * gridDim.z;
    unsigned sum, cnt, mine, sp = 0u;
    for (;;) {
        sum = 0u; cnt = 0u; mine = 0u;
#pragma unroll
        for (unsigned j = 0; j < 16; ++j) { const unsigned c = xb_ld(&bar[XB_XCNT(j)]); sum += c; cnt += (c > 0u) ? 1u : 0u; mine = (j == x) ? c : mine; }
        if (sum == G) break;
        __builtin_amdgcn_s_sleep(1);
        if ((++sp & 255u) == 0u) { if (xb_ld(&bar[XB_TMO])) break; if (sp > XB_SPIN_CAP) { atomicAdd(&bar[XB_TMO], 1u); break; } }
    }
    nloc = mine > 0u ? mine : 1u; nx = cnt > 0u ? cnt : 1u;
}

__device__ __forceinline__ void xcd_barrier(const XcdBarrier& b, bool leader) {
    asm volatile("s_waitcnt vmcnt(0)" ::: "memory");
    __syncthreads();
    if (leader) {
        unsigned* bar = b.bar;
        __builtin_amdgcn_s_waitcnt(0);
        unsigned nloc = b.st[0], nx = b.st[1];
        if (nloc == 0u) { xcd_barrier_complete(bar, b.x, nloc, nx); b.st[0] = nloc; b.st[1] = nx; }
        const unsigned old = xb_add(&bar[XB_XSUB(b.x)], 1u);
        const unsigned gen = old / nloc;
        if (old + 1u == (gen + 1u) * nloc) {
            __builtin_amdgcn_fence(__ATOMIC_RELEASE, "agent");
            asm volatile("s_waitcnt vmcnt(0)" ::: "memory");
            const unsigned og = xb_add(&bar[XB_TOP], 1u);
            const unsigned tg = og / nx;
            if (og + 1u == (tg + 1u) * nx) xb_add(&bar[XB_TOPGEN], 1u);
            else XB_SPIN(xb_ld(&bar[XB_TOPGEN]) == tg, bar);
            __builtin_amdgcn_fence(__ATOMIC_ACQUIRE, "agent");
            xb_add(&bar[XB_XGEN(b.x)], 1u);
            asm volatile("s_waitcnt vmcnt(0)" ::: "memory");
        } else {
            XB_SPIN(xb_ld(&bar[XB_XGEN(b.x)]) == gen, bar);
            __builtin_amdgcn_fence(__ATOMIC_ACQUIRE, "agent");
            asm volatile("s_waitcnt vmcnt(0)" ::: "memory");
        }
    }
    __syncthreads();
}

struct Args { const float* in[33]; float* out; unsigned char* ws; int ph_lo, ph_hi; };
enum { I_XP = 0, I_XS, I_SGLA, I_SSSD, I_CSSD, I_SGDN, I_CGDN, I_CP, I_CS, I_WADA, I_BADA, I_GPREM, I_GPOSTM, I_GPREF, I_GPOSTF, I_WIN, I_WGG, I_BGG, I_GGLAN, I_WSC, I_BSC, I_SDTB, I_SALOG, I_SD, I_GSSDN,
       I_WGC, I_GDTB, I_GALOG, I_GGDNN, I_WBR, I_WOUT, I_WF1, I_WF2 };

struct Ctx {
    LAS unsigned char* lds; int tid, lane, wave, vcu, G;
    const float* const* in; float* out; unsigned char* ws;
};
__device__ __forceinline__ int bidx_of_row(int row) { return row < T_P ? (row >> 11) : 8 + ((row - T_P) >> 2); }

struct TItem { const float* W; int N, k0, n0; bf16* WT; int drow, Kd; const float* ks; int dk0; unsigned char* W8; int w8_ld; float w8_s; };
__device__ __forceinline__ void conv_decode(const Ctx& C, int l, int it, TItem& t) {
    unsigned char* wb = C.ws + WS_W;
    bf16* Win_t = (bf16*)(wb + W_IN); bf16* Wg_t = (bf16*)(wb + W_G); bf16* Wb_t = (bf16*)(wb + W_B); bf16* Wo_t = (bf16*)(wb + W_O); bf16* Wf1_t = (bf16*)(wb + W_F1); bf16* Wf2_t = (bf16*)(wb + W_F2);
    const float* w_in = C.in[I_WIN] + (size_t)l * DM * NIN; const float* w_br = C.in[I_WBR] + (size_t)l * 3 * 512 * DM; const float* w_out = C.in[I_WOUT] + (size_t)l * DM * DM;
    const float* w_f1 = C.in[I_WF1] + (size_t)l * DM * NF1; const float* w_f2 = C.in[I_WF2] + (size_t)l * FH * DM;
    constexpr int IA = 16 * 273, IB = 3 * 8 * 32, IC = 16 * 32, ID = 16 * 176, IE = 44 * 32;
    int r = it; t.ks = nullptr; t.W8 = nullptr; t.w8_ld = 4096; t.w8_s = 32.f;
    if (r < IA) { const int kb = r / 273, nb = r % 273, n0 = 32 * nb; t.W = w_in; t.N = NIN; t.k0 = 64 * kb; t.n0 = n0; t.Kd = DM; t.dk0 = 64 * kb;
        if (n0 < NUV) { t.WT = Win_t; t.drow = n0; }
        else { const int gcol = n0 - NUV, gi = gcol >> 10, ch = gcol & 1023;
            t.WT = Wg_t; t.drow = gi == 1 ? 2048 + ch : (ch >> 7) * 256 + (gi == 2 ? 128 : 0) + (ch & 127); t.W8 = (unsigned char*)C.out + 3072; }
        return; } r -= IA;
    if (r < IB) { const int n = r / 256, q = r % 256, kb = q / 32, nb = q % 32;
        t.W = w_br + (size_t)n * 512 * DM; t.N = DM; t.k0 = 64 * kb; t.n0 = 32 * nb; t.drow = 32 * nb; t.Kd = 512; t.dk0 = 64 * kb;
        if (n != 1) t.WT = Wb_t + (size_t)(n >> 1) * DM * 512; else { t.WT = Wb_t + (size_t)2 * DM * 512; t.ks = C.in[I_GSSDN] + l * 512; }
        return; } r -= IB;
    if (r < IC) { const int kb = r / 32, nb = r % 32; t.W = w_out; t.N = DM; t.k0 = 64 * kb; t.n0 = 32 * nb; t.WT = Wo_t; t.drow = 32 * nb; t.Kd = DM; t.dk0 = 64 * kb; return; } r -= IC;
    if (r < ID) { const int kb = r / 176, nb = r % 176, n0 = 32 * nb; const int isb = n0 >= FH ? 1 : 0, j = n0 - isb * FH;
        t.W = w_f1; t.N = NF1; t.k0 = 64 * kb; t.n0 = n0; t.WT = Wf1_t; t.drow = (j >> 7) * 256 + isb * 128 + (j & 127); t.Kd = DM; t.dk0 = 64 * kb; return; } r -= ID;
    if (r < IE) { const int kb = r / 32, nb = r % 32; t.W = w_f2; t.N = DM; t.k0 = 64 * kb; t.n0 = 32 * nb; t.WT = Wf2_t; t.drow = 32 * nb; t.Kd = FH; t.dk0 = 64 * kb; return; } r -= IE;
    t.W = nullptr; t.WT = Win_t; t.drow = NUV + r; t.Kd = DM; t.N = 0; t.k0 = 0; t.n0 = 0; t.dk0 = 0;
}
__device__ __forceinline__ void ti_load(const TItem& t, int lane, f32x4 (&x)[8], float (&sc)[8]) {
    if (t.W == nullptr) return;
#pragma unroll
    for (int i = 0; i < 8; ++i) { const int kk = 8 * i + (lane >> 3), n4 = (lane & 7) * 4; x[i] = *(const GAS f32x4*)(t.W + (size_t)(t.k0 + kk) * t.N + t.n0 + n4); sc[i] = t.ks ? t.ks[t.k0 + kk] : 1.f; }
}
__device__ __forceinline__ void ti_finish(const TItem& t, LAS float* scr, int lane, const f32x4 (&x)[8], const float (&sc)[8]) {
    if (t.W == nullptr) { GAS v4u* p = (GAS v4u*)(t.WT + (size_t)t.drow * t.Kd) + lane * 2; const v4u z = {0u, 0u, 0u, 0u}; p[0] = z; p[1] = z; return; }
#pragma unroll
    for (int i = 0; i < 8; ++i) { const int kk = 8 * i + (lane >> 3), n4 = (lane & 7) * 4; const f32x4 v = x[i] * sc[i];
        scr[kk * 33 + n4] = v[0]; scr[kk * 33 + n4 + 1] = v[1]; scr[kk * 33 + n4 + 2] = v[2]; scr[kk * 33 + n4 + 3] = v[3]; }
    LDS_WAIT(); asm volatile("" ::: "memory");
    const int c = lane & 7;
#pragma unroll
    for (int j = 0; j < 4; ++j) { const int n = (lane >> 3) + 8 * j; const LAS float* s = scr + (8 * c) * 33 + n;
        v4u o; o.x = pk2(s[0 * 33], s[1 * 33]); o.y = pk2(s[2 * 33], s[3 * 33]); o.z = pk2(s[4 * 33], s[5 * 33]); o.w = pk2(s[6 * 33], s[7 * 33]);
        if (t.WT) *(GAS v4u*)(t.WT + (size_t)(t.drow + n) * t.Kd + t.dk0 + 8 * c) = o;
        if (t.W8) { v2u q8; unsigned w = 0u; w = __builtin_amdgcn_cvt_pk_fp8_f32(t.w8_s * s[0 * 33], t.w8_s * s[1 * 33], w, false); w = __builtin_amdgcn_cvt_pk_fp8_f32(t.w8_s * s[2 * 33], t.w8_s * s[3 * 33], w, true); q8.x = w;
            w = 0u; w = __builtin_amdgcn_cvt_pk_fp8_f32(t.w8_s * s[4 * 33], t.w8_s * s[5 * 33], w, false); w = __builtin_amdgcn_cvt_pk_fp8_f32(t.w8_s * s[6 * 33], t.w8_s * s[7 * 33], w, true); q8.y = w;
            *(GAS v2u*)(t.W8 + (size_t)(t.drow + n) * t.w8_ld + t.dk0 + 8 * c) = q8; } }
    LDS_WAIT(); asm volatile("" ::: "memory");
}
__device__ __forceinline__ void convert_weights(const Ctx& C, int l) {
    LAS float* scr = (LAS float*)(C.lds + C.wave * 16384);
    constexpr int NIT = 16 * 273 + 3 * 8 * 32 + 16 * 32 + 16 * 176 + 44 * 32 + (NU - NUV);
    const int gw = C.vcu * NWAVES + C.wave, NGW = C.G * NWAVES;
    int it = gw; if (it >= NIT) return;
    TItem cur; conv_decode(C, l, it, cur); f32x4 xa[8]; float sa[8]; ti_load(cur, C.lane, xa, sa);
#pragma unroll 1
    for (;;) { const int itn = it + NGW; const bool has = itn < NIT; TItem nxt = cur; f32x4 xb[8]; float sb[8];
#pragma unroll
        for (int i = 0; i < 8; ++i) { xb[i] = xa[i]; sb[i] = sa[i]; }
        if (has) { conv_decode(C, l, itn, nxt); ti_load(nxt, C.lane, xb, sb); }
        __builtin_amdgcn_sched_barrier(0);
        ti_finish(cur, scr, C.lane, xa, sa);
        if (!has) break;
        cur = nxt; it = itn;
#pragma unroll
        for (int i = 0; i < 8; ++i) { xa[i] = xb[i]; sa[i] = sb[i]; } }
}
__device__ __forceinline__ void convert_f2_fp8(const Ctx& C, int l, int rank, int nranks) {
    LAS float* scr = (LAS float*)(C.lds + C.wave * 16384); const float* w_f2 = C.in[I_WF2] + (size_t)l * FH * DM;
    const int gw = rank * NWAVES + C.wave, NGW = nranks * NWAVES;
    for (int it = gw; it < 44 * 32; it += NGW) { const int kb = it / 32, nb = it % 32; TItem t; t.W = w_f2; t.N = DM; t.k0 = 64 * kb; t.n0 = 32 * nb; t.WT = nullptr; t.drow = 32 * nb; t.Kd = FH; t.ks = nullptr; t.dk0 = 64 * kb;
        t.W8 = C.ws + WS_F2Q; t.w8_ld = FH; t.w8_s = 32.f; f32x4 x[8]; float sc[8]; ti_load(t, C.lane, x, sc); ti_finish(t, scr, C.lane, x, sc); }
}
__device__ __forceinline__ void compute_mod(const Ctx& C) {
    LAS float* cs = (LAS float*)C.lds;
    LAS float* red = (LAS float*)(C.lds + 81920);
    float* mod = (float*)(C.ws + WS_MOD);
    for (int item = C.vcu; item < 128; item += C.G) {
        const int l = 0, cb = item / 8, rg = item % 8, r0 = rg * 17;
        __syncthreads();
        for (int idx = C.tid; idx < 17 * 1024; idx += NTHR) { const int r = idx >> 10, k = idx & 1023, bi = r0 + r;
            const float c = bi < 8 ? C.in[I_CP][bi * DM + k] : C.in[I_CS][(bi - 8) * DM + k]; cs[k * 20 + r] = silu_f(c); }
        __syncthreads();
        const int cl = C.tid & 127, col = cb * 128 + cl, kq = C.tid >> 7;
        const float* w = C.in[I_WADA] + (size_t)l * DM * 6144 + col;
        float acc[17];
#pragma unroll
        for (int r = 0; r < 17; ++r) acc[r] = 0.f;
        float wa[8], wq[8];
#define MOD_LDW(wv, kb) do { _Pragma("unroll") for (int u = 0; u < 8; ++u) wv[u] = w[(size_t)((kb) + u) * 6144]; } while (0)
#define MOD_FMA(wv, kb) do { _Pragma("unroll") for (int u = 0; u < 8; ++u) { const LAS f32x4* c4 = (const LAS f32x4*)(cs + ((kb) + u) * 20); const f32x4 a = c4[0], b = c4[1], c = c4[2], d = c4[3]; const float e = cs[((kb) + u) * 20 + 16]; const float x = wv[u]; \
                acc[0] += a[0] * x; acc[1] += a[1] * x; acc[2] += a[2] * x; acc[3] += a[3] * x; acc[4] += b[0] * x; acc[5] += b[1] * x; acc[6] += b[2] * x; acc[7] += b[3] * x; \
                acc[8] += c[0] * x; acc[9] += c[1] * x; acc[10] += c[2] * x; acc[11] += c[3] * x; acc[12] += d[0] * x; acc[13] += d[1] * x; acc[14] += d[2] * x; acc[15] += d[3] * x; acc[16] += e * x; } } while (0)
        MOD_LDW(wa, kq * 256);
#pragma unroll 1
        for (int k0 = kq * 256; k0 < kq * 256 + 256; k0 += 16) {
            MOD_LDW(wq, k0 + 8); __builtin_amdgcn_sched_barrier(0);
            MOD_FMA(wa, k0); __builtin_amdgcn_sched_barrier(0);
            if (k0 + 16 < kq * 256 + 256) MOD_LDW(wa, k0 + 16);
            __builtin_amdgcn_sched_barrier(0);
            MOD_FMA(wq, k0 + 8); __builtin_amdgcn_sched_barrier(0); }
#undef MOD_LDW
#undef MOD_FMA
        LAS float* redw = red + ((kq - 1) * 17) * 128 + cl; LAS float* redr = red + cl; asm volatile("" : "+v"(redw), "+v"(redr));
        if (kq > 0) {
#pragma unroll
            for (int r = 0; r < 17; ++r) redw[r * 128] = acc[r]; }
        __syncthreads();
        if (kq == 0) { const float bv = C.in[I_BADA][l * 6144 + col];
#pragma unroll
            for (int r = 0; r < 17; ++r) mod[((size_t)l * NBC + r0 + r) * 6144 + col] = acc[r] + redr[r * 128] + redr[(17 + r) * 128] + redr[(34 + r) * 128] + bv; }
    }
    __syncthreads();
}
__device__ __forceinline__ void load_bf16_row(const bf16* p, int lane, f32x4 (&v)[4]) {
    const GAS v2u* q = (const GAS v2u*)p + lane;
#pragma unroll
    for (int j = 0; j < 4; ++j) { const v2u w = q[64 * j]; v[j] = (f32x4){blo(w.x), bhi(w.x), blo(w.y), bhi(w.y)}; }
}
__device__ __forceinline__ void load_f32_row(const float* p, int lane, f32x4 (&v)[4]) {
    const GAS f32x4* q = (const GAS f32x4*)p + lane;
#pragma unroll
    for (int j = 0; j < 4; ++j) v[j] = q[64 * j];
}
__device__ __forceinline__ void store_f32_row(float* p, int lane, const f32x4 (&v)[4]) {
    GAS f32x4* q = (GAS f32x4*)p + lane;
#pragma unroll
    for (int j = 0; j < 4; ++j) q[64 * j] = v[j];
}
__device__ __forceinline__ void store_bf16_row(bf16* p, int lane, const f32x4 (&v)[4]) {
    GAS v2u* q = (GAS v2u*)p + lane;
#pragma unroll
    for (int j = 0; j < 4; ++j) { v2u w; w.x = pk2(v[j][0], v[j][1]); w.y = pk2(v[j][2], v[j][3]); q[64 * j] = w; }
}
__device__ __forceinline__ void store_fp8_row(unsigned char* p, int lane, const f32x4 (&v)[4]) {
    GAS unsigned* q = (GAS unsigned*)p + lane;
#pragma unroll
    for (int j = 0; j < 4; ++j) { unsigned w = 0u; w = __builtin_amdgcn_cvt_pk_fp8_f32(v[j][0], v[j][1], w, false); w = __builtin_amdgcn_cvt_pk_fp8_f32(v[j][2], v[j][3], w, true); q[64 * j] = w; }
}
__device__ __forceinline__ float row_rstd(const f32x4 (&v)[4]) {
    float s = 0.f;
#pragma unroll
    for (int j = 0; j < 4; ++j) s += (v[j][0] * v[j][0] + v[j][1] * v[j][1]) + (v[j][2] * v[j][2] + v[j][3] * v[j][3]);
    return rsqrtf(wave_sum(s) * (1.f / DM) + EPS);
}
__device__ __forceinline__ void mod_norm_store(const Ctx& C, const f32x4 (&x)[4], const float* g, const float* sc, const float* sh, bf16* hrow, unsigned char* h8row) {
    const float rstd = row_rstd(x); f32x4 gv[4], scv[4], shv[4], h[4];
    load_f32_row(g, C.lane, gv); load_f32_row(sc, C.lane, scv); load_f32_row(sh, C.lane, shv);
#pragma unroll
    for (int j = 0; j < 4; ++j) h[j] = x[j] * rstd * gv[j] * (1.f + scv[j]) + shv[j];
    store_bf16_row(hrow, C.lane, h); store_fp8_row(h8row, C.lane, h);
}
__device__ __forceinline__ void phase_prenorm0(const Ctx& C) {
    const float* mod = (const float*)(C.ws + WS_MOD); bf16* H = (bf16*)(C.ws + WS_H);
    const int gw = C.vcu * NWAVES + C.wave, NGW = C.G * NWAVES;
    for (int row = gw; row < T_ALL; row += NGW) {
        const float* src = row < T_P ? C.in[I_XP] + (size_t)row * DM : C.in[I_XS] + (size_t)(row - T_P) * DM;
        f32x4 x[4]; load_f32_row(src, C.lane, x);
        const float* mb = mod + (size_t)bidx_of_row(row) * 6144;
        mod_norm_store(C, x, C.in[I_GPREM], mb + 1 * DM, mb + 0 * DM, H + (size_t)row * DM, (unsigned char*)(C.out + (size_t)row * DM) + 2048);
    }
}
__device__ __forceinline__ void rows_core(const Ctx& C, int row, const f32x4 (&s)[4], f32x4 (&x)[4], const f32x4 (&gtv)[4], bool do_h, const f32x4 (&gpsc)[4], const f32x4 (&sh)[4], bool st, bool xf32, bool h8) {
    const float rstd = row_rstd(s);
#pragma unroll
    for (int j = 0; j < 4; ++j) x[j] = x[j] + gtv[j] * (s[j] * rstd);
    if (st) { if (xf32) store_f32_row(C.out + (size_t)row * DM, C.lane, x); else store_bf16_row((bf16*)(C.out + (size_t)row * DM), C.lane, x); }
    if (do_h) { const float r2 = row_rstd(x); f32x4 h[4];
#pragma unroll
        for (int j = 0; j < 4; ++j) h[j] = x[j] * r2 * gpsc[j] + sh[j];
        store_bf16_row(st ? (bf16*)(C.ws + WS_H) + (size_t)row * DM : (bf16*)(C.ws + WS_SCR) + (size_t)row * DM, C.lane, h);
        if (h8 && st) store_fp8_row((unsigned char*)(C.out + (size_t)row * DM) + 2048, C.lane, h); }
}
__device__ __forceinline__ const float* xrow_ptr(const Ctx& C, int row, bool from_inputs) { return from_inputs ? (row < T_P ? C.in[I_XP] + (size_t)row * DM : C.in[I_XS] + (size_t)(row - T_P) * DM) : C.out + (size_t)row * DM; }
__device__ __forceinline__ void phase_rows(const Ctx& C, const bf16* src, int l, int gt_i, const float* gpost, bool do_h, const float* gpre, int lh, int sc_i, int sh_i, bool st = true, bool x_in = false, bool xf32 = false, bool h8 = false) {
    const float* mod = (const float*)(C.ws + WS_MOD);
    const int gw = C.vcu * NWAVES + C.wave, NGW = C.G * NWAVES;
    for (int grp = gw; grp < T_P / 8 + T_S; grp += NGW) {
        const int row0 = grp < T_P / 8 ? grp * 8 : T_P + (grp - T_P / 8), nr = grp < T_P / 8 ? 8 : 1, bi = bidx_of_row(row0);
        f32x4 s0[4], x0[4], s1[4], x1[4], s2[4], x2[4], s3[4], x3[4];
#define ROW_LD(S, X, j) do { load_bf16_row(src + (size_t)(row0 + (j)) * DM, C.lane, S); if (x_in) load_f32_row(xrow_ptr(C, row0 + (j), true), C.lane, X); else load_bf16_row((const bf16*)(C.out + (size_t)(row0 + (j)) * DM), C.lane, X); } while (0)
        ROW_LD(s0, x0, 0);
        if (nr == 8) { ROW_LD(s1, x1, 1); ROW_LD(s2, x2, 2); ROW_LD(s3, x3, 3); }
        f32x4 gtv[4], gpsc[4], sh[4];
        { f32x4 a[4], bq[4]; load_f32_row(mod + ((size_t)l * NBC + bi) * 6144 + gt_i * DM, C.lane, a); load_f32_row(gpost, C.lane, bq);
#pragma unroll
          for (int j = 0; j < 4; ++j) gtv[j] = a[j] * bq[j];
          const float* mb = mod + ((size_t)lh * NBC + bi) * 6144; load_f32_row(gpre, C.lane, a); load_f32_row(mb + sc_i * DM, C.lane, bq); load_f32_row(mb + sh_i * DM, C.lane, sh);
#pragma unroll
          for (int j = 0; j < 4; ++j) gpsc[j] = a[j] * (1.f + bq[j]); }
        __builtin_amdgcn_sched_barrier(0);
        if (nr == 8) {
            rows_core(C, row0 + 0, s0, x0, gtv, do_h, gpsc, sh, st, xf32, h8); __builtin_amdgcn_sched_barrier(0); ROW_LD(s0, x0, 4); __builtin_amdgcn_sched_barrier(0);
            rows_core(C, row0 + 1, s1, x1, gtv, do_h, gpsc, sh, st, xf32, h8); __builtin_amdgcn_sched_barrier(0); ROW_LD(s1, x1, 5); __builtin_amdgcn_sched_barrier(0);
            rows_core(C, row0 + 2, s2, x2, gtv, do_h, gpsc, sh, st, xf32, h8); __builtin_amdgcn_sched_barrier(0); ROW_LD(s2, x2, 6); __builtin_amdgcn_sched_barrier(0);
            rows_core(C, row0 + 3, s3, x3, gtv, do_h, gpsc, sh, st, xf32, h8); __builtin_amdgcn_sched_barrier(0); ROW_LD(s3, x3, 7); __builtin_amdgcn_sched_barrier(0);
            rows_core(C, row0 + 4, s0, x0, gtv, do_h, gpsc, sh, st, xf32, h8); __builtin_amdgcn_sched_barrier(0);
            rows_core(C, row0 + 5, s1, x1, gtv, do_h, gpsc, sh, st, xf32, h8); __builtin_amdgcn_sched_barrier(0);
            rows_core(C, row0 + 6, s2, x2, gtv, do_h, gpsc, sh, st, xf32, h8); __builtin_amdgcn_sched_barrier(0);
            rows_core(C, row0 + 7, s3, x3, gtv, do_h, gpsc, sh, st, xf32, h8);
        } else rows_core(C, row0, s0, x0, gtv, do_h, gpsc, sh, st, xf32, h8);
#undef ROW_LD
    }
}

typedef __bf16 bf16x2_t __attribute__((ext_vector_type(2)));
typedef float f32x2 __attribute__((ext_vector_type(2)));
__device__ __forceinline__ unsigned pkbf(float a, float b) { f32x2 v = {a, b}; return __builtin_bit_cast(unsigned, __builtin_convertvector(v, bf16x2_t)); }
__device__ __forceinline__ bf16 f2b(float a) { return (bf16)(pkbf(a, 0.f) & 0xffffu); }
#define MFMA32(a, b, c) __builtin_amdgcn_mfma_f32_32x32x16_bf16((a), (b), (c), 0, 0, 0)
__device__ __forceinline__ int crow(int i, int h) { return (i & 3) + 8 * (i >> 2) + 4 * h; }
__device__ __forceinline__ int swap23(int k) { return (k & ~12) | ((k & 4) << 1) | ((k & 8) >> 1); }
template <int S> __device__ __forceinline__ bf16x8 pack_step(const f32x16& x) {
    v4u p; p.x = pkbf(x[8 * S], x[8 * S + 1]); p.y = pkbf(x[8 * S + 2], x[8 * S + 3]); p.z = pkbf(x[8 * S + 4], x[8 * S + 5]); p.w = pkbf(x[8 * S + 6], x[8 * S + 7]);
    return __builtin_bit_cast(bf16x8, p);
}
__device__ __forceinline__ f32x16 zero16() { f32x16 z;
#pragma unroll
    for (int i = 0; i < 16; ++i) z[i] = 0.f; return z; }
__device__ __forceinline__ bf16x8 ldg8(const bf16* p) { return *(const GAS bf16x8*)p; }
constexpr size_t WS_SMALL = 47 * MiB;
constexpr size_t SM_ECUM = 0, SM_ELAST = 2048 * 64 * 4, SM_GDEC = SM_ELAST + 2048 * 4;
constexpr size_t SCR_GDN = WS_SCR, GDN_UNIT = 73728;
constexpr size_t SCR_SSD = WS_SCR + 72 * MiB, SSD_UNIT = 147456;
constexpr size_t WS_SSQ = 465 * MiB;
static_assert(SCR_GDN + (size_t)1024 * GDN_UNIT <= SCR_SSD && SCR_SSD + (size_t)512 * SSD_UNIT <= WS_SSQ && WS_SSQ + (size_t)T_ALL * 8 * 4 <= WS_END, "scratch map");

__device__ __forceinline__ LAS unsigned char* lds_v(const Ctx& C) { unsigned a = (unsigned)(size_t)C.lds; asm volatile("" : "+v"(a)); return (LAS unsigned char*)(size_t)a; }
__device__ __forceinline__ void sample_gla(const Ctx& C_, int l, int b, int h) {
    Ctx C = C_; asm volatile("v_mbcnt_lo_u32_b32 %0, -1, 0\n\tv_mbcnt_hi_u32_b32 %0, -1, %0" : "=v"(C.lane)); C.tid = C.wave * 64 + C.lane;
    LAS float* L = (LAS float*)lds_v(C); LAS float *sq = L, *sk = L + 512, *sv = L + 1024, *sa = L + 1536, *sgr = L + 2048, *red = L + 2560;
    const bf16* U = (const bf16*)(C.ws + WS_U); bf16* YS0 = (bf16*)(C.ws + WS_YS);
    const int r0 = T_P + 4 * b;
    const int kg = C.tid >> 5, vq = C.tid & 31;
    const size_t soff = (((size_t)l * 128 + b) * 4 + h) * 16384 + (size_t)(kg * 8) * 128 + 4 * vq;
    const float* sin = C.in[I_SGLA] + soff; f32x4 S[8];
#pragma unroll
    for (int i = 0; i < 8; ++i) S[i] = *(const GAS f32x4*)(sin + i * 128);
    float gn0 = 0.f, gn1 = 0.f; if (C.wave < 4) { const float* gn = C.in[I_GGLAN] + l * 128; gn0 = gn[C.lane]; gn1 = gn[C.lane + 64]; }
    LBAR();
    { const int t = C.tid >> 7, i = C.tid & 127; const bf16* ur = U + (size_t)(r0 + t) * NU;
      sq[t * 128 + i] = bf2f(ur[C_GQ + h * 128 + i]) * 0.08838834764831845f; sk[t * 128 + i] = bf2f(ur[C_GK + h * 128 + i]); sv[t * 128 + i] = bf2f(ur[C_GV + h * 128 + i]); sgr[t * 128 + i] = bf2f(ur[C_GR + h * 128 + i]);
      float acc = C.in[I_BGG][l * 512 + h * 128 + i]; const float* wg = C.in[I_WGG] + (size_t)l * 16 * 512 + h * 128 + i;
#pragma unroll
      for (int r = 0; r < 16; ++r) acc += bf2f(ur[C_GLR + r]) * wg[r * 512];
      sa[t * 128 + i] = __expf(logsigmoid_f(acc) * 0.0625f); }
    LBAR();
    f32x4 ra[4][2], rk[4][2], rq[4][2], rvv[4];
#pragma unroll
    for (int t = 0; t < 4; ++t) { rvv[t] = *(const LAS f32x4*)(sv + t * 128 + 4 * vq);
#pragma unroll
        for (int q = 0; q < 2; ++q) { ra[t][q] = *(const LAS f32x4*)(sa + t * 128 + kg * 8 + 4 * q); rk[t][q] = *(const LAS f32x4*)(sk + t * 128 + kg * 8 + 4 * q); rq[t][q] = *(const LAS f32x4*)(sq + t * 128 + kg * 8 + 4 * q); } }
#pragma unroll
    for (int t = 0; t < 4; ++t) { f32x4 po = {0.f, 0.f, 0.f, 0.f};
#pragma unroll
        for (int i = 0; i < 8; ++i) { S[i] = S[i] * ra[t][i >> 2][i & 3] + rk[t][i >> 2][i & 3] * rvv[t]; po += rq[t][i >> 2][i & 3] * S[i]; }
        *(LAS f32x4*)(red + (t * 16 + kg) * 128 + 4 * vq) = po; }
    float* sout = C.out + O_SGLA + soff;
#pragma unroll
    for (int i = 0; i < 8; ++i) *(GAS f32x4*)(sout + i * 128) = S[i];
    LBAR();
    if (C.wave < 4) { const int t = C.wave; float o0 = 0.f, o1 = 0.f;
#pragma unroll
        for (int g2 = 0; g2 < 16; ++g2) { o0 += red[(t * 16 + g2) * 128 + C.lane]; o1 += red[(t * 16 + g2) * 128 + C.lane + 64]; }
        const float rstd = rsqrtf(wave_sum(o0 * o0 + o1 * o1) * (1.f / 128.f) + EPS);
        bf16* yr = YS0 + (size_t)(r0 + t) * 512 + h * 128;
        yr[C.lane] = f2b(o0 * rstd * gn0 * silu_f(sgr[t * 128 + C.lane])); yr[C.lane + 64] = f2b(o1 * rstd * gn1 * silu_f(sgr[t * 128 + C.lane + 64])); }
}
__device__ __forceinline__ void sample_ssd(const Ctx& C_, int l, int b, int g) {
    Ctx C = C_; asm volatile("v_mbcnt_lo_u32_b32 %0, -1, 0\n\tv_mbcnt_hi_u32_b32 %0, -1, %0" : "=v"(C.lane)); C.tid = C.wave * 64 + C.lane;
    LAS float* L = (LAS float*)lds_v(C); LAS float *xin = L, *cx = L + 3584, *dts = L + 5632, *dAs = L + 5648, *ysr = L + 5664;
    const bf16* U = (const bf16*)(C.ws + WS_U); bf16* YS1 = (bf16*)(C.ws + WS_YS) + (size_t)T_ALL * 512;
    const int r0 = T_P + 4 * b;
    const int pg = C.tid >> 5, nq = C.tid & 31;
    f32x4 SS[4][4]; float wvh[4], bvh, dtr = 0.f, zz[4] = {0.f, 0.f, 0.f, 0.f};
#pragma unroll
    for (int hh = 0; hh < 4; ++hh) { const float* sin = C.in[I_SSSD] + ((((size_t)l * 128 + b) * 8 + g * 4 + hh) * 64 + pg * 4) * 128 + 4 * nq;
#pragma unroll
        for (int i = 0; i < 4; ++i) SS[hh][i] = *(const GAS f32x4*)(sin + i * 128); }
    { const int c = C.tid; const int ch = c < 256 ? g * 256 + c : (c < 384 ? 512 + g * 128 + (c - 256) : 768 + g * 128 + (c - 384)); bvh = C.in[I_BSC][l * 1024 + ch];
#pragma unroll
      for (int j = 0; j < 4; ++j) wvh[j] = C.in[I_WSC][((size_t)l * 4 + j) * 1024 + ch]; }
    if (C.tid < 16) dtr = bf2f(U[(size_t)(r0 + (C.tid >> 2)) * NU + C_SDT + g * 4 + (C.tid & 3)]);
    if (C.wave < 4) {
#pragma unroll
        for (int j = 0; j < 4; ++j) zz[j] = bf2f(U[(size_t)(r0 + C.wave) * NU + C_SZ + g * 256 + C.lane + 64 * j]); }
    LBAR();
    { const int c = C.tid; const int ch = c < 256 ? g * 256 + c : (c < 384 ? 512 + g * 128 + (c - 256) : 768 + g * 128 + (c - 384));
      float xr[7];
#pragma unroll
      for (int j = 0; j < 3; ++j) xr[j] = C.in[I_CSSD][(((size_t)l * 128 + b) * 3 + j) * 1024 + ch];
#pragma unroll
      for (int j = 0; j < 4; ++j) xr[3 + j] = bf2f(U[(size_t)(r0 + j) * NU + C_SXBC + ch]);
#pragma unroll
      for (int j = 0; j < 7; ++j) xin[j * 512 + c] = xr[j];
#pragma unroll
      for (int j = 4; j < 7; ++j) C.out[O_SCS + (((size_t)l * 128 + b) * 3 + (j - 4)) * 1024 + ch] = xr[j]; }
    if (C.tid < 16) { const int hd = g * 4 + (C.tid & 3); const float dt = softplus_f(dtr + C.in[I_SDTB][l * 8 + hd]);
        dts[C.tid] = dt; dAs[C.tid] = __expf(-dt * __expf(C.in[I_SALOG][l * 8 + hd])); }
    LBAR();
    { const int c = C.tid; const int ch = c < 256 ? g * 256 + c : (c < 384 ? 512 + g * 128 + (c - 256) : 768 + g * 128 + (c - 384)); float xr[7];
#pragma unroll
      for (int j = 0; j < 7; ++j) xr[j] = xin[j * 512 + c];
#pragma unroll
      for (int t = 0; t < 4; ++t) { float y = bvh;
#pragma unroll
          for (int j = 0; j < 4; ++j) y += xr[t + j] * wvh[j];
          cx[t * 512 + c] = silu_f(y); } }
    LBAR();
#pragma unroll
    for (int hh = 0; hh < 4; ++hh) { const int hd = g * 4 + hh; const float Dv = C.in[I_SD][l * 8 + hd];
        const size_t soff = ((((size_t)l * 128 + b) * 8 + hd) * 64 + pg * 4) * 128 + 4 * nq; f32x4 (&S)[4] = SS[hh];
#pragma unroll
        for (int t = 0; t < 4; ++t) { const float dA = dAs[t * 4 + hh], dt = dts[t * 4 + hh]; const f32x4 B4 = *(const LAS f32x4*)(cx + t * 512 + 256 + 4 * nq), C4 = *(const LAS f32x4*)(cx + t * 512 + 384 + 4 * nq);
#pragma unroll
            for (int i = 0; i < 4; ++i) { const float xv = cx[t * 512 + hh * 64 + pg * 4 + i]; S[i] = S[i] * dA + (dt * xv) * B4;
                float y = (S[i][0] * C4[0] + S[i][1] * C4[1]) + (S[i][2] * C4[2] + S[i][3] * C4[3]);
                y += SWZ_XOR(y, 1); y += SWZ_XOR(y, 2); y += SWZ_XOR(y, 4); y += SWZ_XOR(y, 8); y += SWZ_XOR(y, 16);
                if (nq == 0) ysr[t * 256 + hh * 64 + pg * 4 + i] = y + Dv * xv; } }
        float* sout = C.out + O_SSSD + soff;
#pragma unroll
        for (int i = 0; i < 4; ++i) *(GAS f32x4*)(sout + i * 128) = S[i]; }
    LBAR();
    if (C.wave < 4) { const int t = C.wave; bf16* yr = YS1 + (size_t)(r0 + t) * 512 + g * 256; float* SSQ = (float*)(C.ws + WS_SSQ);
#pragma unroll
        for (int j = 0; j < 4; ++j) { const int c = C.lane + 64 * j; const float v = ysr[t * 256 + c] * silu_f(zz[j]);
            yr[c] = f2b(v); const float s2 = wave_sum(v * v); if (C.lane == 0) SSQ[(size_t)(r0 + t) * 8 + g * 4 + j] = s2; } }
}
__device__ __forceinline__ void sample_gdn(const Ctx& C_, int l, int b, int h) {
    Ctx C = C_; asm volatile("v_mbcnt_lo_u32_b32 %0, -1, 0\n\tv_mbcnt_hi_u32_b32 %0, -1, %0" : "=v"(C.lane)); C.tid = C.wave * 64 + C.lane;
    LAS float* L = (LAS float*)lds_v(C);
    LAS float *xin = L, *cq = L + 2688, *ck = L + 3200, *cv = L + 3712, *sc = L + 4224;
    LAS float *gg = sc, *be = sc + 4, *cum = sc + 8, *kk = sc + 16, *qk = sc + 32;
    LAS float *Uv = L + 4288, *Wk = L + 4800, *qe = L + 5312, *ke = L + 5824, *vn = L + 6336, *ob = L + 6848, *red = L + 7360;
    const bf16* U = (const bf16*)(C.ws + WS_U); bf16* YS2 = (bf16*)(C.ws + WS_YS) + (size_t)2 * T_ALL * 512;
    const int r0 = T_P + 4 * b;
    const int kg = C.tid >> 5, vq = C.tid & 31;
    const size_t soff = (((size_t)l * 128 + b) * 4 + h) * 16384 + (size_t)(kg * 8) * 128 + 4 * vq;
    const float* sin = C.in[I_SGDN] + soff; f32x4 S[8];
#pragma unroll
    for (int i = 0; i < 8; ++i) S[i] = *(const GAS f32x4*)(sin + i * 128);
    float dav = 0.f, dbv = 0.f, gn0 = 0.f, gn1 = 0.f, dg0 = 0.f, dg1 = 0.f;
    if (C.tid < 4) { dav = bf2f(U[(size_t)(r0 + C.tid) * NU + C_DA + h]); dbv = bf2f(U[(size_t)(r0 + C.tid) * NU + C_DB + h]); }
    if (C.wave < 4) { const float* gn = C.in[I_GGDNN] + l * 128; const bf16* ur = U + (size_t)(r0 + C.wave) * NU + C_DG + h * 128; gn0 = gn[C.lane]; gn1 = gn[C.lane + 64]; dg0 = bf2f(ur[C.lane]); dg1 = bf2f(ur[C.lane + 64]); }
    LBAR();
    float xr[7], wv[4];
    const int cch = C.tid < 384 ? C.tid : 0, gch = (cch >> 7) * 512 + h * 128 + (cch & 127);
    if (C.tid < 384) {
#pragma unroll
        for (int j = 0; j < 3; ++j) xr[j] = C.in[I_CGDN][(((size_t)l * 128 + b) * 3 + j) * 1536 + gch];
#pragma unroll
        for (int j = 0; j < 4; ++j) { xr[3 + j] = bf2f(U[(size_t)(r0 + j) * NU + C_DQKV + gch]); wv[j] = C.in[I_WGC][((size_t)l * 4 + j) * 1536 + gch]; }
#pragma unroll
        for (int j = 4; j < 7; ++j) C.out[O_SCD + (((size_t)l * 128 + b) * 3 + (j - 4)) * 1536 + gch] = xr[j]; }
    if (C.wave == 0) { const float A = __expf(C.in[I_GALOG][l * 4 + h]), db = C.in[I_GDTB][l * 4 + h]; const float g = -A * softplus_f(dav + db);
        const float g0 = __int_as_float(__builtin_amdgcn_readlane(__float_as_int(g), 0)), g1 = __int_as_float(__builtin_amdgcn_readlane(__float_as_int(g), 1)), g2 = __int_as_float(__builtin_amdgcn_readlane(__float_as_int(g), 2));
        if (C.lane < 4) { const float cs = g + (C.lane > 0 ? g0 : 0.f) + (C.lane > 1 ? g1 : 0.f) + (C.lane > 2 ? g2 : 0.f); gg[C.lane] = g; cum[C.lane] = cs; be[C.lane] = sigmoid_f(dbv); } }
    LBAR();
    if (C.tid < 384) { const int w = cch >> 7, d = cch & 127;
#pragma unroll
        for (int t = 0; t < 4; ++t) { float y = 0.f;
#pragma unroll
            for (int j = 0; j < 4; ++j) y += xr[t + j] * wv[j];
            (w == 0 ? cq : (w == 1 ? ck : cv))[t * 128 + d] = silu_f(y); } }
    LBAR();
    { LAS float* vec = (C.wave < 4 ? cq : ck) + (C.wave & 3) * 128; const float a0 = vec[C.lane], a1 = vec[C.lane + 64];
      const float inv = rsqrtf(wave_sum(a0 * a0 + a1 * a1) + EPS) * (C.wave < 4 ? 0.08838834764831845f : 1.f); vec[C.lane] = a0 * inv; vec[C.lane + 64] = a1 * inv; }
    LBAR();
#pragma unroll
    for (int i = 0; i < 4; ++i) { const int d = C.wave * 4 + i, t = (d >> 2) & 3, s = d & 3; const LAS float* a = (d < 16 ? ck : cq) + t * 128; const LAS float* bb = ck + s * 128;
        const float v = wave_sum(a[C.lane] * bb[C.lane] + a[C.lane + 64] * bb[C.lane + 64]); if (C.lane == 0) (d < 16 ? kk : qk)[t * 4 + s] = v; }
    LBAR();
    { const int w = C.tid >> 7, i = C.tid & 127;
      if (w == 0) { float u[4];
#pragma unroll
          for (int t = 0; t < 4; ++t) { float x = cv[t * 128 + i] * be[t];
#pragma unroll
              for (int s = 0; s < 4; ++s) if (s < t) x -= be[t] * be[s] * kk[t * 4 + s] * __expf(cum[t] - cum[s]) * u[s];
              u[t] = x; Uv[t * 128 + i] = x; } }
      else if (w == 1) { float u[4];
#pragma unroll
          for (int t = 0; t < 4; ++t) { float x = ck[t * 128 + i] * be[t] * __expf(cum[t]);
#pragma unroll
              for (int s = 0; s < 4; ++s) if (s < t) x -= be[t] * be[s] * kk[t * 4 + s] * __expf(cum[t] - cum[s]) * u[s];
              u[t] = x; Wk[t * 128 + i] = x; } }
      else if (w == 2) {
#pragma unroll
          for (int t = 0; t < 4; ++t) qe[t * 128 + i] = cq[t * 128 + i] * __expf(cum[t]); }
      else {
#pragma unroll
          for (int t = 0; t < 4; ++t) ke[t * 128 + i] = ck[t * 128 + i] * __expf(cum[3] - cum[t]); } }
    LBAR();
    { f32x4 av[8][2];
#pragma unroll
      for (int vec = 0; vec < 8; ++vec) { const LAS float* a = (vec < 4 ? Wk : qe) + (vec & 3) * 128 + kg * 8; av[vec][0] = *(const LAS f32x4*)a; av[vec][1] = *(const LAS f32x4*)(a + 4); }
#pragma unroll
      for (int vec = 0; vec < 8; ++vec) { f32x4 po = {0.f, 0.f, 0.f, 0.f};
#pragma unroll
          for (int i = 0; i < 8; ++i) po += av[vec][i >> 2][i & 3] * S[i];
          *(LAS f32x4*)(red + (vec * 16 + kg) * 128 + 4 * vq) = po; } }
    LBAR();
    float qs = 0.f; { const int t = C.tid >> 7, v = C.tid & 127; float ws = 0.f;
#pragma unroll
        for (int g2 = 0; g2 < 16; ++g2) { ws += red[(t * 16 + g2) * 128 + v]; qs += red[((4 + t) * 16 + g2) * 128 + v]; }
        vn[t * 128 + v] = Uv[t * 128 + v] - ws; }
    LBAR();
    { const int t = C.tid >> 7, v = C.tid & 127; float o = qs;
#pragma unroll
        for (int s = 0; s < 4; ++s) if (s <= t) o += qk[t * 4 + s] * __expf(cum[t] - cum[s]) * vn[s * 128 + v];
        ob[t * 128 + v] = o; }
    { const float dl = __expf(cum[3]);
      f32x4 kq[4][2], vq4[4];
#pragma unroll
      for (int s = 0; s < 4; ++s) { kq[s][0] = *(const LAS f32x4*)(ke + s * 128 + kg * 8); kq[s][1] = *(const LAS f32x4*)(ke + s * 128 + kg * 8 + 4); vq4[s] = *(const LAS f32x4*)(vn + s * 128 + 4 * vq); }
#pragma unroll
      for (int i = 0; i < 8; ++i) { S[i] = S[i] * dl;
#pragma unroll
          for (int s = 0; s < 4; ++s) S[i] += kq[s][i >> 2][i & 3] * vq4[s]; }
      float* sout = C.out + O_SGDN + soff;
#pragma unroll
      for (int i = 0; i < 8; ++i) *(GAS f32x4*)(sout + i * 128) = S[i]; }
    LBAR();
    if (C.wave < 4) { const int t = C.wave; const float o0 = ob[t * 128 + C.lane], o1 = ob[t * 128 + C.lane + 64];
        const float rstd = rsqrtf(wave_sum(o0 * o0 + o1 * o1) * (1.f / 128.f) + EPS);
        bf16* yr = YS2 + (size_t)(r0 + t) * 512 + h * 128;
        yr[C.lane] = f2b(o0 * rstd * gn0 * silu_f(dg0)); yr[C.lane + 64] = f2b(o1 * rstd * gn1 * silu_f(dg1)); }
}
constexpr int LDK = 136, LDC = 72;
__device__ __forceinline__ void m1_gla(const Ctx& C_, int l, int b, int c, int h, bool st) {
    Ctx C = C_; asm volatile("v_mbcnt_lo_u32_b32 %0, -1, 0\n\tv_mbcnt_hi_u32_b32 %0, -1, %0" : "=v"(C.lane)); C.tid = C.wave * 64 + C.lane;
    LAS unsigned char* lds = lds_v(C);
    LAS float* fL = (LAS float*)lds;
    LAS bf16* sQD = (LAS bf16*)(lds + 32768); LAS bf16* sKD = (LAS bf16*)(lds + 32768 + 64 * LDK * 2);
    LAS float* segs = (LAS float*)(lds + 32768 + 2 * 64 * LDK * 2); LAS float* sWg = segs + 512; LAS float* sBg = sWg + 2048;
    LAS bf16* oKL = (LAS bf16*)(lds + 81920); LAS bf16* oVT = (LAS bf16*)(lds + 100352); LAS bf16* oA = (LAS bf16*)(lds + 118784);
    bf16* U = (bf16*)(C.ws + WS_U); bf16* YS0 = (bf16*)(C.ws + WS_YS);
    const int t0 = b * SEQ + c * CH, t = C.tid >> 3, cg = C.tid & 7, k0 = cg * 16;
    float wg4[4], bg1 = 0.f;
#pragma unroll
    for (int i = 0; i < 4; ++i) { const int idx = C.tid + i * NTHR; wg4[i] = C.in[I_WGG][(size_t)l * 16 * 512 + (idx >> 7) * 512 + h * 128 + (idx & 127)]; }
    if (C.tid < 128) bg1 = C.in[I_BGG][l * 512 + h * 128 + C.tid];
    bf16* urow = U + (size_t)(t0 + t) * NU;
    const v4u ga = *(const GAS v4u*)(urow + C_GLR), gb = *(const GAS v4u*)(urow + C_GLR + 8);
    v4u rq[2], rk[2], rv[2], rg[2];
#pragma unroll
    for (int i = 0; i < 2; ++i) { rq[i] = *(const GAS v4u*)(urow + C_GQ + h * 128 + k0 + 8 * i); rk[i] = *(const GAS v4u*)(urow + C_GK + h * 128 + k0 + 8 * i);
        rv[i] = *(const GAS v4u*)(urow + C_GV + h * 128 + k0 + 8 * i); rg[i] = *(const GAS v4u*)(urow + C_GR + h * 128 + k0 + 8 * i); }
    __builtin_amdgcn_sched_barrier(0);
    LBAR();
    float glr[16];
#pragma unroll
    for (int i = 0; i < 4; ++i) { glr[2 * i] = blo(ga[i]); glr[2 * i + 1] = bhi(ga[i]); glr[8 + 2 * i] = blo(gb[i]); glr[8 + 2 * i + 1] = bhi(gb[i]); }
#pragma unroll
    for (int i = 0; i < 4; ++i) sWg[C.tid + i * NTHR] = wg4[i];
    if (C.tid < 128) sBg[C.tid] = bg1;
    VM_WAIT();
    __syncthreads();
    { float la[16]; f32x4 wq[3][4];
#pragma unroll
      for (int q = 0; q < 4; ++q) { const f32x4 bq = *(const LAS f32x4*)(sBg + k0 + 4 * q); la[4 * q] = bq[0]; la[4 * q + 1] = bq[1]; la[4 * q + 2] = bq[2]; la[4 * q + 3] = bq[3];
          wq[0][q] = *(const LAS f32x4*)(sWg + k0 + 4 * q); wq[1][q] = *(const LAS f32x4*)(sWg + 128 + k0 + 4 * q); }
#pragma unroll
      for (int r = 0; r < 16; ++r) {
          if (r + 2 < 16) {
#pragma unroll
              for (int q = 0; q < 4; ++q) wq[(r + 2) % 3][q] = *(const LAS f32x4*)(sWg + (r + 2) * 128 + k0 + 4 * q); }
          __builtin_amdgcn_sched_barrier(0);
#pragma unroll
          for (int j = 0; j < 16; ++j) la[j] += glr[r] * wq[r % 3][j >> 2][j & 3];
          __builtin_amdgcn_sched_barrier(0); }
#pragma unroll
      for (int j = 0; j < 16; ++j) la[j] = logsigmoid_f(la[j]) * 0.0625f;
#pragma unroll
      for (int j = 0; j < 4; ++j) *(LAS f32x4*)(fL + t * 128 + k0 + 4 * j) = (f32x4){la[4 * j], la[4 * j + 1], la[4 * j + 2], la[4 * j + 3]}; }
    LBAR();
    { const int seg = C.tid >> 7, k = C.tid & 127; float pre[16], s = 0.f;
#pragma unroll
      for (int i = 0; i < 16; ++i) { s += fL[(seg * 16 + i) * 128 + k]; pre[i] = s; }
      segs[seg * 128 + k] = s;
      LBAR();
      const float s0 = segs[k], s1 = segs[128 + k], s2 = segs[256 + k]; const float run = ((seg > 0 ? s0 : 0.f) + (seg > 1 ? s1 : 0.f)) + (seg > 2 ? s2 : 0.f);
#pragma unroll
      for (int i = 0; i < 16; ++i) fL[(seg * 16 + i) * 128 + k] = run + pre[i]; }
    LBAR();
    { float qd[16], kl[16], kd[16]; const float* gn = C.in[I_GGLAN] + l * 128; float ggv[16];
#pragma unroll
      for (int j = 0; j < 16; ++j) { const float bb = fL[t * 128 + k0 + j], bl = fL[63 * 128 + k0 + j];
          const unsigned wq = rq[j >> 3][(j >> 1) & 3], wk = rk[j >> 3][(j >> 1) & 3], wg = rg[j >> 3][(j >> 1) & 3];
          const float qv = (j & 1) ? bhi(wq) : blo(wq), kv = (j & 1) ? bhi(wk) : blo(wk), gv = (j & 1) ? bhi(wg) : blo(wg);
          qd[j] = qv * 0.08838834764831845f * __expf(bb); kd[j] = kv * __expf(-bb); kl[j] = kv * __expf(bl - bb); ggv[j] = gn[k0 + j] * silu_f(gv); }
      v4u w0, w1;
      w0.x = pkbf(qd[0], qd[1]); w0.y = pkbf(qd[2], qd[3]); w0.z = pkbf(qd[4], qd[5]); w0.w = pkbf(qd[6], qd[7]); w1.x = pkbf(qd[8], qd[9]); w1.y = pkbf(qd[10], qd[11]); w1.z = pkbf(qd[12], qd[13]); w1.w = pkbf(qd[14], qd[15]);
      *(LAS v4u*)(sQD + t * LDK + k0) = w0; *(LAS v4u*)(sQD + t * LDK + k0 + 8) = w1;
      { v4u g0, g1; g0.x = w0.x; g0.y = w0.y; g0.z = w1.x; g0.w = w1.y; g1.x = w0.z; g1.y = w0.w; g1.z = w1.z; g1.w = w1.w;
        if (st) { *(GAS v4u*)(urow + C_GQ + h * 128 + k0) = g0; *(GAS v4u*)(urow + C_GQ + h * 128 + k0 + 8) = g1; } }
      w0.x = pkbf(kd[0], kd[1]); w0.y = pkbf(kd[2], kd[3]); w0.z = pkbf(kd[4], kd[5]); w0.w = pkbf(kd[6], kd[7]); w1.x = pkbf(kd[8], kd[9]); w1.y = pkbf(kd[10], kd[11]); w1.z = pkbf(kd[12], kd[13]); w1.w = pkbf(kd[14], kd[15]);
      *(LAS v4u*)(sKD + t * LDK + k0) = w0; *(LAS v4u*)(sKD + t * LDK + k0 + 8) = w1;
#pragma unroll
      for (int j = 0; j < 16; ++j) { const int k = k0 + j, tsw = t ^ (cg << 3); oKL[k * LDC + tsw] = f2b(kl[j]);
          const unsigned wv = rv[j >> 3][(j >> 1) & 3]; oVT[k * LDC + tsw] = (bf16)((j & 1) ? (wv >> 16) : (wv & 0xffffu)); }
      v4u y0, y1; y0.x = pkbf(ggv[0], ggv[1]); y0.y = pkbf(ggv[2], ggv[3]); y0.z = pkbf(ggv[4], ggv[5]); y0.w = pkbf(ggv[6], ggv[7]); y1.x = pkbf(ggv[8], ggv[9]); y1.y = pkbf(ggv[10], ggv[11]); y1.z = pkbf(ggv[12], ggv[13]); y1.w = pkbf(ggv[14], ggv[15]);
      bf16* yr = YS0 + (size_t)(t0 + t) * 512 + h * 128 + k0; if (st) { *(GAS v4u*)yr = y0; *(GAS v4u*)(yr + 8) = y1; } }
    if (C.tid < 128 && st) { const int k = C.tid; ((float*)(U + (size_t)(t0 + (k >> 5)) * NU + C_GR + h * 128 + 64))[k & 31] = __expf(fL[63 * 128 + k]); }
    LBAR();
    if (C.wave < 4) { const int tt = C.wave & 1, st = C.wave >> 1, r = C.lane & 31, hl = C.lane >> 5; f32x16 acc = zero16();
        if (st <= tt) {
#pragma unroll
            for (int ks = 0; ks < 8; ++ks) { const bf16x8 a = *(const LAS bf16x8*)(sQD + (32 * tt + r) * LDK + 16 * ks + 8 * hl), bb = *(const LAS bf16x8*)(sKD + (32 * st + r) * LDK + 16 * ks + 8 * hl); acc = MFMA32(a, bb, acc); } }
#pragma unroll
        for (int i = 0; i < 16; ++i) { const int tr = 32 * tt + crow(i, hl), s = 32 * st + r; oA[tr * LDC + s] = f2b(s <= tr ? acc[i] : 0.f); } }
    LBAR();
    if (st)
#pragma unroll
    for (int it = 0; it < 5; ++it) { const int idx = it * NTHR + C.tid;
        if (it < 2) { const int k = idx >> 3, c8 = idx & 7; *(GAS v4u*)(U + (size_t)(t0 + (k >> 1)) * NU + C_GK + h * 128 + (k & 1) * 64 + c8 * 8) = *(const LAS v4u*)(oKL + k * LDC + ((c8 ^ (k >> 4)) & 7) * 8); }
        else if (it < 4) { const int q = idx - 1024, k = q >> 3, c8 = q & 7; *(GAS v4u*)(U + (size_t)(t0 + (k >> 1)) * NU + C_GV + h * 128 + (k & 1) * 64 + c8 * 8) = *(const LAS v4u*)(oVT + k * LDC + ((c8 ^ (k >> 4)) & 7) * 8); }
        else { const int q = idx - 2048, tr = q >> 3, c8 = q & 7; *(GAS v4u*)(U + (size_t)(t0 + tr) * NU + C_GR + h * 128 + c8 * 8) = *(const LAS v4u*)(oA + tr * LDC + c8 * 8); } }
}
template <int I> struct InvRowH {
    static __device__ __forceinline__ void run(float (&x)[32], f32x4 (&cur)[8], f32x4 (&nxt)[8], const LAS float* sAb, LAS bf16* sXw, int col, bool keep) {
        if constexpr (I < 31) {
#pragma unroll
            for (int j4 = 0; j4 < (I + 4) / 4; ++j4) nxt[j4] = *(const LAS f32x4*)(sAb + (I + 1) * 64 + 4 * j4); }
        __builtin_amdgcn_sched_barrier(0);
        float a0 = (I == col) ? 1.f : 0.f, a1 = 0.f, a2 = 0.f, a3 = 0.f;
#pragma unroll
        for (int j4 = 0; j4 < (I + 3) / 4; ++j4) { const f32x4 av = cur[j4];
            if (4 * j4 + 0 < I) a0 -= av[0] * x[4 * j4 + 0]; if (4 * j4 + 1 < I) a1 -= av[1] * x[4 * j4 + 1]; if (4 * j4 + 2 < I) a2 -= av[2] * x[4 * j4 + 2]; if (4 * j4 + 3 < I) a3 -= av[3] * x[4 * j4 + 3]; }
        x[I] = (a0 + a1) + (a2 + a3); sXw[I * LDC] = f2b(keep ? x[I] : 0.f);
        __builtin_amdgcn_sched_barrier(0);
        if constexpr (I < 31) InvRowH<I + 1>::run(x, nxt, cur, sAb, sXw, col, keep);
    }
};
__device__ __forceinline__ void m1_gdn(const Ctx& C_, int l, int b, int c, int h) {
    Ctx C = C_; asm volatile("v_mbcnt_lo_u32_b32 %0, -1, 0\n\tv_mbcnt_hi_u32_b32 %0, -1, %0" : "=v"(C.lane)); C.tid = C.wave * 64 + C.lane;
    LAS unsigned char* lds = lds_v(C);
    LAS float* sA = (LAS float*)lds;
    LAS bf16* sX = (LAS bf16*)(lds + 16384);
    LAS float* sG = (LAS float*)(lds + 25600); LAS float *sCum = sG + 64, *sBe = sG + 128;
    LAS bf16* sK = (LAS bf16*)(lds + 26624); LAS bf16* sQ = sK + 64 * LDK;
    LAS bf16* sVT = (LAS bf16*)(lds + 61440); LAS bf16* sKT = sVT + 128 * LDC;
    LAS bf16* oKeT = (LAS bf16*)(lds + 98304); LAS bf16* oW = (LAS bf16*)(lds + 116736); LAS bf16* oAqk = (LAS bf16*)(lds + 134144);
    const bf16* U = (const bf16*)(C.ws + WS_U); bf16* YS2 = (bf16*)(C.ws + WS_YS) + (size_t)2 * T_ALL * 512;
    unsigned char* scr = C.ws + SCR_GDN + (size_t)((b * NCH + c) * 4 + h) * GDN_UNIT;
    bf16* gW = (bf16*)scr; bf16* gQe = (bf16*)(scr + 16384); bf16* gKeT = (bf16*)(scr + 32768); bf16* gUT = (bf16*)(scr + 49152); bf16* gAqk = (bf16*)(scr + 65536);
    const int t0 = b * SEQ + c * CH, t = C.tid >> 3, cg = C.tid & 7, d0 = cg * 16, w8 = C.wave * 8;
    float dar = 0.f, dbr = 0.f;
    if (C.tid < 64) { const bf16* ur = U + (size_t)(t0 + C.tid) * NU; dar = bf2f(ur[C_DA + h]); dbr = bf2f(ur[C_DB + h]); }
    float q0[8], q1[8], k0[8], k1[8], v0[8], v1[8]; v4u dg0, dg1;
    {   unsigned uq[11], uk[11], uv[11]; f32x2 wq[4], wk[4], wv[4];
#pragma unroll
        for (int i = 0; i < 11; ++i) { const int tr = c * CH + w8 - 3 + i; const bf16* ur = U + (size_t)(b * SEQ + (tr >= 0 ? tr : 0)) * NU + C_DQKV + h * 128;
            uq[i] = *(const GAS unsigned*)(ur + 2 * C.lane); uk[i] = *(const GAS unsigned*)(ur + 512 + 2 * C.lane); uv[i] = *(const GAS unsigned*)(ur + 1024 + 2 * C.lane); }
#pragma unroll
        for (int tap = 0; tap < 4; ++tap) { const float* w = C.in[I_WGC] + ((size_t)l * 4 + tap) * 1536 + h * 128;
            wq[tap] = *(const GAS f32x2*)(w + 2 * C.lane); wk[tap] = *(const GAS f32x2*)(w + 512 + 2 * C.lane); wv[tap] = *(const GAS f32x2*)(w + 1024 + 2 * C.lane); }
        { const bf16* ur = U + (size_t)(t0 + t) * NU + C_DG + h * 128 + d0; dg0 = *(const GAS v4u*)ur; dg1 = *(const GAS v4u*)(ur + 8); }
        __builtin_amdgcn_sched_barrier(0);
        LBAR();
#pragma unroll
        for (int i = 0; i < 3; ++i) if (c * CH + w8 - 3 + i < 0) { uq[i] = 0u; uk[i] = 0u; uv[i] = 0u; }
        float r[16];
#pragma unroll
        for (int i = 0; i < 8; ++i) { float a0 = 0.f, a1 = 0.f, b0 = 0.f, b1 = 0.f, c0 = 0.f, c1 = 0.f;
#pragma unroll
            for (int tap = 0; tap < 4; ++tap) { a0 += blo(uq[i + tap]) * wq[tap][0]; a1 += bhi(uq[i + tap]) * wq[tap][1]; b0 += blo(uk[i + tap]) * wk[tap][0]; b1 += bhi(uk[i + tap]) * wk[tap][1];
                c0 += blo(uv[i + tap]) * wv[tap][0]; c1 += bhi(uv[i + tap]) * wv[tap][1]; }
            q0[i] = silu_f(a0); q1[i] = silu_f(a1); k0[i] = silu_f(b0); k1[i] = silu_f(b1); v0[i] = silu_f(c0); v1[i] = silu_f(c1);
            r[i] = q0[i] * q0[i] + q1[i] * q1[i]; r[8 + i] = k0[i] * k0[i] + k1[i] * k1[i]; }
#define GDN_HALVE(SH, N) do { const bool hi_ = (C.lane & (SH)) != 0; _Pragma("unroll") for (int j = 0; j < (N) / 2; ++j) { const float send_ = hi_ ? r[j] : r[j + (N) / 2]; const float keep_ = hi_ ? r[j + (N) / 2] : r[j]; r[j] = keep_ + SWZ_XOR(send_, SH); } } while (0)
        GDN_HALVE(16, 16); GDN_HALVE(8, 8); GDN_HALVE(4, 4); GDN_HALVE(2, 2);
#undef GDN_HALVE
        r[0] += SWZ_XOR(r[0], 1);
#pragma unroll
        for (int i = 0; i < 8; ++i) {
            const float sq = __int_as_float(__builtin_amdgcn_readlane(__float_as_int(r[0]), 2 * i)) + __int_as_float(__builtin_amdgcn_readlane(__float_as_int(r[0]), 2 * i + 32));
            const float sk = __int_as_float(__builtin_amdgcn_readlane(__float_as_int(r[0]), 2 * (8 + i))) + __int_as_float(__builtin_amdgcn_readlane(__float_as_int(r[0]), 2 * (8 + i) + 32));
            const float iq = rsqrtf(sq + EPS) * 0.08838834764831845f, ik = rsqrtf(sk + EPS);
            q0[i] *= iq; q1[i] *= iq; k0[i] *= ik; k1[i] *= ik; } }
    if (C.tid < 64) { const int tt = C.tid; const float A = __expf(C.in[I_GALOG][l * 4 + h]);
        const float g = -A * softplus_f(dar + C.in[I_GDTB][l * 4 + h]); const float cs = wave_incl_scan(sG + 192, g, tt);
        sG[tt] = g; sCum[tt] = cs; sBe[tt] = sigmoid_f(dbr); }
#pragma unroll
    for (int i = 0; i < 8; ++i) { *(LAS unsigned*)(sK + (w8 + i) * LDK + 2 * C.lane) = pkbf(k0[i], k1[i]); *(LAS unsigned*)(sQ + (w8 + i) * LDK + 2 * C.lane) = pkbf(q0[i], q1[i]); }
    LBAR();
    {
        const f32x4 cA = *(const LAS f32x4*)(sCum + w8), cB = *(const LAS f32x4*)(sCum + w8 + 4), bA = *(const LAS f32x4*)(sBe + w8), bB = *(const LAS f32x4*)(sBe + w8 + 4); const float cl = sCum[63];
        float eq[8], ekl[8], bt[8], ekb[8];
#pragma unroll
        for (int i = 0; i < 8; ++i) { const float ct = i < 4 ? cA[i & 3] : cB[i & 3]; bt[i] = i < 4 ? bA[i & 3] : bB[i & 3]; eq[i] = __expf(ct); ekl[i] = __expf(cl - ct); ekb[i] = bt[i] * eq[i]; }
#pragma unroll
        for (int i = 0; i < 8; ++i) *(GAS unsigned*)(gQe + (w8 + i) * 128 + swap23(2 * C.lane)) = pkbf(q0[i] * eq[i], q1[i] * eq[i]);
        const int tb = 16 * (C.wave >> 1) + 4 * (C.wave & 1);
        { v2u a; a.x = pkbf(k0[0] * ekl[0], k0[1] * ekl[1]); a.y = pkbf(k0[2] * ekl[2], k0[3] * ekl[3]); *(LAS v2u*)(oKeT + (2 * C.lane) * LDC + tb) = a;
          a.x = pkbf(k0[4] * ekl[4], k0[5] * ekl[5]); a.y = pkbf(k0[6] * ekl[6], k0[7] * ekl[7]); *(LAS v2u*)(oKeT + (2 * C.lane) * LDC + tb + 8) = a;
          a.x = pkbf(k1[0] * ekl[0], k1[1] * ekl[1]); a.y = pkbf(k1[2] * ekl[2], k1[3] * ekl[3]); *(LAS v2u*)(oKeT + (2 * C.lane + 1) * LDC + tb) = a;
          a.x = pkbf(k1[4] * ekl[4], k1[5] * ekl[5]); a.y = pkbf(k1[6] * ekl[6], k1[7] * ekl[7]); *(LAS v2u*)(oKeT + (2 * C.lane + 1) * LDC + tb + 8) = a; }
        { v4u o; o.x = pkbf(v0[0] * bt[0], v0[1] * bt[1]); o.y = pkbf(v0[2] * bt[2], v0[3] * bt[3]); o.z = pkbf(v0[4] * bt[4], v0[5] * bt[5]); o.w = pkbf(v0[6] * bt[6], v0[7] * bt[7]); *(LAS v4u*)(sVT + (2 * C.lane) * LDC + w8) = o;
          o.x = pkbf(v1[0] * bt[0], v1[1] * bt[1]); o.y = pkbf(v1[2] * bt[2], v1[3] * bt[3]); o.z = pkbf(v1[4] * bt[4], v1[5] * bt[5]); o.w = pkbf(v1[6] * bt[6], v1[7] * bt[7]); *(LAS v4u*)(sVT + (2 * C.lane + 1) * LDC + w8) = o;
          o.x = pkbf(k0[0] * ekb[0], k0[1] * ekb[1]); o.y = pkbf(k0[2] * ekb[2], k0[3] * ekb[3]); o.z = pkbf(k0[4] * ekb[4], k0[5] * ekb[5]); o.w = pkbf(k0[6] * ekb[6], k0[7] * ekb[7]); *(LAS v4u*)(sKT + (2 * C.lane) * LDC + w8) = o;
          o.x = pkbf(k1[0] * ekb[0], k1[1] * ekb[1]); o.y = pkbf(k1[2] * ekb[2], k1[3] * ekb[3]); o.z = pkbf(k1[4] * ekb[4], k1[5] * ekb[5]); o.w = pkbf(k1[6] * ekb[6], k1[7] * ekb[7]); *(LAS v4u*)(sKT + (2 * C.lane + 1) * LDC + w8) = o; }
        const float* gn = C.in[I_GGDNN] + l * 128; const v4u a = dg0, bq = dg1; float gg[16];
#pragma unroll
        for (int i = 0; i < 4; ++i) { gg[2 * i] = gn[d0 + 2 * i] * silu_f(blo(a[i])); gg[2 * i + 1] = gn[d0 + 2 * i + 1] * silu_f(bhi(a[i])); gg[8 + 2 * i] = gn[d0 + 8 + 2 * i] * silu_f(blo(bq[i])); gg[8 + 2 * i + 1] = gn[d0 + 8 + 2 * i + 1] * silu_f(bhi(bq[i])); }
        v4u y0, y1; y0.x = pkbf(gg[0], gg[1]); y0.y = pkbf(gg[2], gg[3]); y0.z = pkbf(gg[4], gg[5]); y0.w = pkbf(gg[6], gg[7]); y1.x = pkbf(gg[8], gg[9]); y1.y = pkbf(gg[10], gg[11]); y1.z = pkbf(gg[12], gg[13]); y1.w = pkbf(gg[14], gg[15]);
        bf16* yr = YS2 + (size_t)(t0 + t) * 512 + h * 128 + d0; *(GAS v4u*)yr = y0; *(GAS v4u*)(yr + 8) = y1; }
    {
        const int which = C.wave >> 2, tt = C.wave & 1, st = (C.wave >> 1) & 1, r = C.lane & 31, hl = C.lane >> 5; f32x16 acc = zero16();
        if (st <= tt) { const LAS bf16* Am = which ? sQ : sK;
#pragma unroll
            for (int ks = 0; ks < 8; ++ks) { const bf16x8 a = *(const LAS bf16x8*)(Am + (32 * tt + r) * LDK + 16 * ks + 8 * hl), bb = *(const LAS bf16x8*)(sK + (32 * st + r) * LDK + 16 * ks + 8 * hl); acc = MFMA32(a, bb, acc); } }
        const int s = 32 * st + r; const float cs = sCum[s], bs = sBe[s];
#pragma unroll
        for (int i = 0; i < 16; ++i) { const int tr = 32 * tt + crow(i, hl); const float e = __expf(sCum[tr] - cs);
            if (which == 0) sA[tr * 64 + s] = (s < tr) ? acc[i] * e * bs * sBe[tr] : 0.f;
            else oAqk[tr * LDC + swap23(s)] = f2b((s <= tr) ? acc[i] * e : 0.f); } }
    if (C.tid == 0) ((float*)(C.ws + WS_SMALL + SM_GDEC))[(b * NCH + c) * 4 + h] = __expf(sCum[63]);
    LBAR();
    f32x16 Pm = zero16();
    if (C.wave < 2) {
        float x[32]; f32x4 ra[8], rb[8]; const int off = 32 * C.wave, r = C.lane & 31, hl = C.lane >> 5;
        InvRowH<0>::run(x, ra, rb, sA + off * 64 + off, sX + off * LDC + C.lane, r, hl == C.wave);
        if (C.wave == 0) {
#pragma unroll
            for (int s = 0; s < 2; ++s) { const f32x4 al = *(const LAS f32x4*)(sA + (32 + r) * 64 + 16 * s + 8 * hl), ah = *(const LAS f32x4*)(sA + (32 + r) * 64 + 16 * s + 8 * hl + 4);
                v4u av, bv; av.x = pkbf(al[0], al[1]); av.y = pkbf(al[2], al[3]); av.z = pkbf(ah[0], ah[1]); av.w = pkbf(ah[2], ah[3]);
                bv.x = hl ? pkbf(x[16 * s + 8], x[16 * s + 9]) : pkbf(x[16 * s], x[16 * s + 1]); bv.y = hl ? pkbf(x[16 * s + 10], x[16 * s + 11]) : pkbf(x[16 * s + 2], x[16 * s + 3]);
                bv.z = hl ? pkbf(x[16 * s + 12], x[16 * s + 13]) : pkbf(x[16 * s + 4], x[16 * s + 5]); bv.w = hl ? pkbf(x[16 * s + 14], x[16 * s + 15]) : pkbf(x[16 * s + 6], x[16 * s + 7]);
                Pm = MFMA32(__builtin_bit_cast(bf16x8, av), __builtin_bit_cast(bf16x8, bv), Pm); } } }
    LBAR();
    if (C.wave == 0) {
        const int r = C.lane & 31, hl = C.lane >> 5; f32x16 R = zero16();
#pragma unroll
        for (int s = 0; s < 2; ++s) { const v2u a0 = *(const LAS v2u*)(sX + (32 + r) * LDC + 32 + 16 * s + 4 * hl), a1 = *(const LAS v2u*)(sX + (32 + r) * LDC + 32 + 16 * s + 8 + 4 * hl);
            v4u av, bv; av.x = a0.x; av.y = a0.y; av.z = a1.x; av.w = a1.y;
            bv.x = pkbf(Pm[8 * s], Pm[8 * s + 1]); bv.y = pkbf(Pm[8 * s + 2], Pm[8 * s + 3]); bv.z = pkbf(Pm[8 * s + 4], Pm[8 * s + 5]); bv.w = pkbf(Pm[8 * s + 6], Pm[8 * s + 7]);
            R = MFMA32(__builtin_bit_cast(bf16x8, av), __builtin_bit_cast(bf16x8, bv), R); }
#pragma unroll
        for (int i = 0; i < 16; ++i) sX[(32 + crow(i, hl)) * LDC + r] = f2b(-R[i]); }
    LBAR();
    {
        const int which = C.wave >> 2, nt = C.wave & 3, r = C.lane & 31, hl = C.lane >> 5; const LAS bf16* Bm = which ? sKT : sVT; f32x16 acc[2] = {zero16(), zero16()};
#pragma unroll
        for (int ks = 0; ks < 4; ++ks) { const bf16x8 bb = *(const LAS bf16x8*)(Bm + (32 * nt + r) * LDC + 16 * ks + 8 * hl);
#pragma unroll
            for (int tt = 0; tt < 2; ++tt) { const bf16x8 a = *(const LAS bf16x8*)(sX + (32 * tt + r) * LDC + 16 * ks + 8 * hl); acc[tt] = MFMA32(a, bb, acc[tt]); } }
        const int n = 32 * nt + r;
        if (which == 0) {
#pragma unroll
            for (int tt = 0; tt < 2; ++tt) { v4u w0, w1; w0.x = pkbf(acc[tt][0], acc[tt][1]); w0.y = pkbf(acc[tt][2], acc[tt][3]); w0.z = pkbf(acc[tt][4], acc[tt][5]); w0.w = pkbf(acc[tt][6], acc[tt][7]);
                w1.x = pkbf(acc[tt][8], acc[tt][9]); w1.y = pkbf(acc[tt][10], acc[tt][11]); w1.z = pkbf(acc[tt][12], acc[tt][13]); w1.w = pkbf(acc[tt][14], acc[tt][15]);
                bf16* p = gUT + n * 64 + hl * 32 + tt * 16; *(GAS v4u*)p = w0; *(GAS v4u*)(p + 8) = w1; } }
        else { const int np = swap23(n);
#pragma unroll
            for (int tt = 0; tt < 2; ++tt)
#pragma unroll
                for (int i = 0; i < 16; ++i) oW[(32 * tt + crow(i, hl)) * LDK + np] = f2b(acc[tt][i]); } }
    LBAR();
#pragma unroll
    for (int it = 0; it < 5; ++it) { const int idx = it * NTHR + C.tid;
        if (it < 2) *(GAS v4u*)(gKeT + idx * 8) = *(const LAS v4u*)(oKeT + (idx >> 3) * LDC + (idx & 7) * 8);
        else if (it < 4) { const int q = idx - 1024; *(GAS v4u*)(gW + q * 8) = *(const LAS v4u*)(oW + (q >> 4) * LDK + (q & 15) * 8); }
        else { const int q = idx - 2048; *(GAS v4u*)(gAqk + q * 8) = *(const LAS v4u*)(oAqk + (q >> 3) * LDC + (q & 7) * 8); } }
}
__device__ __forceinline__ void m1_ssd(const Ctx& C_, int l, int b, int c, int g) {
    Ctx C = C_; asm volatile("v_mbcnt_lo_u32_b32 %0, -1, 0\n\tv_mbcnt_hi_u32_b32 %0, -1, %0" : "=v"(C.lane)); C.tid = C.wave * 64 + C.lane;
    LAS unsigned char* lds = lds_v(C);
    LAS bf16* sC = (LAS bf16*)lds; LAS bf16* sB = sC + 64 * LDK;
    LAS float* sCB = (LAS float*)(lds + 34816);
    LAS float* sDt = (LAS float*)(lds + 51200); LAS float* sCu = sDt + 256; LAS float* sWv = sCu + 256;
    LAS bf16* oXT = (LAS bf16*)(lds + 54272); LAS bf16* oBW = (LAS bf16*)(lds + 91136);
    const bf16* U = (const bf16*)(C.ws + WS_U); bf16* YS1 = (bf16*)(C.ws + WS_YS) + (size_t)T_ALL * 512;
    unsigned char* scr = C.ws + SCR_SSD + (size_t)((b * NCH + c) * 2 + g) * SSD_UNIT;
    bf16* gC = (bf16*)scr;
    const int t0 = b * SEQ + c * CH, t = C.tid >> 3, cg = C.tid & 7, d0 = cg * 16, w8 = C.wave * 8;
    unsigned ua[11], ub[11]; f32x2 wa[5], wbq[5]; float x0[8], x1[8]; float dtraw = 0.f; v4u zr4[4];
#define SSD_CHB(P) ((P) < 2 ? g * 256 + (P) * 128 : ((P) == 2 ? 512 + g * 128 : 768 + g * 128))
#define SSD_LD(uu, wq, P) do { \
        _Pragma("unroll") for (int i = 0; i < 11; ++i) { const int tr = c * CH + w8 - 3 + i; const bf16* ur = U + (size_t)(b * SEQ + (tr >= 0 ? tr : 0)) * NU + C_SXBC + SSD_CHB(P); uu[i] = *(const GAS unsigned*)(ur + 2 * C.lane); } \
        _Pragma("unroll") for (int tap = 0; tap < 4; ++tap) wq[tap] = *(const GAS f32x2*)(C.in[I_WSC] + ((size_t)l * 4 + tap) * 1024 + SSD_CHB(P) + 2 * C.lane); \
        wq[4] = *(const GAS f32x2*)(C.in[I_BSC] + l * 1024 + SSD_CHB(P) + 2 * C.lane); } while (0)
    if (C.tid < 256) dtraw = bf2f(U[(size_t)(t0 + (C.tid & 63)) * NU + C_SDT + g * 4 + (C.tid >> 6)]);
    SSD_LD(ua, wa, 0); SSD_LD(ub, wbq, 1);
    { const bf16* zr = U + (size_t)(t0 + t) * NU + C_SZ + g * 256 + cg * 32;
#pragma unroll
      for (int q = 0; q < 4; ++q) zr4[q] = *(const GAS v4u*)(zr + 8 * q); }
    __builtin_amdgcn_sched_barrier(0);
    LBAR();
    if (C.tid < 256) { const int hh = C.tid >> 6, tt = C.tid & 63, hd = g * 4 + hh; const float A = -__expf(C.in[I_SALOG][l * 8 + hd]);
        const float dt = softplus_f(dtraw + C.in[I_SDTB][l * 8 + hd]); const float cs = wave_incl_scan(sCu + 256 + hh * 64, dt * A, tt);
        const float c63 = __int_as_float(__builtin_amdgcn_readlane(__float_as_int(cs), 63));
        sDt[hh * 64 + tt] = dt; sCu[hh * 64 + tt] = cs; sWv[hh * 64 + tt] = __expf(c63 - cs) * dt;
        ((float*)(C.ws + WS_SMALL + SM_ECUM))[(size_t)((b * NCH + c) * 8 + hd) * 64 + tt] = __expf(cs);
        if (tt == 63) ((float*)(C.ws + WS_SMALL + SM_ELAST))[(b * NCH + c) * 8 + hd] = __expf(cs); }
    LBAR();
    {
#define SSD_CONV(uu, wq) do { \
        _Pragma("unroll") for (int i = 0; i < 3; ++i) if (c * CH + w8 - 3 + i < 0) uu[i] = 0u;        \
        _Pragma("unroll") for (int i = 0; i < 8; ++i) { float a0 = wq[4][0], a1 = wq[4][1]; \
            _Pragma("unroll") for (int tap = 0; tap < 4; ++tap) { a0 += blo(uu[i + tap]) * wq[tap][0]; a1 += bhi(uu[i + tap]) * wq[tap][1]; } \
            x0[i] = silu_f(a0); x1[i] = silu_f(a1); } } while (0)
        SSD_CONV(ua, wa);
        { const int hh = C.lane >> 5, p = (2 * C.lane) & 63; v4u o0, o1; o0.x = pkbf(x0[0], x0[1]); o0.y = pkbf(x0[2], x0[3]); o0.z = pkbf(x0[4], x0[5]); o0.w = pkbf(x0[6], x0[7]); o1.x = pkbf(x1[0], x1[1]); o1.y = pkbf(x1[2], x1[3]); o1.z = pkbf(x1[4], x1[5]); o1.w = pkbf(x1[6], x1[7]);
          *(LAS v4u*)(oXT + (hh * 64 + p) * LDC + w8) = o0; *(LAS v4u*)(oXT + (hh * 64 + p + 1) * LDC + w8) = o1; }
        __builtin_amdgcn_sched_barrier(0);
        SSD_LD(ua, wa, 2); __builtin_amdgcn_sched_barrier(0);
        SSD_CONV(ub, wbq);
        { const int hh = 2 + (C.lane >> 5), p = (2 * C.lane) & 63; v4u o0, o1; o0.x = pkbf(x0[0], x0[1]); o0.y = pkbf(x0[2], x0[3]); o0.z = pkbf(x0[4], x0[5]); o0.w = pkbf(x0[6], x0[7]); o1.x = pkbf(x1[0], x1[1]); o1.y = pkbf(x1[2], x1[3]); o1.z = pkbf(x1[4], x1[5]); o1.w = pkbf(x1[6], x1[7]);
          *(LAS v4u*)(oXT + (hh * 64 + p) * LDC + w8) = o0; *(LAS v4u*)(oXT + (hh * 64 + p + 1) * LDC + w8) = o1; }
        __builtin_amdgcn_sched_barrier(0);
        SSD_LD(ub, wbq, 3); __builtin_amdgcn_sched_barrier(0);
        SSD_CONV(ua, wa);
#pragma unroll
        for (int i = 0; i < 8; ++i) *(LAS unsigned*)(sB + (w8 + i) * LDK + 2 * C.lane) = pkbf(x0[i], x1[i]);
#pragma unroll 1
        for (int rnd = 0; rnd < 2; ++rnd) {
#pragma unroll
            for (int h2 = 0; h2 < 2; ++h2) { const int hh = 2 * rnd + h2; const f32x4 wl = *(const LAS f32x4*)(sWv + hh * 64 + w8), wh = *(const LAS f32x4*)(sWv + hh * 64 + w8 + 4); v4u o0, o1;
                o0.x = pkbf(x0[0] * wl[0], x0[1] * wl[1]); o0.y = pkbf(x0[2] * wl[2], x0[3] * wl[3]); o0.z = pkbf(x0[4] * wh[0], x0[5] * wh[1]); o0.w = pkbf(x0[6] * wh[2], x0[7] * wh[3]);
                o1.x = pkbf(x1[0] * wl[0], x1[1] * wl[1]); o1.y = pkbf(x1[2] * wl[2], x1[3] * wl[3]); o1.z = pkbf(x1[4] * wh[0], x1[5] * wh[1]); o1.w = pkbf(x1[6] * wh[2], x1[7] * wh[3]);
                *(LAS v4u*)(oBW + (h2 * 128 + 2 * C.lane) * LDC + w8) = o0; *(LAS v4u*)(oBW + (h2 * 128 + 2 * C.lane + 1) * LDC + w8) = o1; }
            LBAR();
#pragma unroll
            for (int it = 0; it < 4; ++it) { const int idx = it * NTHR + C.tid, h2 = idx >> 10, q = idx & 1023;
                *(GAS v4u*)((bf16*)(scr + 16384 + (size_t)(2 * rnd + h2) * 32768 + 8192) + q * 8) = *(const LAS v4u*)(oBW + (h2 * 128 + (q >> 3)) * LDC + (q & 7) * 8); }
            LBAR(); }
        SSD_CONV(ub, wbq);
#pragma unroll
        for (int i = 0; i < 8; ++i) { const unsigned pv = pkbf(x0[i], x1[i]); *(LAS unsigned*)(sC + (w8 + i) * LDK + 2 * C.lane) = pv; *(GAS unsigned*)(gC + (w8 + i) * 128 + swap23(2 * C.lane)) = pv; }
#undef SSD_CHB
#undef SSD_LD
#undef SSD_CONV
    }
    {
        bf16* yr = YS1 + (size_t)(t0 + t) * 512 + g * 256 + cg * 32;
#pragma unroll
        for (int q = 0; q < 4; ++q) { const v4u a = zr4[q]; v4u o;
#pragma unroll
            for (int i = 0; i < 4; ++i) o[i] = pkbf(silu_f(blo(a[i])), silu_f(bhi(a[i])));
            *(GAS v4u*)(yr + 8 * q) = o; } }
    LBAR();
    if (C.wave < 4) { const int tt = C.wave & 1, st = C.wave >> 1, r = C.lane & 31, hl = C.lane >> 5; f32x16 acc = zero16();
        if (st <= tt) {
#pragma unroll
            for (int ks = 0; ks < 8; ++ks) { const bf16x8 a = *(const LAS bf16x8*)(sC + (32 * tt + r) * LDK + 16 * ks + 8 * hl), bb = *(const LAS bf16x8*)(sB + (32 * st + r) * LDK + 16 * ks + 8 * hl); acc = MFMA32(a, bb, acc); } }
#pragma unroll
        for (int i = 0; i < 16; ++i) sCB[(32 * tt + crow(i, hl)) * 64 + 32 * st + r] = acc[i]; }
    LBAR();
    { const int s0 = cg * 8; f32x4 cb[2], cu[4][2], dq[4][2]; float ctv[4], Dv[4];
      cb[0] = *(const LAS f32x4*)(sCB + t * 64 + s0); cb[1] = *(const LAS f32x4*)(sCB + t * 64 + s0 + 4);
#pragma unroll
      for (int hh = 0; hh < 4; ++hh) { cu[hh][0] = *(const LAS f32x4*)(sCu + hh * 64 + s0); cu[hh][1] = *(const LAS f32x4*)(sCu + hh * 64 + s0 + 4); dq[hh][0] = *(const LAS f32x4*)(sDt + hh * 64 + s0); dq[hh][1] = *(const LAS f32x4*)(sDt + hh * 64 + s0 + 4);
          ctv[hh] = sCu[hh * 64 + t]; Dv[hh] = C.in[I_SD][l * 8 + g * 4 + hh]; }
#pragma unroll
      for (int hh = 0; hh < 4; ++hh) { float m[8];
#pragma unroll
          for (int j = 0; j < 8; ++j) { const int s = s0 + j; m[j] = (s <= t) ? cb[j >> 2][j & 3] * __expf(ctv[hh] - cu[hh][j >> 2][j & 3]) * dq[hh][j >> 2][j & 3] + (s == t ? Dv[hh] : 0.f) : 0.f; }
          v4u o; o.x = pkbf(m[0], m[1]); o.y = pkbf(m[2], m[3]); o.z = pkbf(m[4], m[5]); o.w = pkbf(m[6], m[7]);
          *(GAS v4u*)((bf16*)(scr + 16384 + (size_t)hh * 32768) + t * 64 + s0) = o; } }
#pragma unroll
    for (int it = 0; it < 4; ++it) { const int idx = it * NTHR + C.tid, hh = idx >> 9, q = idx & 511;
        *(GAS v4u*)((bf16*)(scr + 16384 + (size_t)hh * 32768 + 24576) + q * 8) = *(const LAS v4u*)(oXT + (hh * 64 + (q >> 3)) * LDC + (q & 7) * 8); }
}
#define HR_STAGE(SH, N) _Pragma("unroll") for (int idx = 0; idx < (N) / 2; ++idx) { const float keep = up##SH ? v[idx + (N) / 2] : v[idx], send = up##SH ? v[idx] : v[idx + (N) / 2]; v[idx] = keep + __int_as_float(__builtin_amdgcn_ds_swizzle(__float_as_int(send), 0x1f | ((SH) << 10))); }
__device__ __forceinline__ float half_reduce32(float (&v)[32], int lane) {
    const bool up16 = lane & 16, up8 = lane & 8, up4 = lane & 4, up2 = lane & 2, up1 = lane & 1;
    HR_STAGE(16, 32) HR_STAGE(8, 16) HR_STAGE(4, 8) HR_STAGE(2, 4) HR_STAGE(1, 2)
    return v[0];
}
__device__ __forceinline__ void rows_rstd_a(LAS float* xch, int par, int wave, int lane, float (&v)[32]) {
    const float tot = half_reduce32(v, lane);
    xch[par * 512 + wave * 64 + lane] = tot;
}
template <int NWG, int NCOLS> __device__ __forceinline__ void rows_rstd_b(LAS float* xch, int par, int wave, int lane, float (&rs)[32]) {
    const int slot = lane;
    LAS float* part = xch + par * 512;
    LBAR();
    const int w0 = (wave / NWG) * NWG; float s = 0.f;
#pragma unroll
    for (int j = 0; j < NWG; ++j) s += part[(w0 + j) * 64 + slot];
    LAS float* bc = xch + 1024 + wave * 64;
    bc[slot] = rsqrtf(s * (1.f / NCOLS) + EPS);
    asm volatile("s_waitcnt lgkmcnt(0)" ::: "memory");
#pragma unroll
    for (int q = 0; q < 8; ++q) { const f32x4 x = *(const LAS f32x4*)(bc + (lane & 32) + 4 * q); rs[4 * q] = x[0]; rs[4 * q + 1] = x[1]; rs[4 * q + 2] = x[2]; rs[4 * q + 3] = x[3]; }
}
__device__ __forceinline__ void scale_rows4(f32x16& a, const float* vec32, int hl) {
#pragma unroll
    for (int q = 0; q < 4; ++q) { const f32x4 d = *(const GAS f32x4*)(vec32 + 8 * q + 4 * hl); a[4 * q] *= d[0]; a[4 * q + 1] *= d[1]; a[4 * q + 2] *= d[2]; a[4 * q + 3] *= d[3]; }
}
constexpr int SB_STRIDE = 63488, OB_OFF = 126976, DEC_OFF = 144384;
#define LDF(base, row, ld, col) (*(const LAS bf16x8*)((base) + (row) * (ld) + (col)))
__device__ __forceinline__ void stage_out(LAS bf16* ob, const f32x16 (&o)[2], int col, int hl) {
#pragma unroll
    for (int i = 0; i < 32; ++i) ob[(32 * (i >> 4) + crow(i & 15, hl)) * LDK + col] = f2b(o[i >> 4][i & 15]);
}
__device__ __forceinline__ void load_gates(const bf16* ys, int lt, v4u (&g)[4]) {
    const bf16* yp = ys + (size_t)(lt >> 2) * 512 + (lt & 3) * 32;
#pragma unroll
    for (int q = 0; q < 4; ++q) g[q] = *(const GAS v4u*)(yp + 8 * q);
}
__device__ __forceinline__ void finish_rows_norm(const LAS bf16* ob, bf16* ys, int lt, bool st, const v4u (&g)[4]) {
    const int t = lt >> 2, cb = (lt & 3) * 32; float x[32]; float ss = 0.f;
    bf16* yp = ys + (size_t)t * 512 + cb;
#pragma unroll
    for (int q = 0; q < 4; ++q) { const v4u w = *(const LAS v4u*)(ob + t * LDK + cb + 8 * q);
#pragma unroll
        for (int e = 0; e < 4; ++e) { x[8 * q + 2 * e] = blo(w[e]); x[8 * q + 2 * e + 1] = bhi(w[e]); } }
#pragma unroll
    for (int j = 0; j < 32; ++j) ss += x[j] * x[j];
    ss += SWZ_XOR(ss, 1); ss += SWZ_XOR(ss, 2);
    const float rstd = rsqrtf(ss * (1.f / 128.f) + EPS);
#pragma unroll
    for (int q = 0; q < 4; ++q) { v4u o;
#pragma unroll
        for (int e = 0; e < 4; ++e) o[e] = pkbf(x[8 * q + 2 * e] * rstd * blo(g[q][e]), x[8 * q + 2 * e + 1] * rstd * bhi(g[q][e]));
        if (st) *(GAS v4u*)(yp + 8 * q) = o; }
}
__device__ __forceinline__ void gla_scan(const Ctx& C_, int l, int b, int h, bool st) {
    Ctx C = C_; asm volatile("v_mbcnt_lo_u32_b32 %0, -1, 0\n\tv_mbcnt_hi_u32_b32 %0, -1, %0" : "=v"(C.lane)); C.tid = C.wave * 64 + C.lane;
    LAS unsigned char* lds = lds_v(C); LAS bf16* ob = (LAS bf16*)(lds + OB_OFF);
    const bf16* U = (const bf16*)(C.ws + WS_U); bf16* YS0 = (bf16*)(C.ws + WS_YS);
    LBAR();
    if (C.wave >= 4) {
        int lt = C.tid - 256; v4u srA[14], srB[14], dA = {0u, 0u, 0u, 0u}, dB = {0u, 0u, 0u, 0u};
        const unsigned char* ub = (const unsigned char*)(U + (size_t)(b * SEQ) * NU + h * 128);
        LAS float* dcl = (LAS float*)(lds + DEC_OFF);
#define GLA_LOAD(sr, dreg, c) do { const unsigned char* cb = ub + (size_t)(c) * CH * NU * 2; _Pragma("unroll") for (int j = 0; j < 14; ++j) { const int idx = j * 256 + lt; \
            if (j < 4) { const int ur = idx >> 4, c16 = idx & 15; sr[j] = *(const GAS v4u*)(cb + (size_t)ur * (NU * 2) + C_GQ * 2 + c16 * 16); } \
            else if (j < 6) { const int q = idx - 1024, ur = q >> 3, c16 = q & 7; sr[j] = *(const GAS v4u*)(cb + (size_t)ur * (NU * 2) + C_GR * 2 + c16 * 16); } \
            else if (j < 10) { const int q = idx - 1536, ur = q >> 4, c16 = q & 15; sr[j] = *(const GAS v4u*)(cb + (size_t)ur * (NU * 2) + C_GK * 2 + c16 * 16); } \
            else { const int q = idx - 2560, ur = q >> 4, c16 = q & 15; sr[j] = *(const GAS v4u*)(cb + (size_t)ur * (NU * 2) + C_GV * 2 + c16 * 16); } } \
            if (lt < 32) dreg = *(const GAS v4u*)(ub + (size_t)((c) * CH + (lt >> 3)) * (NU * 2) + (C_GR + 64) * 2 + (lt & 7) * 16); } while (0)
#define GLA_WRITE(sr, dreg, buf) do { LAS unsigned char* B = lds + (buf) * SB_STRIDE; _Pragma("unroll") for (int j = 0; j < 14; ++j) { const int idx = j * 256 + lt; \
            if (j < 4) { const int ur = idx >> 4, c16 = idx & 15; *(LAS v4u*)(B + ur * 272 + c16 * 16) = sr[j]; } \
            else if (j < 6) { const int q = idx - 1024, ur = q >> 3, c16 = q & 7; *(LAS v4u*)(B + 17408 + ur * 144 + c16 * 16) = sr[j]; } \
            else if (j < 10) { const int q = idx - 1536, ur = q >> 4, c16 = q & 15; *(LAS v4u*)(B + 26624 + (2 * ur + (c16 >> 3)) * 144 + (c16 & 7) * 16) = sr[j]; } \
            else { const int q = idx - 2560, ur = q >> 4, c16 = q & 15; *(LAS v4u*)(B + 45056 + (2 * ur + (c16 >> 3)) * 144 + (c16 & 7) * 16) = sr[j]; } } \
            if (lt < 32) *(LAS v4u*)(dcl + (buf) * 128 + lt * 4) = dreg; } while (0)
        GLA_LOAD(srA, dA, 0); GLA_WRITE(srA, dA, 0); GLA_LOAD(srB, dB, 1); GLA_LOAD(srA, dA, 2);
        v4u gg[4]; load_gates(YS0 + (size_t)(b * SEQ) * 512 + h * 128, lt, gg);
        LBAR();
#pragma unroll 1
        for (int c = 0; c < NCH; c += 2) { asm volatile("" : "+v"(lt));
            if (c > 0) { finish_rows_norm(ob, YS0 + (size_t)(b * SEQ + (c - 1) * CH) * 512 + h * 128, lt, st, gg); load_gates(YS0 + (size_t)(b * SEQ + c * CH) * 512 + h * 128, lt, gg); }
            GLA_WRITE(srB, dB, 1); if (c + 3 < NCH) GLA_LOAD(srB, dB, c + 3);
            LBAR(); LBAR();
            finish_rows_norm(ob, YS0 + (size_t)(b * SEQ + c * CH) * 512 + h * 128, lt, st, gg); load_gates(YS0 + (size_t)(b * SEQ + (c + 1) * CH) * 512 + h * 128, lt, gg);
            if (c + 2 < NCH) { GLA_WRITE(srA, dA, 0); if (c + 4 < NCH) GLA_LOAD(srA, dA, c + 4); }
            LBAR(); LBAR(); }
        finish_rows_norm(ob, YS0 + (size_t)(b * SEQ + (NCH - 1) * CH) * 512 + h * 128, lt, st, gg);
#undef GLA_LOAD
#undef GLA_WRITE
        return;
    }
    const int vs = C.wave & 3; int lane_ = C.lane;
    f32x16 S[4] = {zero16(), zero16(), zero16(), zero16()};
    LBAR();
#pragma unroll 1
    for (int c = 0; c < NCH; ++c) {
        asm volatile("" : "+v"(lane_)); const int r = lane_ & 31, hl = lane_ >> 5, v = 32 * vs + r;
        LAS unsigned char* B = lds + (c & 1) * SB_STRIDE;
        const LAS bf16* qdl = (const LAS bf16*)B; const LAS bf16* al = (const LAS bf16*)(B + 17408); const LAS bf16* kll = (const LAS bf16*)(B + 26624); const LAS bf16* vtl = (const LAS bf16*)(B + 45056);
        const LAS float* dcl = (const LAS float*)(lds + DEC_OFF) + (c & 1) * 128;
        f32x16 o[2] = {zero16(), zero16()};
#define SB0() __builtin_amdgcn_sched_barrier(0)
#define LDW(f, T, kt) do { f[0] = LDF(T, r, LDK, 32 * (kt) + 8 * hl); f[1] = LDF(T, r, LDK, 32 * (kt) + 16 + 8 * hl); f[2] = LDF(T, 32 + r, LDK, 32 * (kt) + 8 * hl); f[3] = LDF(T, 32 + r, LDK, 32 * (kt) + 16 + 8 * hl); } while (0)
#define MMW(f, acc) do { acc[0] = MFMA32(f[0], b0, acc[0]); acc[0] = MFMA32(f[1], b1, acc[0]); acc[1] = MFMA32(f[2], b0, acc[1]); acc[1] = MFMA32(f[3], b1, acc[1]); } while (0)
#define LDA2(f, T, ka, kb) do { f[0] = LDF(T, r, LDC, 16 * (ka) + 8 * hl); f[1] = LDF(T, 32 + r, LDC, 16 * (ka) + 8 * hl); f[2] = LDF(T, r, LDC, 16 * (kb) + 8 * hl); f[3] = LDF(T, 32 + r, LDC, 16 * (kb) + 8 * hl); } while (0)
#define MMA2(f, bq, ka, kb, acc) do { acc[0] = MFMA32(f[0], bq[ka], acc[0]); acc[1] = MFMA32(f[1], bq[ka], acc[1]); acc[0] = MFMA32(f[2], bq[kb], acc[0]); acc[1] = MFMA32(f[3], bq[kb], acc[1]); } while (0)
#define LDR4(f, T, row) do { f[0] = LDF(T, (row) + r, LDC, 8 * hl); f[1] = LDF(T, (row) + r, LDC, 16 + 8 * hl); f[2] = LDF(T, (row) + r, LDC, 32 + 8 * hl); f[3] = LDF(T, (row) + r, LDC, 48 + 8 * hl); } while (0)
#define MMR4(f, bq, acc) do { acc = MFMA32(f[0], bq[0], acc); acc = MFMA32(f[1], bq[1], acc); acc = MFMA32(f[2], bq[2], acc); acc = MFMA32(f[3], bq[3], acc); } while (0)
#define LDD(d, kt) do { _Pragma("unroll") for (int q = 0; q < 4; ++q) d[q] = *(const LAS f32x4*)(dcl + 32 * (kt) + 8 * q + 4 * hl); } while (0)
#define MULD(d, kt) do { _Pragma("unroll") for (int q = 0; q < 4; ++q) { S[kt][4 * q] *= d[q][0]; S[kt][4 * q + 1] *= d[q][1]; S[kt][4 * q + 2] *= d[q][2]; S[kt][4 * q + 3] *= d[q][3]; } } while (0)
        bf16x8 fA[4], fB[4], bv[4]; f32x4 dA[4], dB[4];
        LDW(fA, qdl, 0);
#pragma unroll
        for (int ks = 0; ks < 4; ++ks) bv[ks] = LDF(vtl, v, LDC, 16 * ks + 8 * hl);
        SB0();
        { bf16x8 b0 = pack_step<0>(S[0]), b1 = pack_step<1>(S[0]);
          LDW(fB, qdl, 1); SB0(); MMW(fA, o); SB0();
          b0 = pack_step<0>(S[1]); b1 = pack_step<1>(S[1]);
          LDW(fA, qdl, 2); SB0(); MMW(fB, o); SB0();
          b0 = pack_step<0>(S[2]); b1 = pack_step<1>(S[2]);
          LDW(fB, qdl, 3); SB0(); MMW(fA, o); SB0();
          b0 = pack_step<0>(S[3]); b1 = pack_step<1>(S[3]);
          LDA2(fA, al, 0, 1); SB0(); MMW(fB, o); SB0(); }
        LDA2(fB, al, 2, 3); SB0(); MMA2(fA, bv, 0, 1, o); SB0();
        LDR4(fA, kll, 0); LDD(dA, 0); SB0(); MMA2(fB, bv, 2, 3, o); SB0();
        LDR4(fB, kll, 32); LDD(dB, 1); SB0(); MULD(dA, 0); MMR4(fA, bv, S[0]); SB0();
        LDR4(fA, kll, 64); LDD(dA, 2); SB0(); MULD(dB, 1); MMR4(fB, bv, S[1]); SB0();
        LDR4(fB, kll, 96); LDD(dB, 3); SB0(); MULD(dA, 2); MMR4(fA, bv, S[2]); SB0();
        MULD(dB, 3); MMR4(fB, bv, S[3]); SB0();
#undef LDW
#undef MMW
#undef LDD
#undef MULD
        LBAR();
        stage_out(ob, o, v, hl);
        LBAR();
    }
    const int r = lane_ & 31, hl = lane_ >> 5, v = 32 * vs + r;
    float* so = C.out + O_PGLA + ((((size_t)l * 8 + b) * 4 + h) * 128) * 128 + v;
#pragma unroll
    for (int kt = 0; kt < 4; ++kt)
#pragma unroll
        for (int i = 0; i < 16; ++i) if (st) so[(size_t)(32 * kt + crow(i, hl)) * 128] = S[kt][i];
}
__device__ __forceinline__ void gdn_scan(const Ctx& C_, int l, int b, int h, bool st) {
    Ctx C = C_; asm volatile("v_mbcnt_lo_u32_b32 %0, -1, 0\n\tv_mbcnt_hi_u32_b32 %0, -1, %0" : "=v"(C.lane)); C.tid = C.wave * 64 + C.lane;
    LAS unsigned char* lds = lds_v(C); LAS bf16* ob = (LAS bf16*)(lds + OB_OFF);
    const unsigned char* sbase = C.ws + SCR_GDN + (size_t)((b * NCH) * 4 + h) * GDN_UNIT;
    bf16* YS2 = (bf16*)(C.ws + WS_YS) + (size_t)2 * T_ALL * 512;
    LBAR();
    if (C.wave >= 4) {
        int lt = C.tid - 256; v4u srA[14], srB[14];
#define GDN_LOAD(sr, c) do { const unsigned char* cb = sbase + (size_t)(c) * 4 * GDN_UNIT; _Pragma("unroll") for (int j = 0; j < 14; ++j) { const int idx = j * 256 + lt; \
            sr[j] = *(const GAS v4u*)(cb + (j < 12 ? idx * 16 : 65536 + (idx - 3072) * 16)); } } while (0)
#define GDN_WRITE(sr, buf) do { LAS unsigned char* B = lds + (buf) * SB_STRIDE; _Pragma("unroll") for (int j = 0; j < 14; ++j) { const int idx = j * 256 + lt; \
            if (j < 4) { *(LAS v4u*)(B + (idx >> 4) * 272 + (idx & 15) * 16) = sr[j]; } \
            else if (j < 8) { const int q = idx - 1024; *(LAS v4u*)(B + 17408 + (q >> 4) * 272 + (q & 15) * 16) = sr[j]; } \
            else if (j < 12) { const int q = idx - 2048; *(LAS v4u*)(B + 34816 + (q >> 3) * 144 + (q & 7) * 16) = sr[j]; } \
            else { const int q = idx - 3072; *(LAS v4u*)(B + 53248 + (q >> 3) * 144 + (q & 7) * 16) = sr[j]; } } } while (0)
        GDN_LOAD(srA, 0); GDN_WRITE(srA, 0); GDN_LOAD(srB, 1); GDN_LOAD(srA, 2);
        v4u gg[4]; load_gates(YS2 + (size_t)(b * SEQ) * 512 + h * 128, lt, gg);
        LBAR();
#pragma unroll 1
        for (int c = 0; c < NCH; c += 2) { asm volatile("" : "+v"(lt));
            if (c > 0) { finish_rows_norm(ob, YS2 + (size_t)(b * SEQ + (c - 1) * CH) * 512 + h * 128, lt, st, gg); load_gates(YS2 + (size_t)(b * SEQ + c * CH) * 512 + h * 128, lt, gg); }
            GDN_WRITE(srB, 1); if (c + 3 < NCH) GDN_LOAD(srB, c + 3);
            LBAR(); LBAR();
            finish_rows_norm(ob, YS2 + (size_t)(b * SEQ + c * CH) * 512 + h * 128, lt, st, gg); load_gates(YS2 + (size_t)(b * SEQ + (c + 1) * CH) * 512 + h * 128, lt, gg);
            if (c + 2 < NCH) { GDN_WRITE(srA, 0); if (c + 4 < NCH) GDN_LOAD(srA, c + 4); }
            LBAR(); LBAR(); }
        finish_rows_norm(ob, YS2 + (size_t)(b * SEQ + (NCH - 1) * CH) * 512 + h * 128, lt, st, gg);
#undef GDN_LOAD
#undef GDN_WRITE
        return;
    }
    const int vs = C.wave & 3; int lane_ = C.lane;
    f32x16 S[4] = {zero16(), zero16(), zero16(), zero16()};
    const float* gdec = (const float*)(C.ws + WS_SMALL + SM_GDEC) + (b * NCH) * 4 + h; float decn = gdec[0];
    v4u un0, un1, un2, un3; { const bf16* up = (const bf16*)(sbase + 49152) + (32 * vs + (lane_ & 31)) * 64 + (lane_ >> 5) * 32; un0 = *(const GAS v4u*)up; un1 = *(const GAS v4u*)(up + 8); un2 = *(const GAS v4u*)(up + 16); un3 = *(const GAS v4u*)(up + 24); }
    LBAR();
#pragma unroll 1
    for (int c = 0; c < NCH; ++c) {
        asm volatile("" : "+v"(lane_)); const int r = lane_ & 31, hl = lane_ >> 5, v = 32 * vs + r;
        LAS unsigned char* B = lds + (c & 1) * SB_STRIDE;
        const LAS bf16* wl = (const LAS bf16*)B; const LAS bf16* qel = (const LAS bf16*)(B + 17408); const LAS bf16* ketl = (const LAS bf16*)(B + 34816); const LAS bf16* aqkl = (const LAS bf16*)(B + 53248);
        const int cn = c + 1 < NCH ? c + 1 : c; const bf16* gUT = (const bf16*)(sbase + (size_t)cn * 4 * GDN_UNIT + 49152);
        const float dec = decn; decn = gdec[cn * 4];
        f32x16 ws[2] = {zero16(), zero16()}, qs[2] = {zero16(), zero16()};
        const v4u u0 = un0, u1 = un1, u2 = un2, u3 = un3;
        un0 = *(const GAS v4u*)(gUT + v * 64 + hl * 32); un1 = *(const GAS v4u*)(gUT + v * 64 + hl * 32 + 8); un2 = *(const GAS v4u*)(gUT + v * 64 + hl * 32 + 16); un3 = *(const GAS v4u*)(gUT + v * 64 + hl * 32 + 24);
#define LDW(f, T, kt) do { f[0] = LDF(T, r, LDK, 32 * (kt) + 8 * hl); f[1] = LDF(T, r, LDK, 32 * (kt) + 16 + 8 * hl); f[2] = LDF(T, 32 + r, LDK, 32 * (kt) + 8 * hl); f[3] = LDF(T, 32 + r, LDK, 32 * (kt) + 16 + 8 * hl); } while (0)
#define MMW(f, acc) do { acc[0] = MFMA32(f[0], b0, acc[0]); acc[0] = MFMA32(f[1], b1, acc[0]); acc[1] = MFMA32(f[2], b0, acc[1]); acc[1] = MFMA32(f[3], b1, acc[1]); } while (0)
#define LDK2(f, ka, kb, ts) do { f[0] = LDF(ketl, 32 * (ka) + r, LDC, 32 * (ts) + 8 * hl); f[1] = LDF(ketl, 32 * (ka) + r, LDC, 32 * (ts) + 16 + 8 * hl); f[2] = LDF(ketl, 32 * (kb) + r, LDC, 32 * (ts) + 8 * hl); f[3] = LDF(ketl, 32 * (kb) + r, LDC, 32 * (ts) + 16 + 8 * hl); } while (0)
#define MMK2(f, ka, kb) do { S[ka] = MFMA32(f[0], n0, S[ka]); S[ka] = MFMA32(f[1], n1, S[ka]); S[kb] = MFMA32(f[2], n0, S[kb]); S[kb] = MFMA32(f[3], n1, S[kb]); } while (0)
        bf16x8 fA[4], fB[4];
        LDW(fA, wl, 0); SB0();
        { bf16x8 b0 = pack_step<0>(S[0]), b1 = pack_step<1>(S[0]);
          LDW(fB, qel, 0); SB0(); MMW(fA, ws); SB0(); LDW(fA, wl, 1); SB0(); MMW(fB, qs); SB0();
          b0 = pack_step<0>(S[1]); b1 = pack_step<1>(S[1]);
          LDW(fB, qel, 1); SB0(); MMW(fA, ws); SB0(); LDW(fA, wl, 2); SB0(); MMW(fB, qs); SB0();
          b0 = pack_step<0>(S[2]); b1 = pack_step<1>(S[2]);
          LDW(fB, qel, 2); SB0(); MMW(fA, ws); SB0(); LDW(fA, wl, 3); SB0(); MMW(fB, qs); SB0();
          b0 = pack_step<0>(S[3]); b1 = pack_step<1>(S[3]);
          LDW(fB, qel, 3); SB0(); MMW(fA, ws); SB0();
          fA[0] = LDF(aqkl, r, LDC, 8 * hl); fA[1] = LDF(aqkl, r, LDC, 16 + 8 * hl); fA[2] = LDF(aqkl, 32 + r, LDC, 8 * hl); fA[3] = LDF(aqkl, 32 + r, LDC, 16 + 8 * hl); SB0();
          MMW(fB, qs); SB0(); }
        f32x16 vn[2];
#pragma unroll
        for (int i = 0; i < 4; ++i) { vn[0][2 * i] = blo(u0[i]) - ws[0][2 * i]; vn[0][2 * i + 1] = bhi(u0[i]) - ws[0][2 * i + 1]; vn[0][8 + 2 * i] = blo(u1[i]) - ws[0][8 + 2 * i]; vn[0][8 + 2 * i + 1] = bhi(u1[i]) - ws[0][8 + 2 * i + 1];
            vn[1][2 * i] = blo(u2[i]) - ws[1][2 * i]; vn[1][2 * i + 1] = bhi(u2[i]) - ws[1][2 * i + 1]; vn[1][8 + 2 * i] = blo(u3[i]) - ws[1][8 + 2 * i]; vn[1][8 + 2 * i + 1] = bhi(u3[i]) - ws[1][8 + 2 * i + 1]; }
#pragma unroll
        for (int kt = 0; kt < 4; ++kt) S[kt] = S[kt] * dec;
        SB0();
        { bf16x8 n0 = pack_step<0>(vn[0]), n1 = pack_step<1>(vn[0]);
          LDK2(fB, 0, 1, 0); SB0(); qs[0] = MFMA32(fA[0], n0, qs[0]); qs[0] = MFMA32(fA[1], n1, qs[0]); qs[1] = MFMA32(fA[2], n0, qs[1]); qs[1] = MFMA32(fA[3], n1, qs[1]); SB0();
          LDK2(fA, 2, 3, 0); SB0(); MMK2(fB, 0, 1); SB0();
          fB[0] = LDF(aqkl, 32 + r, LDC, 32 + 8 * hl); fB[1] = LDF(aqkl, 32 + r, LDC, 48 + 8 * hl); fB[2] = LDF(ketl, r, LDC, 32 + 8 * hl); fB[3] = LDF(ketl, r, LDC, 48 + 8 * hl); SB0();
          MMK2(fA, 2, 3); SB0();
          n0 = pack_step<0>(vn[1]); n1 = pack_step<1>(vn[1]);
          LDK2(fA, 1, 2, 1); SB0(); qs[1] = MFMA32(fB[0], n0, qs[1]); qs[1] = MFMA32(fB[1], n1, qs[1]); S[0] = MFMA32(fB[2], n0, S[0]); S[0] = MFMA32(fB[3], n1, S[0]); SB0();
          fB[0] = LDF(ketl, 96 + r, LDC, 32 + 8 * hl); fB[1] = LDF(ketl, 96 + r, LDC, 48 + 8 * hl); SB0(); MMK2(fA, 1, 2); SB0();
          S[3] = MFMA32(fB[0], n0, S[3]); S[3] = MFMA32(fB[1], n1, S[3]); }
#undef LDW
#undef MMW
#undef LDK2
#undef MMK2
        LBAR();
        stage_out(ob, qs, v, hl);
        LBAR();
    }
    const int r = lane_ & 31, hl = lane_ >> 5, v = 32 * vs + r;
    float* so = C.out + O_PGDN + ((((size_t)l * 8 + b) * 4 + h) * 128) * 128 + v;
#pragma unroll
    for (int kt = 0; kt < 4; ++kt)
#pragma unroll
        for (int i = 0; i < 16; ++i) if (st) so[(size_t)(32 * kt + crow(i, hl)) * 128] = S[kt][i];
}
__device__ __forceinline__ void ssd_load_gates(const bf16* ys, int lt, v4u& g0, v4u& g1) { const bf16* yp = ys + (size_t)(lt >> 2) * 512 + (lt & 3) * 16; g0 = *(const GAS v4u*)yp; g1 = *(const GAS v4u*)(yp + 8); }
__device__ __forceinline__ void ssd_finish_rows(const LAS bf16* ob, bf16* ys, float* ssq, int lt, bool st, const v4u g0, const v4u g1) {
    const int t = lt >> 2, cb = (lt & 3) * 16; bf16* yp = ys + (size_t)t * 512 + cb; float x[16], ss = 0.f;
    const v4u w0 = *(const LAS v4u*)(ob + t * LDK + cb), w1 = *(const LAS v4u*)(ob + t * LDK + cb + 8);
#pragma unroll
    for (int e = 0; e < 4; ++e) { x[2 * e] = blo(w0[e]) * blo(g0[e]); x[2 * e + 1] = bhi(w0[e]) * bhi(g0[e]); x[8 + 2 * e] = blo(w1[e]) * blo(g1[e]); x[8 + 2 * e + 1] = bhi(w1[e]) * bhi(g1[e]); }
#pragma unroll
    for (int j = 0; j < 16; ++j) ss += x[j] * x[j];
    ss += SWZ_XOR(ss, 1); ss += SWZ_XOR(ss, 2);
    v4u o0, o1;
#pragma unroll
    for (int e = 0; e < 4; ++e) { o0[e] = pkbf(x[2 * e], x[2 * e + 1]); o1[e] = pkbf(x[8 + 2 * e], x[8 + 2 * e + 1]); }
    if (st) { *(GAS v4u*)yp = o0; *(GAS v4u*)(yp + 8) = o1; if ((lt & 3) == 0) ssq[(size_t)t * 8] = ss; }
}
__device__ __forceinline__ void ssd_scan(const Ctx& C_, int l, int b, int hd, bool st) {
    Ctx C = C_; asm volatile("v_mbcnt_lo_u32_b32 %0, -1, 0\n\tv_mbcnt_hi_u32_b32 %0, -1, %0" : "=v"(C.lane)); C.tid = C.wave * 64 + C.lane;
    LAS unsigned char* lds = lds_v(C); LAS bf16* ob = (LAS bf16*)(lds + OB_OFF);
    const int g = hd >> 2, hh = hd & 3;
    const unsigned char* sbase = C.ws + SCR_SSD + (size_t)((b * NCH) * 2 + g) * SSD_UNIT;
    bf16* YS1 = (bf16*)(C.ws + WS_YS) + (size_t)T_ALL * 512 + g * 256;
    float* SSQ = (float*)(C.ws + WS_SSQ);
    LBAR();
    if (C.wave >= 4) {
        int lt = C.tid - 256; v4u srA[12], srB[12], eA = {0u, 0u, 0u, 0u}, eB = {0u, 0u, 0u, 0u};
        LAS float* ecl = (LAS float*)(lds + DEC_OFF);
        const float* ecg = (const float*)(C.ws + WS_SMALL + SM_ECUM) + (size_t)((b * NCH) * 8 + hd) * 64;
#define SSD_LOAD(sr, ereg, c) do { const unsigned char* cb = sbase + (size_t)(c) * 2 * SSD_UNIT; _Pragma("unroll") for (int j = 0; j < 12; ++j) { const int idx = j * 256 + lt; \
            sr[j] = *(const GAS v4u*)(cb + (j < 4 ? idx * 16 : 16384 + hh * 32768 + (idx - 1024) * 16)); } \
            if (lt < 16) ereg = *(const GAS v4u*)(ecg + (size_t)(c) * 512 + lt * 4); } while (0)
#define SSD_WRITE(sr, ereg, buf) do { LAS unsigned char* B = lds + (buf) * SB_STRIDE; _Pragma("unroll") for (int j = 0; j < 12; ++j) { const int idx = j * 256 + lt; \
            if (j < 4) { *(LAS v4u*)(B + (idx >> 4) * 272 + (idx & 15) * 16) = sr[j]; } \
            else if (j < 6) { const int q = idx - 1024; *(LAS v4u*)(B + 17408 + (q >> 3) * 144 + (q & 7) * 16) = sr[j]; } \
            else if (j < 10) { const int q = idx - 1536; *(LAS v4u*)(B + 26624 + (q >> 3) * 144 + (q & 7) * 16) = sr[j]; } \
            else { const int q = idx - 2560; *(LAS v4u*)(B + 45056 + (q >> 3) * 144 + (q & 7) * 16) = sr[j]; } } \
            if (lt < 16) *(LAS v4u*)(ecl + (buf) * 64 + lt * 4) = ereg; } while (0)
        SSD_LOAD(srA, eA, 0); SSD_WRITE(srA, eA, 0); SSD_LOAD(srB, eB, 1); SSD_LOAD(srA, eA, 2);
        v4u g0, g1; ssd_load_gates(YS1 + (size_t)(b * SEQ) * 512 + hh * 64, lt, g0, g1);
        LBAR();
#pragma unroll 1
        for (int c = 0; c < NCH; c += 2) { asm volatile("" : "+v"(lt));
            if (c > 0) { const int t0 = b * SEQ + (c - 1) * CH; ssd_finish_rows(ob, YS1 + (size_t)t0 * 512 + hh * 64, SSQ + (size_t)t0 * 8 + hd, lt, st, g0, g1); ssd_load_gates(YS1 + (size_t)(t0 + CH) * 512 + hh * 64, lt, g0, g1); }
            SSD_WRITE(srB, eB, 1); if (c + 3 < NCH) SSD_LOAD(srB, eB, c + 3);
            LBAR(); LBAR();
            { const int t0 = b * SEQ + c * CH; ssd_finish_rows(ob, YS1 + (size_t)t0 * 512 + hh * 64, SSQ + (size_t)t0 * 8 + hd, lt, st, g0, g1); ssd_load_gates(YS1 + (size_t)(t0 + CH) * 512 + hh * 64, lt, g0, g1); }
            if (c + 2 < NCH) { SSD_WRITE(srA, eA, 0); if (c + 4 < NCH) SSD_LOAD(srA, eA, c + 4); }
            LBAR(); LBAR(); }
        { const int t0 = b * SEQ + (NCH - 1) * CH; ssd_finish_rows(ob, YS1 + (size_t)t0 * 512 + hh * 64, SSQ + (size_t)t0 * 8 + hd, lt, st, g0, g1); }
#undef SSD_LOAD
#undef SSD_WRITE
        return;
    }
    if (C.wave >= 2) {
        LBAR();
#pragma unroll 1
        for (int c = 0; c < NCH; ++c) { LBAR(); LBAR(); }
        return;
    }
    const int ps = C.wave & 1; int lane_ = C.lane;
    f32x16 Sn[4] = {zero16(), zero16(), zero16(), zero16()};
    const float* gel = (const float*)(C.ws + WS_SMALL + SM_ELAST) + (b * NCH) * 8 + hd; float eln = gel[0];
    LBAR();
#pragma unroll 1
    for (int c = 0; c < NCH; ++c) {
        asm volatile("" : "+v"(lane_)); const int r = lane_ & 31, hl = lane_ >> 5, p = 32 * ps + r;
        LAS unsigned char* B = lds + (c & 1) * SB_STRIDE;
        const LAS bf16* cl = (const LAS bf16*)B; const LAS bf16* ml = (const LAS bf16*)(B + 17408); const LAS bf16* bwl = (const LAS bf16*)(B + 26624); const LAS bf16* xtl = (const LAS bf16*)(B + 45056);
        const LAS float* ecl = (const LAS float*)(lds + DEC_OFF) + (c & 1) * 64; const float elast = eln; eln = gel[(c + 1 < NCH ? c + 1 : c) * 8];
        f32x16 y[2] = {zero16(), zero16()};
#define LDW(f, T, kt) do { f[0] = LDF(T, r, LDK, 32 * (kt) + 8 * hl); f[1] = LDF(T, r, LDK, 32 * (kt) + 16 + 8 * hl); f[2] = LDF(T, 32 + r, LDK, 32 * (kt) + 8 * hl); f[3] = LDF(T, 32 + r, LDK, 32 * (kt) + 16 + 8 * hl); } while (0)
#define MMW(f, acc) do { acc[0] = MFMA32(f[0], b0, acc[0]); acc[0] = MFMA32(f[1], b1, acc[0]); acc[1] = MFMA32(f[2], b0, acc[1]); acc[1] = MFMA32(f[3], b1, acc[1]); } while (0)
        bf16x8 fA[4], fB[4], bx[4]; f32x4 ec[8];
        LDW(fA, cl, 0);
#pragma unroll
        for (int ks = 0; ks < 4; ++ks) bx[ks] = LDF(xtl, p, LDC, 16 * ks + 8 * hl);
#pragma unroll
        for (int q = 0; q < 8; ++q) ec[q] = *(const LAS f32x4*)(ecl + 32 * (q >> 2) + 8 * (q & 3) + 4 * hl);
        SB0();
        { bf16x8 b0 = pack_step<0>(Sn[0]), b1 = pack_step<1>(Sn[0]);
          LDW(fB, cl, 1); SB0(); MMW(fA, y); SB0();
          b0 = pack_step<0>(Sn[1]); b1 = pack_step<1>(Sn[1]);
          LDW(fA, cl, 2); SB0(); MMW(fB, y); SB0();
          b0 = pack_step<0>(Sn[2]); b1 = pack_step<1>(Sn[2]);
          LDW(fB, cl, 3); SB0(); MMW(fA, y); SB0();
          b0 = pack_step<0>(Sn[3]); b1 = pack_step<1>(Sn[3]);
          LDA2(fA, ml, 0, 1); SB0(); MMW(fB, y); SB0(); }
#pragma unroll
        for (int q = 0; q < 8; ++q) { y[q >> 2][4 * (q & 3)] *= ec[q][0]; y[q >> 2][4 * (q & 3) + 1] *= ec[q][1]; y[q >> 2][4 * (q & 3) + 2] *= ec[q][2]; y[q >> 2][4 * (q & 3) + 3] *= ec[q][3]; }
        SB0();
        LDA2(fB, ml, 2, 3); SB0(); MMA2(fA, bx, 0, 1, y); SB0();
#pragma unroll
        for (int nt = 0; nt < 4; ++nt) Sn[nt] = Sn[nt] * elast;
        LDR4(fA, bwl, 0); SB0(); MMA2(fB, bx, 2, 3, y); SB0();
        LDR4(fB, bwl, 32); SB0(); MMR4(fA, bx, Sn[0]); SB0();
        LDR4(fA, bwl, 64); SB0(); MMR4(fB, bx, Sn[1]); SB0();
        LDR4(fB, bwl, 96); SB0(); MMR4(fA, bx, Sn[2]); SB0();
        MMR4(fB, bx, Sn[3]); SB0();
#undef LDW
#undef MMW
#undef LDA2
#undef MMA2
#undef LDR4
#undef MMR4
        LBAR();
        stage_out(ob, y, p, hl);
        LBAR();
    }
    const int r = lane_ & 31, hl = lane_ >> 5, p = 32 * ps + r;
    float* so = C.out + O_PSSD + ((((size_t)l * 8 + b) * 8 + hd) * 64 + p) * 128;
#pragma unroll
    for (int nt = 0; nt < 4; ++nt)
#pragma unroll
        for (int i = 0; i < 16; ++i) if (st) so[32 * nt + crow(i, hl)] = Sn[nt][i];
}
struct TailStore { bf16* O; int ldc; bool sig, gates;
    __device__ __forceinline__ void operator()(int row, int col, const float (&v)[4]) const { float x[4];
        if (gates) col = col >= 2048 ? col - 1024 : ((col & 128) ? 2048 : 0) + (col >> 8) * 128 + (col & 127);
#pragma unroll
        for (int e = 0; e < 4; ++e) x[e] = sig ? fmaxf(sigmoid_f(v[e]), 1e-30f) : v[e];
        v2u w; w.x = pkbf(x[0], x[1]); w.y = pkbf(x[2], x[3]); *(GAS v2u*)(O + (size_t)row * ldc + col) = w; } };
struct TailBranch { const bf16* G; int goff; bf16* O; const float* ssq; int grp; bool first;
    __device__ __forceinline__ void operator()(int row, int col, const float (&v)[4]) const {
        float rsc = 1.f; if (ssq) { const f32x4 q4 = *(const GAS f32x4*)(ssq + (size_t)row * 8 + grp * 4); rsc = rsqrtf(((q4[0] + q4[1]) + (q4[2] + q4[3])) * (1.f / 256.f) + EPS); }
        const v2u g = *(const GAS v2u*)(G + (size_t)row * NG + goff + col); bf16* op = O + (size_t)row * DM + col; float x[4] = {v[0] * blo(g.x) * rsc, v[1] * bhi(g.x) * rsc, v[2] * blo(g.y) * rsc, v[3] * bhi(g.y) * rsc};
        if (!first) { const v2u o = __builtin_nontemporal_load((const v2u*)op);
            x[0] += blo(o.x); x[1] += bhi(o.x); x[2] += blo(o.y); x[3] += bhi(o.y); }
        v2u w; w.x = pkbf(x[0], x[1]); w.y = pkbf(x[2], x[3]); *(GAS v2u*)op = w; } };
template <int K, int LD = K, class Epi> __device__ __forceinline__ void tail_gemm(const Ctx& C_, const bf16* A  , const bf16* Bt  , int N, const Epi& E) {
    Ctx C = C_; asm volatile("v_mbcnt_lo_u32_b32 %0, -1, 0\n\tv_mbcnt_hi_u32_b32 %0, -1, %0" : "=v"(C.lane)); C.tid = C.wave * 64 + C.lane;
    LAS float* red = (LAS float*)lds_v(C);
    constexpr int kw = K >> 3, nst = kw >> 4; const int r = C.lane & 31, hl = C.lane >> 5, nitems = 8 * (N >> 5);
    for (int it = C.vcu; it < nitems; it += C.G) {
        const int rb = it & 7, cb = it >> 3;
        const bf16* ap0 = A + (size_t)(rb * 64 + r) * LD + C.wave * kw + 8 * hl; const bf16* ap1 = ap0 + (size_t)32 * LD; const bf16* bp = Bt + (size_t)(cb * 32 + r) * LD + C.wave * kw + 8 * hl;
        f32x16 acc0 = zero16(), acc1 = zero16();
#pragma unroll
        for (int k0 = 0; k0 < nst; k0 += 8) { constexpr int NB8 = 8; bf16x8 fa0[NB8], fa1[NB8], fbb[NB8];
#pragma unroll
            for (int j = 0; j < NB8; ++j) if (k0 + j < nst) { fa0[j] = ldg8(ap0 + 16 * (k0 + j)); fa1[j] = ldg8(ap1 + 16 * (k0 + j)); fbb[j] = ldg8(bp + 16 * (k0 + j)); }
            __builtin_amdgcn_sched_barrier(0);
#pragma unroll
            for (int j = 0; j < NB8; ++j) if (k0 + j < nst) { acc0 = MFMA32(fa0[j], fbb[j], acc0); acc1 = MFMA32(fa1[j], fbb[j], acc1); }
            __builtin_amdgcn_sched_barrier(0); }
        LBAR();
#pragma unroll
        for (int i = 0; i < 16; ++i) { red[((C.wave * 2 + 0) * 16 + i) * 64 + C.lane] = acc0[i]; red[((C.wave * 2 + 1) * 16 + i) * 64 + C.lane] = acc1[i]; }
        LBAR();
        { const int row = C.tid >> 3, c4 = (C.tid & 7) * 4, tt = row >> 5, rr = row & 31, hs = (rr >> 2) & 1, i = (rr & 3) + 4 * (rr >> 3); float v[4] = {0.f, 0.f, 0.f, 0.f};
#pragma unroll
          for (int w = 0; w < 8; ++w) { const f32x4 x = *(const LAS f32x4*)(red + ((w * 2 + tt) * 16 + i) * 64 + 32 * hs + c4); v[0] += x[0]; v[1] += x[1]; v[2] += x[2]; v[3] += x[3]; }
          E(T_P + rb * 64 + row, cb * 32 + c4, v); }
    }
    LBAR();
}
__device__ __forceinline__ void tail_branch_chain(const Ctx& C_, const bf16* YSb, const bf16* Wb, const bf16* G, const float* ssq, bf16* O) {
    Ctx C = C_; asm volatile("v_mbcnt_lo_u32_b32 %0, -1, 0\n\tv_mbcnt_hi_u32_b32 %0, -1, %0" : "=v"(C.lane)); C.tid = C.wave * 64 + C.lane;
    LAS float* red = (LAS float*)lds_v(C);
    const int r = C.lane & 31, hl = C.lane >> 5;
    for (int it = C.vcu; it < 256; it += C.G) {
        const int rb = it & 7, cb = it >> 3;
        const bf16* a0 = YSb + (size_t)(T_P + rb * 64 + r) * 512 + 8 * hl; const bf16* b0 = Wb + (size_t)(cb * 32 + r) * 512 + 8 * hl;
        const int row = C.tid >> 3, c4 = (C.tid & 7) * 4, tt = row >> 5, rr = row & 31, hs = (rr >> 2) & 1, ii = (rr & 3) + 4 * (rr >> 3); const size_t grow = (size_t)(T_P + rb * 64 + row); const int col = cb * 32 + c4;
        bf16x8 fa[8], fb[4], ga[8], gb[4];
#define TBC_LD(A, B, ap, bp, kw, n) do { _Pragma("unroll") for (int j = 0; j < (n); ++j) { A[j] = ldg8((ap) + C.wave * (kw) + 16 * j); A[4 + j] = ldg8((ap) + (size_t)32 * 512 + C.wave * (kw) + 16 * j); B[j] = ldg8((bp) + C.wave * (kw) + 16 * j); } } while (0)
#define TBC_MM(A, B, n) do { acc0 = zero16(); acc1 = zero16(); _Pragma("unroll") for (int j = 0; j < (n); ++j) { acc0 = MFMA32(A[j], B[j], acc0); acc1 = MFMA32(A[4 + j], B[j], acc1); } } while (0)
#define TBC_RED(v) do { LBAR(); _Pragma("unroll") for (int i = 0; i < 16; ++i) { red[((C.wave * 2 + 0) * 16 + i) * 64 + C.lane] = acc0[i]; red[((C.wave * 2 + 1) * 16 + i) * 64 + C.lane] = acc1[i]; } LBAR(); \
            v[0] = 0.f; v[1] = 0.f; v[2] = 0.f; v[3] = 0.f; _Pragma("unroll") for (int w = 0; w < 8; ++w) { const f32x4 x = *(const LAS f32x4*)(red + ((w * 2 + tt) * 16 + ii) * 64 + 32 * hs + c4); v[0] += x[0]; v[1] += x[1]; v[2] += x[2]; v[3] += x[3]; } } while (0)
        TBC_LD(fa, fb, a0, b0, 64, 4);
        const v2u g_gla = *(const GAS v2u*)(G + grow * NG + col), g_ssd = *(const GAS v2u*)(G + grow * NG + 1024 + col), g_gdn = *(const GAS v2u*)(G + grow * NG + 2048 + col);
        const f32x4 qa = *(const GAS f32x4*)(ssq + grow * 8), qb = *(const GAS f32x4*)(ssq + grow * 8 + 4);
        __builtin_amdgcn_sched_barrier(0);
        f32x16 acc0, acc1; float v[4], tot[4];
        TBC_LD(ga, gb, a0 + (size_t)2 * T_ALL * 512, b0 + (size_t)DM * 512, 64, 4); __builtin_amdgcn_sched_barrier(0);
        TBC_MM(fa, fb, 4); TBC_RED(v);
        tot[0] = v[0] * blo(g_gla.x); tot[1] = v[1] * bhi(g_gla.x); tot[2] = v[2] * blo(g_gla.y); tot[3] = v[3] * bhi(g_gla.y);
        __builtin_amdgcn_sched_barrier(0);
        TBC_LD(fa, fb, a0 + (size_t)T_ALL * 512, b0 + (size_t)2 * DM * 512, 32, 2); __builtin_amdgcn_sched_barrier(0);
        TBC_MM(ga, gb, 4); TBC_RED(v);
        tot[0] += v[0] * blo(g_gdn.x); tot[1] += v[1] * bhi(g_gdn.x); tot[2] += v[2] * blo(g_gdn.y); tot[3] += v[3] * bhi(g_gdn.y);
        __builtin_amdgcn_sched_barrier(0);
        TBC_LD(ga, gb, a0 + (size_t)T_ALL * 512 + 256, b0 + (size_t)2 * DM * 512 + 256, 32, 2); __builtin_amdgcn_sched_barrier(0);
        const float rs0 = rsqrtf(((qa[0] + qa[1]) + (qa[2] + qa[3])) * (1.f / 256.f) + EPS), rs1 = rsqrtf(((qb[0] + qb[1]) + (qb[2] + qb[3])) * (1.f / 256.f) + EPS);
        TBC_MM(fa, fb, 2); TBC_RED(v);
        tot[0] += v[0] * (blo(g_ssd.x) * rs0); tot[1] += v[1] * (bhi(g_ssd.x) * rs0); tot[2] += v[2] * (blo(g_ssd.y) * rs0); tot[3] += v[3] * (bhi(g_ssd.y) * rs0);
        __builtin_amdgcn_sched_barrier(0);
        TBC_MM(ga, gb, 2); TBC_RED(v);
        tot[0] += v[0] * (blo(g_ssd.x) * rs1); tot[1] += v[1] * (bhi(g_ssd.x) * rs1); tot[2] += v[2] * (blo(g_ssd.y) * rs1); tot[3] += v[3] * (bhi(g_ssd.y) * rs1);
        v2u w; w.x = pkbf(tot[0], tot[1]); w.y = pkbf(tot[2], tot[3]); *(GAS v2u*)(O + grow * DM + col) = w;
#undef TBC_LD
#undef TBC_MM
#undef TBC_RED
    }
    LBAR();
}
constexpr size_t MOD_S_OFF = SCR_GDN;
__device__ __forceinline__ void mod_prepare(const Ctx& C) {
    bf16* Shi = (bf16*)(C.ws + MOD_S_OFF); bf16* Slo = Shi + 160 * 1024;
    for (int idx = C.vcu * NTHR + C.tid; idx < 160 * 1024; idx += C.G * NTHR) { const int bi = idx >> 10, k = idx & 1023; float v = 0.f;
        if (bi < NBC) v = silu_f(bi < 8 ? C.in[I_CP][bi * DM + k] : C.in[I_CS][(bi - 8) * DM + k]);
        const unsigned p = pkbf(v, 0.f); Shi[idx] = (bf16)(p & 0xffffu); Slo[idx] = f2b(v - blo(p)); }
}
__device__ __forceinline__ void mod_mfma(const Ctx& C_) {
    Ctx C = C_; asm volatile("v_mbcnt_lo_u32_b32 %0, -1, 0\n\tv_mbcnt_hi_u32_b32 %0, -1, %0" : "=v"(C.lane)); C.tid = C.wave * 64 + C.lane;
    const bf16* Shi = (const bf16*)(C.ws + MOD_S_OFF); const bf16* Slo = Shi + 160 * 1024; float* mod = (float*)(C.ws + WS_MOD);
    LAS float* red = (LAS float*)lds_v(C);
    const int r = C.lane & 31, hl = C.lane >> 5, kb = C.wave * 128 + 8 * hl;
    for (int item = C.vcu; item < 320; item += C.G) {
        const int l = item < 128 ? 0 : 1, nt = item < 128 ? 64 + item : item - 128;
        const float* W = C.in[I_WADA] + (size_t)l * DM * 6144 + 32 * nt + r;
        bf16x8 bh[8], bl[8];
#pragma unroll
        for (int half = 0; half < 2; ++half) { float wv[4][8];
#pragma unroll
          for (int ks = 0; ks < 4; ++ks)
#pragma unroll
              for (int j = 0; j < 8; ++j) wv[ks][j] = W[(size_t)(kb + 16 * (4 * half + ks) + j) * 6144];
#pragma unroll
          for (int ks = 0; ks < 4; ++ks) { v4u ph, pl;
#pragma unroll
              for (int q = 0; q < 4; ++q) { ph[q] = pkbf(wv[ks][2 * q], wv[ks][2 * q + 1]); pl[q] = pkbf(wv[ks][2 * q] - blo(ph[q]), wv[ks][2 * q + 1] - bhi(ph[q])); }
              bh[4 * half + ks] = __builtin_bit_cast(bf16x8, ph); bl[4 * half + ks] = __builtin_bit_cast(bf16x8, pl); }
          __builtin_amdgcn_sched_barrier(0); }
        const unsigned soff = (unsigned)(r * 1024 + kb) * 2u;
#pragma unroll 1
        for (int t = 0; t < 5; ++t) { bf16x8 ah[8], al[8]; const char* sh = (const char*)Shi + (size_t)t * 65536 + soff; const char* sl = (const char*)Slo + (size_t)t * 65536 + soff;
#pragma unroll
            for (int ks = 0; ks < 8; ++ks) { ah[ks] = *(const GAS bf16x8*)(sh + 32 * ks); al[ks] = *(const GAS bf16x8*)(sl + 32 * ks); }
            f32x16 acc = zero16();
#pragma unroll
            for (int ks = 0; ks < 8; ++ks) { acc = MFMA32(ah[ks], bh[ks], acc); acc = MFMA32(al[ks], bh[ks], acc); acc = MFMA32(ah[ks], bl[ks], acc); }
            LBAR();
#pragma unroll
            for (int i = 0; i < 16; ++i) red[(C.wave * 16 + i) * 64 + C.lane] = acc[i];
            LBAR();
#pragma unroll
            for (int h2 = 0; h2 < 2; ++h2) { const int e = C.tid + 512 * h2, i = e >> 6, ln = e & 63, bi = 32 * t + crow(i, ln >> 5), n = 32 * nt + (ln & 31); float s = 0.f;
#pragma unroll
                for (int w = 0; w < 8; ++w) s += red[(w * 16 + i) * 64 + ln];
                if (bi < NBC) mod[((size_t)l * NBC + bi) * 6144 + n] = s + C.in[I_BADA][l * 6144 + n]; } }
    }
    LBAR();
}
constexpr size_t WS_RSD = WS_SSQ + MiB;
__device__ __forceinline__ void rstd_table(const Ctx& C) {
    const float* ssq = (const float*)(C.ws + WS_SSQ); float* rsd = (float*)(C.ws + WS_RSD);
    for (int row = C.vcu * NTHR + C.tid; row < T_P; row += C.G * NTHR) { const f32x4 qa = *(const GAS f32x4*)(ssq + (size_t)row * 8), qb = *(const GAS f32x4*)(ssq + (size_t)row * 8 + 4);
        f32x2 o; o[0] = rsqrtf(((qa[0] + qa[1]) + (qa[2] + qa[3])) * (1.f / 256.f) + EPS); o[1] = rsqrtf(((qb[0] + qb[1]) + (qb[2] + qb[3])) * (1.f / 256.f) + EPS); *(GAS f32x2*)(rsd + (size_t)row * 2) = o; }
}
__device__ __forceinline__ void mixer_precompute(const Ctx& C, int l, bool dry) {
    const bf16* U = (const bf16*)(C.ws + WS_U);
    for (int idx = C.vcu * NTHR + C.tid; idx < 8 * 3 * 2560; idx += C.G * NTHR) { const int bj = idx / 2560, ch = idx % 2560, b = bj / 3, j = bj % 3; const size_t row = (size_t)(b * SEQ + SEQ - 3 + j) * NU;
        if (ch < 1024) C.out[O_PCS + ((size_t)(l * 8 + b) * 3 + j) * 1024 + ch] = bf2f(U[row + C_SXBC + ch]);
        else C.out[O_PCD + ((size_t)(l * 8 + b) * 3 + j) * 1536 + (ch - 1024)] = bf2f(U[row + C_DQKV + (ch - 1024)]); }
    for (int u = C.vcu; u < 2560; u += C.G) {
        const bool st = !dry || C.G == 77777;
        if (u < 1024) { if (!dry || (PROBE_PRE & 1)) m1_gdn(C, l, u >> 7, (u >> 2) & 31, u & 3); }
        else if (u < 2048) { if (!dry || (PROBE_PRE & 4)) { const int q = u - 1024; m1_gla(C, l, q >> 7, (q >> 2) & 31, q & 3, st); } }
        else { if (!dry || (PROBE_PRE & 2)) { const int q = u - 2048; m1_ssd(C, l, q >> 6, (q >> 1) & 31, q & 1); } }
    }
}
__device__ __forceinline__ void mixer_scan_and_sample(const Ctx& C, int l, bool dry) {
    const int bx = blockIdx.x;
    const bool st = !dry || C.G == 77777;
    if (!dry || PROBE_SCAN != 2) {
    if (bx < 32) gdn_scan(C, l, bx >> 2, bx & 3, st);
    else if (bx < 64) gla_scan(C, l, (bx - 32) >> 2, bx & 3, st);
    else if (bx < 128) ssd_scan(C, l, (bx - 64) >> 3, bx & 7, st); }
    if (dry && PROBE_SCAN == 3) return;
    unsigned* ctr = (unsigned*)(C.ws + WS_CTL) + 8192 + (l * 2 + (dry ? 1 : 0)) * 64;
    volatile LAS unsigned* slot = (volatile LAS unsigned*)(C.lds + MISC_OFF) + 16;
    LBAR();
    if (C.tid == 0) slot[0] = __hip_atomic_fetch_add(ctr, 1u, __ATOMIC_RELAXED, __HIP_MEMORY_SCOPE_AGENT);
    LBAR();
    unsigned u = slot[0];
    while (u < 1280u) {
        unsigned nxt = 0; if (C.tid == 0) nxt = __hip_atomic_fetch_add(ctr, 1u, __ATOMIC_RELAXED, __HIP_MEMORY_SCOPE_AGENT);
        if (u < 512u) sample_gdn(C, l, (int)u >> 2, (int)u & 3);
        else if (u < 1024u) sample_gla(C, l, (int)(u - 512u) >> 2, (int)u & 3);
        else sample_ssd(C, l, (int)(u - 1024u) >> 1, (int)u & 1);
        LBAR();
        if (C.tid == 0) slot[0] = nxt;
        LBAR();
        u = slot[0];
    }
}

constexpr int N_PHASES = 22;
__global__ void __launch_bounds__(NTHR, 2) mega_fwd(Args args) {
    extern __shared__ __attribute__((aligned(16))) unsigned char lds_raw[];
    Ctx C;
    C.lds = (LAS unsigned char*)lds_raw;
    C.tid = threadIdx.x; C.lane = C.tid & 63; C.wave = __builtin_amdgcn_readfirstlane(C.tid >> 6);
    C.G = gridDim.x; { const int bx = blockIdx.x; C.vcu = (C.G % 8 == 0) ? (bx % 8) * (C.G / 8) + bx / 8 : bx; }
    C.in = args.in; C.out = args.out; C.ws = args.ws;
    volatile LAS unsigned* MISC = (volatile LAS unsigned*)(C.lds + MISC_OFF);
    for (int u = C.tid; u < (LDS_BYTES - LDSCTL_OFF) / 4; u += NTHR) ((LAS unsigned*)(C.lds + LDSCTL_OFF))[u] = 0u;
    __syncthreads();
    int lo = args.ph_lo, hi = args.ph_hi, zoff = 0;
    const bool single = (hi - lo) > 1;
    XcdBarrier bar; bar.bar = (unsigned*)(C.ws + WS_CTL) + CW_BAR; bar.x = 0; bar.st = nullptr;
    if (single) bar = xcd_barrier_post((unsigned*)(C.ws + WS_CTL) + CW_BAR, MISC + 8, C.tid == 0);
#define IN(k) (lo <= (k) && (k) < hi)
#define SEAM(k) do { asm volatile("v_mbcnt_lo_u32_b32 %0, -1, 0\n\tv_mbcnt_hi_u32_b32 %0, -1, %0" : "=v"(C.lane)); C.tid = C.wave * 64 + C.lane;     asm volatile("" : "+s"(C.vcu), "+s"(C.wave), "+s"(lo), "+s"(hi)); asm volatile("" : "+s"(zoff)); C.in = args.in + zoff; C.ws = args.ws + zoff; C.out = args.out + zoff; if (IN(k) && IN((k) + 1)) { if ((k) == 0 && C.G == 77777) cg::this_grid().sync();   xcd_barrier(bar, C.tid == 0); } } while (0)
#define wb (C.ws + WS_W)
#define H ((bf16*)(C.ws + WS_H))
#define YS ((bf16*)(C.ws + WS_YS))
#define U ((bf16*)(C.ws + WS_U))
#define Gt ((bf16*)(C.ws + WS_G))
#define MERGED ((bf16*)(C.ws + WS_MERGED))
#define MIX ((bf16*)(C.ws + WS_MIX))
#define HID ((bf16*)(C.ws + WS_HID))
#define Fo ((bf16*)(C.ws + WS_F))

    if (IN(0)) _Pragma("unroll 1") for (int rep = 0; rep < 1 + PROBE_PRO; ++rep) { mod_prepare(C); compute_mod(C); convert_weights(C, 0); } SEAM(0);
    if (IN(1)) { mod_mfma(C); phase_prenorm0(C); } SEAM(1);
    { constexpr int l = 0;
        const int pb = 2 + 10 * l;
        if (IN(pb + 0)) _Pragma("unroll 1") for (int rep = 0; rep < 1 + ((PROBE_GEMM & 1) != 0); ++rep) {
            pg8::Gemm g{H, (const bf16*)(wb + W_IN), T_ALL, NU, DM, 0, 0}; pg8::StaticOrder S; S.init(T_ALL, NU, C.G, (int)blockIdx.x);
            pg8::EpiStore<0> E{U, NU}; pg8::gemm_phase<pg8::EpiStore<0>, pg8::StaticOrder, true, true>(C.lds, g, S, E, C.wave); }
        SEAM(pb + 0);
        if (IN(pb + 1)) _Pragma("unroll 1") for (int rep = (PROBE_PRE != 0); rep >= 0; --rep) { mixer_precompute(C, l, rep != 0); }
        SEAM(pb + 1);
        if (IN(pb + 2)) _Pragma("unroll 1") for (int rep = (PROBE_SCAN != 0); rep >= 0; --rep) { mixer_scan_and_sample(C, l, rep != 0); }
        SEAM(pb + 2);
        if (IN(pb + 3)) _Pragma("unroll 1") for (int rep = 0; rep < 1 + ((PROBE_GEMM & 2) != 0); ++rep) {
            const unsigned char* a8 = (const unsigned char*)C.out + 2048; const unsigned char* b8 = (const unsigned char*)C.out + 3072; asm volatile("" : "+s"(a8)); asm volatile("" : "+s"(b8));
            pg8::Gemm g{(const bf16*)a8, (const bf16*)b8, T_P, NG, 512, 0, 0, 2048}; pg8::StaticOrder S; S.init(T_P, NG, C.G, (int)blockIdx.x);
            pg8::EpiGates E{Gt, NG, 1.f / 32.f}; pg8::gemm_phase<pg8::EpiGates, pg8::StaticOrder, true, true, false, true>(C.lds, g, S, E, C.wave);
            if (rep == 0) { TailStore TE{Gt, NG, true, true}; tail_gemm<DM>(C, H + (size_t)T_P * DM, (const bf16*)(wb + W_G), NG, TE); rstd_table(C); } }
        SEAM(pb + 3);
        if (IN(pb + 4)) _Pragma("unroll 1") for (int rep = 0; rep < 1 + ((PROBE_GEMM & 4) != 0); ++rep) {
            { pg8::Gemm g{YS, (const bf16*)(wb + W_B), T_P, DM, 512, 0, 0, 512}; pg8::Chain4Order S; S.init(T_P, DM, C.G, (int)blockIdx.x);
              pg8::EpiChain E{Gt, NG, MERGED, DM, (const float*)(C.ws + WS_RSD), (long)2 * T_ALL * 512, (long)T_ALL * 512, (long)DM * 512, (long)2 * DM * 512};
              pg8::gemm_phase<pg8::EpiChain, pg8::Chain4Order, true, true>(C.lds, g, S, E, C.wave); }
            if (rep == 0) tail_branch_chain(C, YS, (const bf16*)(wb + W_B), Gt, (const float*)(C.ws + WS_SSQ), MERGED); }
        SEAM(pb + 4);
        if (IN(pb + 5)) _Pragma("unroll 1") for (int rep = 0; rep < 1 + ((PROBE_GEMM & 8) != 0); ++rep) {
            pg8::Gemm g{MERGED, (const bf16*)(wb + W_O), T_P, DM, DM, 0, 0}; pg8::StaticOrder S; S.init(T_P, DM, C.G, (int)blockIdx.x);
            pg8::EpiStore<0> E{MIX, DM}; pg8::gemm_phase<pg8::EpiStore<0>, pg8::StaticOrder, true, true>(C.lds, g, S, E, C.wave);
            if (rep == 0) { TailStore TE{MIX, DM, false, false}; tail_gemm<DM>(C, MERGED + (size_t)T_P * DM, (const bf16*)(wb + W_O), DM, TE); } }
        SEAM(pb + 5);
        if (IN(pb + 6)) _Pragma("unroll 1") for (int rep = PROBE_ROWS; rep >= 0; --rep) { phase_rows(C, MIX, l, 2, C.in[I_GPOSTM] + l * DM, true, C.in[I_GPREF] + l * DM, l, 4, 3, rep == 0 || C.G == 77777, l == 0); }
        SEAM(pb + 6);
        if (IN(pb + 7)) _Pragma("unroll 1") for (int rep = 0; rep < 1 + ((PROBE_GEMM & 16) != 0); ++rep) {
            pg8::Gemm g{H, (const bf16*)(wb + W_F1), T_ALL, NF1, DM, 0, 0}; pg8::StaticOrder S; S.init(T_ALL, NF1, C.G, (int)blockIdx.x);
            pg8::EpiSwiGLU E{C.ws + WS_HID, (bf16*)(C.ws + WS_HIDS), FH, 8.f}; pg8::gemm_phase<pg8::EpiSwiGLU, pg8::StaticOrder, true, true>(C.lds, g, S, E, C.wave);
            if (rep == 0) { const int nwg = (T_ALL / 256) * (NF1 / 256), rounds = (nwg + C.G - 1) / C.G, first_idle = nwg - (rounds - 1) * C.G;
                if (first_idle >= C.G) convert_f2_fp8(C, l, C.vcu, C.G); else if ((int)blockIdx.x >= first_idle) convert_f2_fp8(C, l, (int)blockIdx.x - first_idle, C.G - first_idle); } }
        SEAM(pb + 7);
        if (IN(pb + 8)) _Pragma("unroll 1") for (int rep = 0; rep < 1 + ((PROBE_GEMM & 32) != 0); ++rep) {
            pg8::Gemm g{(const bf16*)(C.ws + WS_HID), (const bf16*)(C.ws + WS_F2Q), T_P, DM, FH / 2, 0, 0}; pg8::StaticOrder S; S.init(T_P, DM, C.G, (int)blockIdx.x);
            pg8::EpiStore<0, true> E{Fo, DM, 1.f / 256.f}; pg8::gemm_phase<pg8::EpiStore<0, true>, pg8::StaticOrder, true, true, false, true>(C.lds, g, S, E, C.wave);
            if (rep == 0) { TailStore TE{Fo, DM, false, false}; tail_gemm<FH>(C, (const bf16*)(C.ws + WS_HIDS), (const bf16*)(wb + W_F2), DM, TE); } }
        SEAM(pb + 8);
        if (IN(pb + 9)) { phase_rows(C, Fo, l, 5, C.in[I_GPOSTF] + l * DM, l == 0, C.in[I_GPREM] + DM, 1, 1, 0, true, false, l == 1, l == 0); if (l == 0) convert_weights(C, 1); }
        if (l == 0) SEAM(pb + 9);
        }
    { constexpr int l = 1;
        const int pb = 2 + 10 * l;
        if (IN(pb + 0)) _Pragma("unroll 1") for (int rep = 0; rep < 1 + ((PROBE_GEMM & 1) != 0); ++rep) {
            pg8::Gemm g{H, (const bf16*)(wb + W_IN), T_ALL, NU, DM, 0, 0}; pg8::StaticOrder S; S.init(T_ALL, NU, C.G, (int)blockIdx.x);
            pg8::EpiStore<0> E{U, NU}; pg8::gemm_phase<pg8::EpiStore<0>, pg8::StaticOrder, true, true>(C.lds, g, S, E, C.wave); }
        SEAM(pb + 0);
        if (IN(pb + 1)) _Pragma("unroll 1") for (int rep = (PROBE_PRE != 0); rep >= 0; --rep) { mixer_precompute(C, l, rep != 0); }
        SEAM(pb + 1);
        if (IN(pb + 2)) _Pragma("unroll 1") for (int rep = (PROBE_SCAN != 0); rep >= 0; --rep) { mixer_scan_and_sample(C, l, rep != 0); }
        SEAM(pb + 2);
        if (IN(pb + 3)) _Pragma("unroll 1") for (int rep = 0; rep < 1 + ((PROBE_GEMM & 2) != 0); ++rep) {
            const unsigned char* a8 = (const unsigned char*)C.out + 2048; const unsigned char* b8 = (const unsigned char*)C.out + 3072; asm volatile("" : "+s"(a8)); asm volatile("" : "+s"(b8));
            pg8::Gemm g{(const bf16*)a8, (const bf16*)b8, T_P, NG, 512, 0, 0, 2048}; pg8::StaticOrder S; S.init(T_P, NG, C.G, (int)blockIdx.x);
            pg8::EpiGates E{Gt, NG, 1.f / 32.f}; pg8::gemm_phase<pg8::EpiGates, pg8::StaticOrder, true, true, false, true>(C.lds, g, S, E, C.wave);
            if (rep == 0) { TailStore TE{Gt, NG, true, true}; tail_gemm<DM>(C, H + (size_t)T_P * DM, (const bf16*)(wb + W_G), NG, TE); rstd_table(C); } }
        SEAM(pb + 3);
        if (IN(pb + 4)) _Pragma("unroll 1") for (int rep = 0; rep < 1 + ((PROBE_GEMM & 4) != 0); ++rep) {
            { pg8::Gemm g{YS, (const bf16*)(wb + W_B), T_P, DM, 512, 0, 0, 512}; pg8::Chain4Order S; S.init(T_P, DM, C.G, (int)blockIdx.x);
              pg8::EpiChain E{Gt, NG, MERGED, DM, (const float*)(C.ws + WS_RSD), (long)2 * T_ALL * 512, (long)T_ALL * 512, (long)DM * 512, (long)2 * DM * 512};
              pg8::gemm_phase<pg8::EpiChain, pg8::Chain4Order, true, true>(C.lds, g, S, E, C.wave); }
            if (rep == 0) tail_branch_chain(C, YS, (const bf16*)(wb + W_B), Gt, (const float*)(C.ws + WS_SSQ), MERGED); }
        SEAM(pb + 4);
        if (IN(pb + 5)) _Pragma("unroll 1") for (int rep = 0; rep < 1 + ((PROBE_GEMM & 8) != 0); ++rep) {
            pg8::Gemm g{MERGED, (const bf16*)(wb + W_O), T_P, DM, DM, 0, 0}; pg8::StaticOrder S; S.init(T_P, DM, C.G, (int)blockIdx.x);
            pg8::EpiStore<0> E{MIX, DM}; pg8::gemm_phase<pg8::EpiStore<0>, pg8::StaticOrder, true, true>(C.lds, g, S, E, C.wave);
            if (rep == 0) { TailStore TE{MIX, DM, false, false}; tail_gemm<DM>(C, MERGED + (size_t)T_P * DM, (const bf16*)(wb + W_O), DM, TE); } }
        SEAM(pb + 5);
        if (IN(pb + 6)) _Pragma("unroll 1") for (int rep = PROBE_ROWS; rep >= 0; --rep) { phase_rows(C, MIX, l, 2, C.in[I_GPOSTM] + l * DM, true, C.in[I_GPREF] + l * DM, l, 4, 3, rep == 0 || C.G == 77777, l == 0); }
        SEAM(pb + 6);
        if (IN(pb + 7)) _Pragma("unroll 1") for (int rep = 0; rep < 1 + ((PROBE_GEMM & 16) != 0); ++rep) {
            pg8::Gemm g{H, (const bf16*)(wb + W_F1), T_ALL, NF1, DM, 0, 0}; pg8::StaticOrder S; S.init(T_ALL, NF1, C.G, (int)blockIdx.x);
            pg8::EpiSwiGLU E{C.ws + WS_HID, (bf16*)(C.ws + WS_HIDS), FH, 8.f}; pg8::gemm_phase<pg8::EpiSwiGLU, pg8::StaticOrder, true, true>(C.lds, g, S, E, C.wave);
            if (rep == 0) { const int nwg = (T_ALL / 256) * (NF1 / 256), rounds = (nwg + C.G - 1) / C.G, first_idle = nwg - (rounds - 1) * C.G;
                if (first_idle >= C.G) convert_f2_fp8(C, l, C.vcu, C.G); else if ((int)blockIdx.x >= first_idle) convert_f2_fp8(C, l, (int)blockIdx.x - first_idle, C.G - first_idle); } }
        SEAM(pb + 7);
        if (IN(pb + 8)) _Pragma("unroll 1") for (int rep = 0; rep < 1 + ((PROBE_GEMM & 32) != 0); ++rep) {
            pg8::Gemm g{(const bf16*)(C.ws + WS_HID), (const bf16*)(C.ws + WS_F2Q), T_P, DM, FH / 2, 0, 0}; pg8::StaticOrder S; S.init(T_P, DM, C.G, (int)blockIdx.x);
            pg8::EpiStore<0, true> E{Fo, DM, 1.f / 256.f}; pg8::gemm_phase<pg8::EpiStore<0, true>, pg8::StaticOrder, true, true, false, true>(C.lds, g, S, E, C.wave);
            if (rep == 0) { TailStore TE{Fo, DM, false, false}; tail_gemm<FH>(C, (const bf16*)(C.ws + WS_HIDS), (const bf16*)(wb + W_F2), DM, TE); } }
        SEAM(pb + 8);
        if (IN(pb + 9)) { phase_rows(C, Fo, l, 5, C.in[I_GPOSTF] + l * DM, l == 0, C.in[I_GPREM] + DM, 1, 1, 0, true, false, l == 1, l == 0); if (l == 0) convert_weights(C, 1); }
        if (l == 0) SEAM(pb + 9);
        }
#undef IN
#undef SEAM
#undef wb
#undef H
#undef YS
#undef U
#undef Gt
#undef MERGED
#undef MIX
#undef HID
#undef Fo
}

extern "C" void kernel_launch(void* const* d_in, const int* in_sizes, int n_in, void* d_out, int out_size, void* d_ws, size_t ws_size, hipStream_t stream) {
    static int grid = 0;
    if (grid == 0) {
        if (n_in != 33 || (size_t)out_size != O_END || ws_size < WS_END) { fprintf(stderr, "kernel_launch: unexpected shapes: n_in %d out %d ws %zu (need %zu)\n", n_in, out_size, ws_size, (size_t)WS_END); grid = -1; return; }
        int dev = 0, cus = 0, per_cu = 0;
        if (hipGetDevice(&dev) != hipSuccess || hipDeviceGetAttribute(&cus, hipDeviceAttributeMultiprocessorCount, dev) != hipSuccess) { grid = -1; return; }
        if (hipFuncSetAttribute((const void*)mega_fwd, hipFuncAttributeMaxDynamicSharedMemorySize, LDS_BYTES) != hipSuccess) { fprintf(stderr, "kernel_launch: hipFuncSetAttribute failed\n"); grid = -1; return; }
        if (hipOccupancyMaxActiveBlocksPerMultiprocessor(&per_cu, (const void*)mega_fwd, NTHR, LDS_BYTES) != hipSuccess || per_cu < 1) { fprintf(stderr, "kernel_launch: occupancy query says %d\n", per_cu); per_cu = 1; }
        (void)hipGetLastError();
        grid = cus;
    }
    if (grid < 0) return;
    (void)hipMemsetAsync((char*)d_ws + WS_CTL, 0, CTL_ZERO_BYTES, stream);
    Args a{};
    for (int i = 0; i < 33; ++i) a.in[i] = (const float*)d_in[i];
    a.out = (float*)d_out; a.ws = (unsigned char*)d_ws;
#if MK_MULTI
    for (int p = 0; p < N_PHASES; ++p) { a.ph_lo = p; a.ph_hi = p + 1; hipLaunchKernelGGL(mega_fwd, dim3(grid), dim3(NTHR), LDS_BYTES, stream, a); }
#else
    a.ph_lo = 0; a.ph_hi = N_PHASES;
    void* kargs[] = {&a};
    hipError_t e = hipLaunchCooperativeKernel((const void*)mega_fwd, dim3(grid), dim3(NTHR), kargs, LDS_BYTES, stream);
    if (e != hipSuccess) fprintf(stderr, "kernel_launch: cooperative launch failed: %s (grid %d)\n", hipGetErrorString(e), grid);
#endif
}
```

```cpp
#include <hip/hip_runtime.h>
#include <hip/hip_cooperative_groups.h>
#include <cstdio>
#include <cstdint>
namespace cg = cooperative_groups;
#ifndef MK_MULTI
#define MK_MULTI 0
#endif
#ifndef PROBE_GEMM
#define PROBE_GEMM 0
#endif
#ifndef PROBE_PRE
#define PROBE_PRE 0
#endif
#ifndef PROBE_SCAN
#define PROBE_SCAN 0
#endif
#ifndef PROBE_SAMPLE
#define PROBE_SAMPLE 0
#endif
#ifndef PROBE_ROWS
#define PROBE_ROWS 0
#endif
#ifndef PROBE_PRO
#define PROBE_PRO 0
#endif
namespace pg8 {
#define PG8_LAS __attribute__((address_space(3)))
typedef unsigned short bf16_t;
typedef short bf16x8 __attribute__((ext_vector_type(8)));
typedef float f32x4 __attribute__((ext_vector_type(4)));
typedef unsigned u32x4 __attribute__((ext_vector_type(4)));
typedef int i32x8 __attribute__((ext_vector_type(8)));
typedef int i32x4 __attribute__((ext_vector_type(4)));
constexpr int BM = 256, BK = 64, HALF = 128, HTB = HALF * BK * 2  , STAGE_BYTES = 8 * HTB, NXCD = 8, WGM = 8;

__host__ __device__ __forceinline__ int lds_byte(int r, int c) { const int st = (r >> 4) * 2 + (c >> 5), rr = r & 15, cc = c & 31, ob = rr * 64 + cc * 2; return st * 1024 + (ob ^ (((ob >> 9) & 1) << 5)); }
__host__ __device__ __forceinline__ void stage_rc(int b, int& R, int& C) { const int st = b / 1024, sb = b % 1024, swz = sb ^ (((sb >> 9) & 1) << 5); R = (st >> 1) * 16 + swz / 64; C = (st & 1) * 32 + (swz % 64) / 2; }
__host__ __device__ __forceinline__ int perm32(int rho) { const int n = rho >> 4, i = rho & 15; return 8 * (i >> 2) + 4 * n + (i & 3); }

struct Unit { int pm, pn, kz; };
struct Gemm { const bf16_t* A; const bf16_t* Bt; int M, N, K; long a_z, b_z; int ld = 0; };

struct StaticOrder {
    int nM, nN, nwg, G, c;
    __host__ __device__ void init(int M, int N, int G_, int c_) { nM = M / BM; nN = N / BM; nwg = nM * nN; G = G_; c = c_; }
    __host__ __device__ bool next(int i, Unit& u) const {
        const long L = (long)i * G + c; if (L >= nwg) return false;
        int wgid = (int)L; { const int q = nwg / NXCD, r = nwg % NXCD, xcd = wgid % NXCD, off = wgid / NXCD; wgid = (xcd < r ? xcd * (q + 1) : r * (q + 1) + (xcd - r) * q) + off; }
        const int nig = WGM * nN, gid = wgid / nig, fm = gid * WGM, gsz = (nM - fm) < WGM ? (nM - fm) : WGM;
        u.pm = fm + ((wgid % nig) % gsz); u.pn = (wgid % nig) / gsz; u.kz = 0; return true;
    }
    __device__ __forceinline__ void a_ready(const Unit&) const {}
    __device__ __forceinline__ void done(const Unit&) const {}
};


__device__ __forceinline__ unsigned cvt_pk_bf16(float lo, float hi) { unsigned r; asm volatile("v_cvt_pk_bf16_f32 %0, %1, %2" : "=v"(r) : "v"(lo), "v"(hi)); return r; }
__device__ __forceinline__ float sigm(float x) { return __builtin_amdgcn_rcpf(1.f + __builtin_amdgcn_exp2f(-1.4426950408889634f * x)); }
__device__ __forceinline__ float bf_lo(unsigned u) { return __uint_as_float(u << 16); }
__device__ __forceinline__ float bf_hi(unsigned u) { return __uint_as_float(u & 0xffff0000u); }
template <int ACT  , bool PRE = false  > struct EpiStore {
    static constexpr bool PERM = true, CHAIN = false;
    bf16_t* O; int ldc; float pre = 1.f;
    __device__ __forceinline__ void operator()(const f32x4 (&acc)[2][2][4][2], const Unit& u, int wr, int wc, int fr, int fq) const {
        int row0 = u.pm * BM + wr * 64 + fr; asm volatile("" : "+v"(row0)); const int col0 = u.pn * BM + wc * 32 + 8 * fq;
#pragma unroll
        for (int ai = 0; ai < 2; ++ai)
#pragma unroll
            for (int m = 0; m < 4; ++m) { bf16_t* rowp = O + (size_t)(row0 + ai * HALF + m * 16) * ldc + col0;
#pragma unroll
                for (int bj = 0; bj < 2; ++bj) { f32x4 v0 = acc[ai][bj][m][0], v1 = acc[ai][bj][m][1]; if (PRE) { v0 = v0 * pre; v1 = v1 * pre; }
                    if (ACT == 1) {
#pragma unroll
                        for (int j = 0; j < 4; ++j) { v0[j] = fmaxf(sigm(v0[j]), 1e-30f); v1[j] = fmaxf(sigm(v1[j]), 1e-30f); } }
                    u32x4 w; w.x = cvt_pk_bf16(v0[0], v0[1]); w.y = cvt_pk_bf16(v0[2], v0[3]); w.z = cvt_pk_bf16(v1[0], v1[1]); w.w = cvt_pk_bf16(v1[2], v1[3]);
                    *(u32x4*)(rowp + bj * HALF) = w; } }
    }
};
struct EpiSwiGLU {
    static constexpr bool PERM = true, CHAIN = false;
    unsigned char* O8; bf16_t* Os; int ldc; float s8;
    __device__ __forceinline__ void operator()(const f32x4 (&acc)[2][2][4][2], const Unit& u, int wr, int wc, int fr, int fq) const {
        int row0 = u.pm * BM + wr * 64 + fr; asm volatile("" : "+v"(row0)); const int col0 = u.pn * HALF + wc * 32 + 8 * fq; const bool samp = u.pm >= 64;
#pragma unroll
        for (int ai = 0; ai < 2; ++ai)
#pragma unroll
            for (int m = 0; m < 4; ++m) { const unsigned r = (unsigned)(row0 + ai * HALF + m * 16);
                f32x4 v0, v1;
#pragma unroll
                for (int j = 0; j < 4; ++j) { const float a0 = acc[ai][0][m][0][j], a1 = acc[ai][0][m][1][j]; v0[j] = a0 * sigm(a0) * acc[ai][1][m][0][j]; v1[j] = a1 * sigm(a1) * acc[ai][1][m][1][j]; }
                if (samp) { u32x4 w; w.x = cvt_pk_bf16(v0[0], v0[1]); w.y = cvt_pk_bf16(v0[2], v0[3]); w.z = cvt_pk_bf16(v1[0], v1[1]); w.w = cvt_pk_bf16(v1[2], v1[3]); *(u32x4*)((char*)Os + ((r - 16384u) * (unsigned)ldc + (unsigned)col0) * 2u) = w; }
                else {
#pragma unroll
                    for (int j = 0; j < 4; ++j) { v0[j] = __builtin_amdgcn_fmed3f(v0[j] * s8, -448.f, 448.f); v1[j] = __builtin_amdgcn_fmed3f(v1[j] * s8, -448.f, 448.f); }
                    unsigned w0 = 0u, w1 = 0u; w0 = __builtin_amdgcn_cvt_pk_fp8_f32(v0[0], v0[1], w0, false); w0 = __builtin_amdgcn_cvt_pk_fp8_f32(v0[2], v0[3], w0, true);
                    w1 = __builtin_amdgcn_cvt_pk_fp8_f32(v1[0], v1[1], w1, false); w1 = __builtin_amdgcn_cvt_pk_fp8_f32(v1[2], v1[3], w1, true);
                    typedef unsigned u32x2 __attribute__((ext_vector_type(2))); u32x2 q; q.x = w0; q.y = w1; *(u32x2*)((char*)O8 + (r * (unsigned)ldc + (unsigned)col0)) = q; } }
    }
};
struct EpiGates {
    static constexpr bool PERM = true, CHAIN = false;
    bf16_t* O; int ldc; float pre;
    __device__ __forceinline__ void operator()(const f32x4 (&acc)[2][2][4][2], const Unit& u, int wr, int wc, int fr, int fq) const {
        int row0 = u.pm * BM + wr * 64 + fr; asm volatile("" : "+v"(row0));
        if (u.pn < 8) { const int ch0 = u.pn * HALF + wc * 32 + 8 * fq;
#pragma unroll
            for (int ai = 0; ai < 2; ++ai)
#pragma unroll
                for (int m = 0; m < 4; ++m) { bf16_t* rowp = O + (size_t)(row0 + ai * HALF + m * 16) * ldc + ch0; float q[8], d[8];
#pragma unroll
                    for (int j = 0; j < 4; ++j) {
                        const float pk = -1.4426950408889634f * pre; const float da0 = 1.f + __builtin_amdgcn_exp2f(pk * acc[ai][0][m][0][j]), da1 = 1.f + __builtin_amdgcn_exp2f(pk * acc[ai][0][m][1][j]);
                        const float db0 = 1.f + __builtin_amdgcn_exp2f(pk * acc[ai][1][m][0][j]), db1 = 1.f + __builtin_amdgcn_exp2f(pk * acc[ai][1][m][1][j]);
                        d[j] = fmaxf(__builtin_amdgcn_rcpf(db0), 1e-30f); d[4 + j] = fmaxf(__builtin_amdgcn_rcpf(db1), 1e-30f);
                        q[j] = fmaxf(__builtin_amdgcn_rcpf(da0), 1e-30f) * fminf(db0, 1e30f); q[4 + j] = fmaxf(__builtin_amdgcn_rcpf(da1), 1e-30f) * fminf(db1, 1e30f); }
                    u32x4 w; w.x = cvt_pk_bf16(q[0], q[1]); w.y = cvt_pk_bf16(q[2], q[3]); w.z = cvt_pk_bf16(q[4], q[5]); w.w = cvt_pk_bf16(q[6], q[7]); *(u32x4*)rowp = w;
                    w.x = cvt_pk_bf16(d[0], d[1]); w.y = cvt_pk_bf16(d[2], d[3]); w.z = cvt_pk_bf16(d[4], d[5]); w.w = cvt_pk_bf16(d[6], d[7]); *(u32x4*)(rowp + 2048) = w; asm volatile("" ::: "memory"); } }
        else { const int col0 = 1024 + (u.pn - 8) * BM + wc * 32 + 8 * fq;
#pragma unroll
            for (int ai = 0; ai < 2; ++ai)
#pragma unroll
                for (int m = 0; m < 4; ++m) { bf16_t* rowp = O + (size_t)(row0 + ai * HALF + m * 16) * ldc + col0;
#pragma unroll
                    for (int bj = 0; bj < 2; ++bj) { f32x4 v0 = acc[ai][bj][m][0], v1 = acc[ai][bj][m][1];
#pragma unroll
                        for (int j = 0; j < 4; ++j) { v0[j] = fmaxf(sigm(pre * v0[j]), 1e-30f); v1[j] = fmaxf(sigm(pre * v1[j]), 1e-30f); }
                        u32x4 w; w.x = cvt_pk_bf16(v0[0], v0[1]); w.y = cvt_pk_bf16(v0[2], v0[3]); w.z = cvt_pk_bf16(v1[0], v1[1]); w.w = cvt_pk_bf16(v1[2], v1[3]);
                        *(u32x4*)(rowp + bj * HALF) = w; } asm volatile("" ::: "memory"); } }
    }
};
struct EpiChain {
    static constexpr bool PERM = true, CHAIN = true;
    const bf16_t* G; int ldg; bf16_t* O; int ldc; const float* rsd; long a1, a2, b1, b2;
    __device__ __forceinline__ long a_off(int kz) const { return kz == 0 ? 0 : (kz == 1 ? a1 : (kz == 2 ? a2 : a2 + 256)); }
    __device__ __forceinline__ long b_off(int kz) const { return kz == 0 ? 0 : (kz == 1 ? b1 : (kz == 2 ? b2 : b2 + 256)); }
    __device__ __forceinline__ int n_ktiles(int kz) const { return kz < 2 ? 8 : 4; }
    __device__ __forceinline__ bool restart(int kz) const { return kz == 3; }
    __device__ __forceinline__ void operator()(f32x4 (&acc)[2][2][4][2], const Unit& u, int wr, int wc, int fr, int fq) const {
        int row0 = u.pm * BM + wr * 64 + fr; const int col0 = u.pn * BM + wc * 32 + 8 * fq; const int kz = u.kz, npass = kz == 1 ? 2 : 1;
#pragma unroll 1
        for (int p = 0; p < npass; ++p) {
            const int goff = kz == 0 ? 0 : ((kz == 1 && p == 0) ? 2048 : 1024), code = kz == 0 ? 0 : (kz == 1 ? p : kz);
            const bool tile = kz != 2, inv = kz == 1 && p == 1, store = kz == 3;
            u32x4 ga[2][4][2]; float rs[2][4]; asm volatile("" : "+v"(row0));
#pragma unroll
            for (int ai = 0; ai < 2; ++ai)
#pragma unroll
                for (int m = 0; m < 4; ++m) { const unsigned r = (unsigned)(row0 + ai * HALF + m * 16); const char* gp = (const char*)G + (r * (unsigned)ldg + (unsigned)(goff + col0)) * 2u;
                    ga[ai][m][0] = (u32x4){0x3f803f80u, 0x3f803f80u, 0x3f803f80u, 0x3f803f80u}; ga[ai][m][1] = ga[ai][m][0];
                    if (tile) { ga[ai][m][0] = *(const u32x4*)gp; ga[ai][m][1] = *(const u32x4*)(gp + HALF * 2); }
                    const float r0 = *(const float*)((const char*)rsd + r * 8u), r1 = *(const float*)((const char*)rsd + r * 8u + 4u);
                    rs[ai][m] = code == 0 ? 1.f : (code == 1 ? r0 : (code == 2 ? r0 * __builtin_amdgcn_rcpf(r1) : r1)); }
#pragma unroll
            for (int ai = 0; ai < 2; ++ai)
#pragma unroll
                for (int m = 0; m < 4; ++m) { bf16_t* rowp = (bf16_t*)((char*)O + ((unsigned)(row0 + ai * HALF + m * 16) * (unsigned)ldc + (unsigned)col0) * 2u);
#pragma unroll
                    for (int bj = 0; bj < 2; ++bj) { float fa[8];
#pragma unroll
                        for (int q = 0; q < 4; ++q) { fa[2 * q] = bf_lo(ga[ai][m][bj][q]) * rs[ai][m]; fa[2 * q + 1] = bf_hi(ga[ai][m][bj][q]) * rs[ai][m]; }
                        if (inv) {
#pragma unroll
                            for (int q = 0; q < 8; ++q) fa[q] = __builtin_amdgcn_rcpf(fa[q]); }
                        f32x4 v0 = acc[ai][bj][m][0], v1 = acc[ai][bj][m][1];
#pragma unroll
                        for (int j = 0; j < 4; ++j) { v0[j] *= fa[j]; v1[j] *= fa[4 + j]; }
                        acc[ai][bj][m][0] = v0; acc[ai][bj][m][1] = v1;
                        if (store) { u32x4 w; w.x = cvt_pk_bf16(v0[0], v0[1]); w.y = cvt_pk_bf16(v0[2], v0[3]); w.z = cvt_pk_bf16(v1[0], v1[1]); w.w = cvt_pk_bf16(v1[2], v1[3]); *(u32x4*)(rowp + bj * HALF) = w; } } }
            asm volatile("" ::: "memory"); }
    }
};
struct Chain4Order {
    StaticOrder so;
    __device__ void init(int M, int N, int G_, int c_) { so.init(M, N, G_, c_); }
    __device__ bool next(int i, Unit& u) const { if (!so.next(i >> 2, u)) return false; u.kz = i & 3; return true; }
    __device__ __forceinline__ void a_ready(const Unit&) const {}
    __device__ __forceinline__ void done(const Unit&) const {}
};
template <class Epi> __device__ __forceinline__ size_t unit_aoff(const Epi& E, const Gemm& g, const Unit& u) { if constexpr (Epi::CHAIN) return (size_t)E.a_off(u.kz) * 2; else return (size_t)u.kz * (size_t)g.a_z * 2; }
template <class Epi> __device__ __forceinline__ size_t unit_boff(const Epi& E, const Gemm& g, const Unit& u) { if constexpr (Epi::CHAIN) return (size_t)E.b_off(u.kz) * 2; else return (size_t)u.kz * (size_t)g.b_z * 2; }
template <class Epi> __device__ __forceinline__ int unit_ktiles(const Epi& E, int nt, const Unit& u) { if constexpr (Epi::CHAIN) return E.n_ktiles(u.kz); else return nt; }
template <class Epi> __device__ __forceinline__ bool unit_restart(const Epi& E, const Unit& u) { if constexpr (Epi::CHAIN) return E.restart(u.kz); else return true; }
template <class Epi, class Sched, bool ALIGN_EPI = false, bool SP2 = false, bool WARM = false, bool FP8 = false>
__device__ __forceinline__ void gemm_phase(PG8_LAS unsigned char* lds, const Gemm g, const Sched& S, const Epi& E, const int wave_id) {
    int tid_; asm volatile("v_mbcnt_lo_u32_b32 %0, -1, 0\n\tv_mbcnt_hi_u32_b32 %0, -1, %0" : "=v"(tid_)); tid_ += 64 * wave_id;
    const int tid = tid_, wid = __builtin_amdgcn_readfirstlane(tid >> 6), lane = tid & 63, wr = wid >> 2, wc = wid & 3, fr = lane & 15, fq = lane >> 4;
    const int K = g.K, nt = K / BK, ld = g.ld ? g.ld : K;
    unsigned voffA[2], voffB[2];
#pragma unroll
    for (int i = 0; i < 2; ++i) { int R, C; stage_rc(tid * 16 + i * 8192, R, C); const int Rb = Epi::PERM ? ((R & ~31) + perm32(R & 31)) : R;
        voffA[i] = (unsigned)(R * ld + C) * 2u; voffB[i] = (unsigned)(Rb * ld + C) * 2u; }
    const size_t kstep = (size_t)(BK * 2);
    const size_t hstep = (size_t)HALF * ld * 2;
    const size_t tstep = 2 * hstep;
    const unsigned ldsw = (unsigned)wid * 1024u;
    const int aoff = lds_byte(wr * 64 + fr, fq * 8), boff = lds_byte(wc * 32 + fr, fq * 8);
#define PG8_SA(b, h) (((b) * 2 + (h)) * HTB)
#define PG8_SB(b, h) ((4 + (b) * 2 + (h)) * HTB)
#define PG8_STAGE(bufoff, gbase, voff) do { _Pragma("unroll") for (int _i = 0; _i < 2; ++_i) \
        __builtin_amdgcn_global_load_lds((const unsigned*)((const char*)(gbase) + (voff)[_i]), (PG8_LAS unsigned*)(lds + (bufoff) + ldsw + _i * 8192), 16, 0, 0); } while (0)
#define PG8_LDA(dst, b, h) do { _Pragma("unroll") for (int m = 0; m < 4; ++m) _Pragma("unroll") for (int k = 0; k < 2; ++k) dst[m][k] = *(const PG8_LAS bf16x8*)(lds + PG8_SA(b, h) + aoff + m * 2048 + k * 1024); } while (0)
#define PG8_LDB(dst, b, h) do { _Pragma("unroll") for (int n = 0; n < 2; ++n) _Pragma("unroll") for (int k = 0; k < 2; ++k) dst[n][k] = *(const PG8_LAS bf16x8*)(lds + PG8_SB(b, h) + boff + n * 2048 + k * 1024); } while (0)
#define PG8_MMA(ai, bj, At, Bt) do { __builtin_amdgcn_s_setprio(1); _Pragma("unroll") for (int m = 0; m < 4; ++m) _Pragma("unroll") for (int n = 0; n < 2; ++n) { \
        if constexpr (FP8) { const i32x8 a8_ = __builtin_shufflevector(__builtin_bit_cast(i32x4, At[m][0]), __builtin_bit_cast(i32x4, At[m][1]), 0, 1, 2, 3, 4, 5, 6, 7), \
                                            b8_ = __builtin_shufflevector(__builtin_bit_cast(i32x4, Bt[n][0]), __builtin_bit_cast(i32x4, Bt[n][1]), 0, 1, 2, 3, 4, 5, 6, 7); \
            asm volatile("v_mfma_f32_16x16x128_f8f6f4 %0, %1, %2, %0" : "+v"(acc[ai][bj][m][n]) : "v"(b8_), "v"(a8_)); }   \
        else { _Pragma("unroll") for (int k = 0; k < 2; ++k) acc[ai][bj][m][n] = __builtin_amdgcn_mfma_f32_16x16x32_bf16(Bt[n][k], At[m][k], acc[ai][bj][m][n], 0, 0, 0); } } \
        __builtin_amdgcn_s_setprio(0); } while (0)
#define PG8_WAIT_V(n) asm volatile("s_waitcnt vmcnt(" #n ")" ::: "memory")
#define PG8_WAIT_L(n) asm volatile("s_waitcnt lgkmcnt(" #n ")" ::: "memory")
#define PG8_BAR __builtin_amdgcn_s_barrier()
#define PG8_SCHED __builtin_amdgcn_sched_barrier(0)
    Unit cur, nxt; int ui = 0;
    if (!S.next(0, cur)) return;
    f32x4 acc[2][2][4][2];
#pragma unroll
    for (int a = 0; a < 2; ++a)
#pragma unroll
        for (int b = 0; b < 2; ++b)
#pragma unroll
            for (int m = 0; m < 4; ++m)
#pragma unroll
                for (int n = 0; n < 2; ++n) acc[a][b][m][n] = (f32x4){0.f, 0.f, 0.f, 0.f};
    bf16x8 At[4][2], B0[2][2], B1[2][2];
#define PG8_AOFF(u) unit_aoff(E, g, u)
#define PG8_BOFF(u) unit_boff(E, g, u)
    const char* cA = (const char*)g.A + (size_t)cur.pm * tstep + PG8_AOFF(cur); const char* cB = (const char*)g.Bt + (size_t)cur.pn * tstep + PG8_BOFF(cur);
    S.a_ready(cur);
    if constexpr (WARM) {
#pragma unroll 4
        for (int i = tid; i < 256 * K * 2 / 128; i += 512) { const unsigned x = *(const unsigned*)(cA + (size_t)i * 128); asm volatile("" :: "v"(x)); } }
    if constexpr (SP2) {
        PG8_STAGE(PG8_SB(0, 0), cB, voffB); PG8_STAGE(PG8_SB(0, 1), cB + hstep, voffB); PG8_STAGE(PG8_SA(0, 0), cA, voffA); PG8_STAGE(PG8_SA(0, 1), cA + hstep, voffA);
        if (wr == 1) PG8_BAR;
        PG8_WAIT_V(2); PG8_BAR;
        PG8_STAGE(PG8_SB(1, 0), cB + kstep, voffB); PG8_STAGE(PG8_SA(1, 0), cA + kstep, voffA); PG8_STAGE(PG8_SB(1, 1), cB + hstep + kstep, voffB);
        PG8_WAIT_V(6); PG8_BAR;
    } else {
        PG8_STAGE(PG8_SB(0, 0), cB, voffB); PG8_STAGE(PG8_SA(0, 0), cA, voffA); PG8_STAGE(PG8_SB(0, 1), cB + hstep, voffB); PG8_STAGE(PG8_SA(0, 1), cA + hstep, voffA);
        if (wr == 1) PG8_BAR;
        PG8_WAIT_V(4); PG8_BAR;
        PG8_STAGE(PG8_SB(1, 0), cB + kstep, voffB); PG8_STAGE(PG8_SA(1, 0), cA + kstep, voffA); PG8_STAGE(PG8_SB(1, 1), cB + hstep + kstep, voffB);
        PG8_WAIT_V(6); PG8_BAR;
    }
    for (;;) {
        const bool has_next = S.next(ui + 1, nxt);
        const char* nA = has_next ? (const char*)g.A + (size_t)nxt.pm * tstep + PG8_AOFF(nxt) : cA; const char* nB = has_next ? (const char*)g.Bt + (size_t)nxt.pn * tstep + PG8_BOFF(nxt) : cB;
        const int nt_u = unit_ktiles(E, nt, cur);
        for (int t = 0; t < nt_u; t += 2) {
            const bool last = (t == nt_u - 2);
            const char* a1 = cA + (size_t)(t + 1) * kstep;
            const char* a2 = last ? nA : cA + (size_t)(t + 2) * kstep; const char* b2 = last ? nB : cB + (size_t)(t + 2) * kstep;
            const char* a3 = a2 + kstep; const char* b3 = b2 + kstep;
            if (last && has_next) S.a_ready(nxt);
            if constexpr (SP2) {
            PG8_LDB(B0, 0, 0); PG8_LDB(B1, 0, 1); PG8_SCHED; PG8_LDA(At, 0, 0); PG8_STAGE(PG8_SA(1, 1), a1 + hstep, voffA);
            PG8_WAIT_V(8); PG8_WAIT_L(0); PG8_BAR; PG8_MMA(0, 0, At, B0); PG8_MMA(0, 1, At, B1); PG8_BAR; PG8_SCHED;
            PG8_LDA(At, 0, 1); PG8_STAGE(PG8_SB(0, 0), b2, voffB); PG8_STAGE(PG8_SB(0, 1), b2 + hstep, voffB); PG8_STAGE(PG8_SA(0, 0), a2, voffA);
            PG8_WAIT_V(8); PG8_WAIT_L(0); PG8_BAR; PG8_MMA(1, 0, At, B0); PG8_MMA(1, 1, At, B1); PG8_BAR; PG8_SCHED;
            PG8_LDB(B0, 1, 0); PG8_LDB(B1, 1, 1); PG8_SCHED; PG8_LDA(At, 1, 0); PG8_STAGE(PG8_SA(0, 1), a2 + hstep, voffA);
            PG8_WAIT_V(8); PG8_WAIT_L(0); PG8_BAR; PG8_MMA(0, 0, At, B0); PG8_MMA(0, 1, At, B1); PG8_BAR; PG8_SCHED;
            PG8_LDA(At, 1, 1); PG8_STAGE(PG8_SB(1, 0), b3, voffB); PG8_STAGE(PG8_SB(1, 1), b3 + hstep, voffB); PG8_STAGE(PG8_SA(1, 0), a3, voffA);
            PG8_WAIT_V(8); PG8_WAIT_L(0); PG8_BAR; PG8_MMA(1, 0, At, B0); PG8_MMA(1, 1, At, B1); PG8_BAR; PG8_SCHED;
            } else {
            PG8_LDB(B0, 0, 0); PG8_SCHED; PG8_LDA(At, 0, 0); PG8_STAGE(PG8_SA(1, 1), a1 + hstep, voffA);
            PG8_WAIT_L(8); PG8_BAR; PG8_WAIT_L(0); PG8_MMA(0, 0, At, B0); PG8_BAR; PG8_SCHED;
            PG8_LDB(B1, 0, 1); PG8_STAGE(PG8_SB(0, 0), b2, voffB);
            PG8_BAR; PG8_WAIT_L(0); PG8_MMA(0, 1, At, B1); PG8_BAR;
            PG8_LDA(At, 0, 1); PG8_STAGE(PG8_SA(0, 0), a2, voffA);
            PG8_BAR; PG8_WAIT_L(0); PG8_MMA(1, 0, At, B0); PG8_BAR; PG8_SCHED;
            PG8_STAGE(PG8_SB(0, 1), b2 + hstep, voffB);
            PG8_WAIT_V(6); PG8_BAR; PG8_MMA(1, 1, At, B1); PG8_BAR;
            PG8_LDB(B0, 1, 0); PG8_SCHED; PG8_LDA(At, 1, 0); PG8_STAGE(PG8_SA(0, 1), a2 + hstep, voffA);
            PG8_WAIT_L(8); PG8_BAR; PG8_WAIT_L(0); PG8_MMA(0, 0, At, B0); PG8_BAR; PG8_SCHED;
            PG8_LDB(B1, 1, 1); PG8_STAGE(PG8_SB(1, 0), b3, voffB);
            PG8_BAR; PG8_WAIT_L(0); PG8_MMA(0, 1, At, B1); PG8_BAR;
            PG8_LDA(At, 1, 1); PG8_STAGE(PG8_SA(1, 0), a3, voffA);
            PG8_BAR; PG8_WAIT_L(0); PG8_MMA(1, 0, At, B0); PG8_BAR; PG8_SCHED;
            PG8_STAGE(PG8_SB(1, 1), b3 + hstep, voffB);
            PG8_WAIT_V(6); PG8_BAR; PG8_MMA(1, 1, At, B1); PG8_BAR;
            }
        }
        if constexpr (ALIGN_EPI) { if (wr == 0) PG8_BAR; }
        if constexpr (FP8) { asm volatile("s_nop 15\n\ts_nop 15" ::: "memory");
#pragma unroll
            for (int a = 0; a < 2; ++a)
#pragma unroll
                for (int b = 0; b < 2; ++b)
#pragma unroll
                    for (int m = 0; m < 4; ++m) asm volatile("" : "+v"(acc[a][b][m][0]), "+v"(acc[a][b][m][1])); }
        E(acc, cur, wr, wc, fr, fq);
        S.done(cur);
        if (!has_next) break;
        if (unit_restart(E, cur)) {
#pragma unroll
        for (int a = 0; a < 2; ++a)
#pragma unroll
            for (int b = 0; b < 2; ++b)
#pragma unroll
                for (int m = 0; m < 4; ++m)
#pragma unroll
                    for (int n = 0; n < 2; ++n) acc[a][b][m][n] = (f32x4){0.f, 0.f, 0.f, 0.f};
        }
        cur = nxt; cA = nA; cB = nB; ++ui;
        if constexpr (ALIGN_EPI) { if (wr == 1) PG8_BAR; }
    }
    PG8_WAIT_V(0);
    if constexpr (!ALIGN_EPI) { if (wr == 0) PG8_BAR; }
    PG8_BAR;
#undef PG8_AOFF
#undef PG8_BOFF
#undef PG8_SA
#undef PG8_SB
#undef PG8_STAGE
#undef PG8_LDA
#undef PG8_LDB
#undef PG8_MMA
#undef PG8_WAIT_V
#undef PG8_WAIT_L
#undef PG8_BAR
#undef PG8_SCHED
}
}

constexpr int T_ALL = 16896, T_P = 16384, T_S = 512, DM = 1024, NBC = 136;
constexpr int SEQ = 2048, NCH = 32, CH = 64;
constexpr int NU = 5888, NUV = 5664, NG = 3072, NF1 = 5632, FH = 2816, NIN = 8736;
constexpr int C_GQ = 0, C_GK = 512, C_GV = 1024, C_GR = 1536, C_GLR = 2048, C_SZ = 2064, C_SXBC = 2576, C_SDT = 3600, C_DQKV = 3608, C_DA = 5144, C_DB = 5148, C_DG = 5152;
constexpr float EPS = 1e-6f;
constexpr size_t MiB = 1u << 20;
constexpr size_t WS_CTL = 0, CTL_ZERO_BYTES = 65536;
constexpr size_t WS_MOD = 1 * MiB;
constexpr size_t WS_W = 8 * MiB;
constexpr size_t W_IN = 0, W_G = W_IN + (size_t)NU * DM * 2, W_B = W_G + (size_t)NG * DM * 2, W_O = W_B + (size_t)3 * DM * 512 * 2, W_F1 = W_O + (size_t)DM * DM * 2, W_F2 = W_F1 + (size_t)NF1 * DM * 2, W_END = W_F2 + (size_t)DM * FH * 2;
static_assert(W_END <= 40 * MiB, "weights");
constexpr size_t WS_H = 48 * MiB;
constexpr size_t WS_YS = 81 * MiB;
constexpr size_t WS_U = 131 * MiB;
constexpr size_t WS_G = WS_U, WS_MERGED = WS_U + 100 * MiB, WS_MIX = WS_U + 134 * MiB, WS_HID = WS_U, WS_HIDS = WS_U + 48 * MiB, WS_F = WS_U + 100 * MiB;
constexpr size_t WS_SCR = 321 * MiB;
constexpr size_t WS_END = 467 * MiB;
constexpr size_t WS_F2Q = 321 * MiB;
static_assert(WS_H + (size_t)T_ALL * DM * 2 <= WS_YS && WS_YS + (size_t)3 * T_ALL * 512 * 2 <= WS_U && WS_U + (size_t)T_ALL * NU * 2 <= WS_SCR, "ws map");
static_assert((size_t)T_ALL * NG * 2 <= 100 * MiB && (size_t)T_ALL * DM * 2 <= 34 * MiB && (size_t)T_ALL * FH * 2 <= 100 * MiB && WS_MIX + 34 * MiB <= WS_SCR, "overlays");
constexpr size_t O_Y = 0, O_YS = (size_t)T_P * DM, O_PGLA = O_YS + (size_t)T_S * DM, O_PSSD = O_PGLA + 1048576, O_PCS = O_PSSD + 1048576, O_PGDN = O_PCS + 49152, O_PCD = O_PGDN + 1048576,
                 O_SGLA = O_PCD + 73728, O_SSSD = O_SGLA + 16777216, O_SCS = O_SSSD + 16777216, O_SGDN = O_SCS + 786432, O_SCD = O_SGDN + 16777216, O_END = O_SCD + 1179648;
constexpr int CW_BAR = 4096;
constexpr int RING_BYTES = 131072, LDS_BYTES = 147456, LDSCTL_OFF = LDS_BYTES - 2048, MISC_OFF = LDSCTL_OFF + 320;
constexpr int NWAVES = 8, NTHR = 512;
#define GAS __attribute__((address_space(1)))
#define LAS __attribute__((address_space(3)))
typedef unsigned short bf16;
typedef unsigned v4u __attribute__((ext_vector_type(4)));
typedef unsigned v2u __attribute__((ext_vector_type(2)));
typedef float f32x4 __attribute__((ext_vector_type(4)));
typedef float f32x16 __attribute__((ext_vector_type(16)));
typedef short bf16x8 __attribute__((ext_vector_type(8)));
typedef GAS unsigned gu32;
#define RLX_AGENT __ATOMIC_RELAXED, __HIP_MEMORY_SCOPE_AGENT
#define LDS_WAIT() asm volatile("s_waitcnt lgkmcnt(0)" ::: "memory")
#define LBAR() do { asm volatile("s_waitcnt lgkmcnt(0)" ::: "memory"); __builtin_amdgcn_s_barrier(); asm volatile("" ::: "memory"); } while (0)
#define VM_WAIT() asm volatile("s_waitcnt vmcnt(0)" ::: "memory")
__device__ __forceinline__ unsigned f2bf(float f) { unsigned u = __builtin_bit_cast(unsigned, f); return (u + 0x7fffu + ((u >> 16) & 1u)) >> 16; }
__device__ __forceinline__ unsigned pk2(float lo, float hi) { return f2bf(lo) | (f2bf(hi) << 16); }
__device__ __forceinline__ float bf2f(bf16 x) { return __uint_as_float((unsigned)x << 16); }
__device__ __forceinline__ float blo(unsigned u) { return __uint_as_float(u << 16); }
__device__ __forceinline__ float bhi(unsigned u) { return __uint_as_float(u & 0xffff0000u); }
__device__ __forceinline__ float sigmoid_f(float x) { return __builtin_amdgcn_rcpf(1.f + __expf(-x)); }
__device__ __forceinline__ float silu_f(float x) { return x * __builtin_amdgcn_rcpf(1.f + __expf(-x)); }
__device__ __forceinline__ float softplus_f(float x) { return x > 20.f ? x : __logf(1.f + __expf(x)); }
__device__ __forceinline__ float logsigmoid_f(float x) { return fminf(x, 0.f) - __logf(1.f + __expf(-fabsf(x))); }
#define SWZ_XOR(x, SH) __int_as_float(__builtin_amdgcn_ds_swizzle(__float_as_int(x), 0x1f | ((SH) << 10)))
__device__ __forceinline__ float wave_sum(float v) {
    v += SWZ_XOR(v, 1); v += SWZ_XOR(v, 2); v += SWZ_XOR(v, 4); v += SWZ_XOR(v, 8); v += SWZ_XOR(v, 16);
    return __int_as_float(__builtin_amdgcn_readlane(__float_as_int(v), 0)) + __int_as_float(__builtin_amdgcn_readlane(__float_as_int(v), 32));
}
__device__ __forceinline__ float wave_incl_scan(LAS float* buf, float x, int lane) {
    buf[lane] = x; asm volatile("s_waitcnt lgkmcnt(0)" ::: "memory"); f32x4 v[16];
#pragma unroll
    for (int q = 0; q < 16; ++q) v[q] = *(const LAS f32x4*)(buf + 4 * q);
    float acc = 0.f;
#pragma unroll
    for (int j = 0; j < 64; ++j) acc += (j <= lane) ? v[j >> 2][j & 3] : 0.f;
    return acc;
}

#define XB_TMO      128
#define XB_XCNT(j)  (256  + 64 * (j))
#define XB_XSUB(j)  (1280 + 64 * (j))
#define XB_XGEN(j)  (2304 + 64 * (j))
#define XB_TOP      3328
#define XB_TOPGEN   3392
#define XCD_BAR_WORDS 3456
#define XB_SPIN_CAP (1u << 18)

__device__ __forceinline__ unsigned xb_ld(unsigned* p)              { return __hip_atomic_load(p, __ATOMIC_RELAXED, __HIP_MEMORY_SCOPE_AGENT); }
__device__ __forceinline__ unsigned xb_add(unsigned* p, unsigned v) { return __hip_atomic_fetch_add(p, v, __ATOMIC_RELAXED, __HIP_MEMORY_SCOPE_AGENT); }
__device__ __forceinline__ unsigned xb_xcc_id() { return (unsigned)__builtin_amdgcn_s_getreg((3 << 11) | 20) & 0xFu; }
#define XB_SPIN(cond, bar) do { unsigned _sp = 0; while (cond) { __builtin_amdgcn_s_sleep(1); \
    if ((++_sp & 255u) == 0u) { if (xb_ld(&(bar)[XB_TMO])) break; if (_sp > XB_SPIN_CAP) { atomicAdd(&(bar)[XB_TMO], 1u); break; } } } } while (0)

struct XcdBarrier {
    unsigned* bar; unsigned x;
    volatile LAS unsigned* st;
};

__device__ __forceinline__ XcdBarrier xcd_barrier_post(unsigned* bar, volatile LAS unsigned* st, bool leader) {
    XcdBarrier b; b.bar = bar; b.x = xb_xcc_id(); b.st = st;
    if (leader) (void)xb_add(&bar[XB_XCNT(b.x)], 1u);
    return b;
}
__device__ __forceinline__ void xcd_barrier_complete(unsigned* bar, unsigned x, unsigned& nloc, unsigned& nx) {
    const unsigned G = gridDim.x * gridDim.y * gridDim.z;
    unsigned sum, cnt, mine, sp = 0u;
    for (;;) {
        sum = 0u; cnt = 0u; mine = 0u;
#pragma unroll
        for (unsigned j = 0; j < 16; ++j) { const unsigned c = xb_ld(&bar[XB_XCNT(j)]); sum += c; cnt += (c > 0u) ? 1u : 0u; mine = (j == x) ? c : mine; }
        if (sum == G) break;
        __builtin_amdgcn_s_sleep(1);
        if ((++sp & 255u) == 0u) { if (xb_ld(&bar[XB_TMO])) break; if (sp > XB_SPIN_CAP) { atomicAdd(&bar[XB_TMO], 1u); break; } }
    }
    nloc = mine > 0u ? mine : 1u; nx = cnt > 0u ? cnt : 1u;
}

__device__ __forceinline__ void xcd_barrier(const XcdBarrier& b, bool leader) {
    asm volatile("s_waitcnt vmcnt(0)" ::: "memory");
    __syncthreads();
    if (leader) {
        unsigned* bar = b.bar;
        __builtin_amdgcn_s_waitcnt(0);
        unsigned nloc = b.st[0], nx = b.st[1];
        if (nloc == 0u) { xcd_barrier_complete(bar, b.x, nloc, nx); b.st[0] = nloc; b.st[1] = nx; }
        const unsigned old = xb_add(&bar[XB_XSUB(b.x)], 1u);
        const unsigned gen = old / nloc;
        if (old + 1u == (gen + 1u) * nloc) {
            __builtin_amdgcn_fence(__ATOMIC_RELEASE, "agent");
            asm volatile("s_waitcnt vmcnt(0)" ::: "memory");
            const unsigned og = xb_add(&bar[XB_TOP], 1u);
            const unsigned tg = og / nx;
            if (og + 1u == (tg + 1u) * nx) xb_add(&bar[XB_TOPGEN], 1u);
            else XB_SPIN(xb_ld(&bar[XB_TOPGEN]) == tg, bar);
            __builtin_amdgcn_fence(__ATOMIC_ACQUIRE, "agent");
            xb_add(&bar[XB_XGEN(b.x)], 1u);
            asm volatile("s_waitcnt vmcnt(0)" ::: "memory");
        } else {
            XB_SPIN(xb_ld(&bar[XB_XGEN(b.x)]) == gen, bar);
            __builtin_amdgcn_fence(__ATOMIC_ACQUIRE, "agent");
            asm volatile("s_waitcnt vmcnt(0)" ::: "memory");
        }
    }
    __syncthreads();
}

struct Args { const float* in[33]; float* out; unsigned char* ws; int ph_lo, ph_hi; };
enum { I_XP = 0, I_XS, I_SGLA, I_SSSD, I_CSSD, I_SGDN, I_CGDN, I_CP, I_CS, I_WADA, I_BADA, I_GPREM, I_GPOSTM, I_GPREF, I_GPOSTF, I_WIN, I_WGG, I_BGG, I_GGLAN, I_WSC, I_BSC, I_SDTB, I_SALOG, I_SD, I_GSSDN,
       I_WGC, I_GDTB, I_GALOG, I_GGDNN, I_WBR, I_WOUT, I_WF1, I_WF2 };

struct Ctx {
    LAS unsigned char* lds; int tid, lane, wave, vcu, G;
    const float* const* in; float* out; unsigned char* ws;
};
__device__ __forceinline__ int bidx_of_row(int row) { return row < T_P ? (row >> 11) : 8 + ((row - T_P) >> 2); }

struct TItem { const float* W; int N, k0, n0; bf16* WT; int drow, Kd; const float* ks; int dk0; unsigned char* W8; int w8_ld; float w8_s; };
__device__ __forceinline__ void conv_decode(const Ctx& C, int l, int it, TItem& t) {
    unsigned char* wb = C.ws + WS_W;
    bf16* Win_t = (bf16*)(wb + W_IN); bf16* Wg_t = (bf16*)(wb + W_G); bf16* Wb_t = (bf16*)(wb + W_B); bf16* Wo_t = (bf16*)(wb + W_O); bf16* Wf1_t = (bf16*)(wb + W_F1); bf16* Wf2_t = (bf16*)(wb + W_F2);
    const float* w_in = C.in[I_WIN] + (size_t)l * DM * NIN; const float* w_br = C.in[I_WBR] + (size_t)l * 3 * 512 * DM; const float* w_out = C.in[I_WOUT] + (size_t)l * DM * DM;
    const float* w_f1 = C.in[I_WF1] + (size_t)l * DM * NF1; const float* w_f2 = C.in[I_WF2] + (size_t)l * FH * DM;
    constexpr int IA = 16 * 273, IB = 3 * 8 * 32, IC = 16 * 32, ID = 16 * 176, IE = 44 * 32;
    int r = it; t.ks = nullptr; t.W8 = nullptr; t.w8_ld = 4096; t.w8_s = 32.f;
    if (r < IA) { const int kb = r / 273, nb = r % 273, n0 = 32 * nb; t.W = w_in; t.N = NIN; t.k0 = 64 * kb; t.n0 = n0; t.Kd = DM; t.dk0 = 64 * kb;
        if (n0 < NUV) { t.WT = Win_t; t.drow = n0; }
        else { const int gcol = n0 - NUV, gi = gcol >> 10, ch = gcol & 1023;
            t.WT = Wg_t; t.drow = gi == 1 ? 2048 + ch : (ch >> 7) * 256 + (gi == 2 ? 128 : 0) + (ch & 127); t.W8 = (unsigned char*)C.out + 3072; }
        return; } r -= IA;
    if (r < IB) { const int n = r / 256, q = r % 256, kb = q / 32, nb = q % 32;
        t.W = w_br + (size_t)n * 512 * DM; t.N = DM; t.k0 = 64 * kb; t.n0 = 32 * nb; t.drow = 32 * nb; t.Kd = 512; t.dk0 = 64 * kb;
        if (n != 1) t.WT = Wb_t + (size_t)(n >> 1) * DM * 512; else { t.WT = Wb_t + (size_t)2 * DM * 512; t.ks = C.in[I_GSSDN] + l * 512; }
        return; } r -= IB;
    if (r < IC) { const int kb = r / 32, nb = r % 32; t.W = w_out; t.N = DM; t.k0 = 64 * kb; t.n0 = 32 * nb; t.WT = Wo_t; t.drow = 32 * nb; t.Kd = DM; t.dk0 = 64 * kb; return; } r -= IC;
    if (r < ID) { const int kb = r / 176, nb = r % 176, n0 = 32 * nb; const int isb = n0 >= FH ? 1 : 0, j = n0 - isb * FH;
        t.W = w_f1; t.N = NF1; t.k0 = 64 * kb; t.n0 = n0; t.WT = Wf1_t; t.drow = (j >> 7) * 256 + isb * 128 + (j & 127); t.Kd = DM; t.dk0 = 64 * kb; return; } r -= ID;
    if (r < IE) { const int kb = r / 32, nb = r % 32; t.W = w_f2; t.N = DM; t.k0 = 64 * kb; t.n0 = 32 * nb; t.WT = Wf2_t; t.drow = 32 * nb; t.Kd = FH; t.dk0 = 64 * kb; return; } r -= IE;
    t.W = nullptr; t.WT = Win_t; t.drow = NUV + r; t.Kd = DM; t.N = 0; t.k0 = 0; t.n0 = 0; t.dk0 = 0;
}
__device__ __forceinline__ void ti_load(const TItem& t, int lane, f32x4 (&x)[8], float (&sc)[8]) {
    if (t.W == nullptr) return;
#pragma unroll
    for (int i = 0; i < 8; ++i) { const int kk = 8 * i + (lane >> 3), n4 = (lane & 7) * 4; x[i] = *(const GAS f32x4*)(t.W + (size_t)(t.k0 + kk) * t.N + t.n0 + n4); sc[i] = t.ks ? t.ks[t.k0 + kk] : 1.f; }
}
__device__ __forceinline__ void ti_finish(const TItem& t, LAS float* scr, int lane, const f32x4 (&x)[8], const float (&sc)[8]) {
    if (t.W == nullptr) { GAS v4u* p = (GAS v4u*)(t.WT + (size_t)t.drow * t.Kd) + lane * 2; const v4u z = {0u, 0u, 0u, 0u}; p[0] = z; p[1] = z; return; }
#pragma unroll
    for (int i = 0; i < 8; ++i) { const int kk = 8 * i + (lane >> 3), n4 = (lane & 7) * 4; const f32x4 v = x[i] * sc[i];
        scr[kk * 33 + n4] = v[0]; scr[kk * 33 + n4 + 1] = v[1]; scr[kk * 33 + n4 + 2] = v[2]; scr[kk * 33 + n4 + 3] = v[3]; }
    LDS_WAIT(); asm volatile("" ::: "memory");
    const int c = lane & 7;
#pragma unroll
    for (int j = 0; j < 4; ++j) { const int n = (lane >> 3) + 8 * j; const LAS float* s = scr + (8 * c) * 33 + n;
        v4u o; o.x = pk2(s[0 * 33], s[1 * 33]); o.y = pk2(s[2 * 33], s[3 * 33]); o.z = pk2(s[4 * 33], s[5 * 33]); o.w = pk2(s[6 * 33], s[7 * 33]);
        if (t.WT) *(GAS v4u*)(t.WT + (size_t)(t.drow + n) * t.Kd + t.dk0 + 8 * c) = o;
        if (t.W8) { v2u q8; unsigned w = 0u; w = __builtin_amdgcn_cvt_pk_fp8_f32(t.w8_s * s[0 * 33], t.w8_s * s[1 * 33], w, false); w = __builtin_amdgcn_cvt_pk_fp8_f32(t.w8_s * s[2 * 33], t.w8_s * s[3 * 33], w, true); q8.x = w;
            w = 0u; w = __builtin_amdgcn_cvt_pk_fp8_f32(t.w8_s * s[4 * 33], t.w8_s * s[5 * 33], w, false); w = __builtin_amdgcn_cvt_pk_fp8_f32(t.w8_s * s[6 * 33], t.w8_s * s[7 * 33], w, true); q8.y = w;
            *(GAS v2u*)(t.W8 + (size_t)(t.drow + n) * t.w8_ld + t.dk0 + 8 * c) = q8; } }
    LDS_WAIT(); asm volatile("" ::: "memory");
}
__device__ __forceinline__ void convert_weights(const Ctx& C, int l, bool p0 = false) {
    LAS float* scr = (LAS float*)(C.lds + C.wave * 16384);
    constexpr int NIT = 16 * 273 + 3 * 8 * 32 + 16 * 32 + 16 * 176 + 44 * 32 + (NU - NUV);
    const int gw = C.vcu * NWAVES + C.wave, NGW = C.G * NWAVES; const bool bal = p0 && C.G == 256; const int r3 = 1024 + ((C.vcu - 128) * NWAVES + C.wave) * 3;
#define CW_ITEM(j) (!bal ? gw + (j) * NGW : (C.vcu < 128 ? gw + (j) * 4096 : r3 + (j) % 3 + ((j) / 3) * 4096))
    int jj = 0, it = CW_ITEM(0); if (it >= NIT) return;
    TItem cur; conv_decode(C, l, it, cur); f32x4 xa[8]; float sa[8]; ti_load(cur, C.lane, xa, sa);
#pragma unroll 1
    for (;;) { const int itn = CW_ITEM(jj + 1); const bool has = itn < NIT; TItem nxt = cur; f32x4 xb[8]; float sb[8];
#pragma unroll
        for (int i = 0; i < 8; ++i) { xb[i] = xa[i]; sb[i] = sa[i]; }
        if (has) { conv_decode(C, l, itn, nxt); ti_load(nxt, C.lane, xb, sb); }
        __builtin_amdgcn_sched_barrier(0);
        ti_finish(cur, scr, C.lane, xa, sa);
        if (!has) break;
        cur = nxt; it = itn; ++jj;
#pragma unroll
        for (int i = 0; i < 8; ++i) { xa[i] = xb[i]; sa[i] = sb[i]; } }
}
#undef CW_ITEM
__device__ __forceinline__ void convert_f2_fp8(const Ctx& C, int l) {
    LAS float* scr = (LAS float*)(C.lds + C.wave * 16384); const float* w_f2 = C.in[I_WF2] + (size_t)l * FH * DM;
    const int gw = C.vcu * NWAVES + C.wave, NGW = C.G * NWAVES;
    for (int it = gw; it < 44 * 32; it += NGW) { const int kb = it / 32, nb = it % 32; TItem t; t.W = w_f2; t.N = DM; t.k0 = 64 * kb; t.n0 = 32 * nb; t.WT = nullptr; t.drow = 32 * nb; t.Kd = FH; t.ks = nullptr; t.dk0 = 64 * kb;
        t.W8 = C.ws + WS_F2Q; t.w8_ld = FH; t.w8_s = 32.f; f32x4 x[8]; float sc[8]; ti_load(t, C.lane, x, sc); ti_finish(t, scr, C.lane, x, sc); }
}
__device__ __forceinline__ void compute_mod(const Ctx& C) {
    LAS float* cs = (LAS float*)C.lds;
    LAS float* red = (LAS float*)(C.lds + 81920);
    float* mod = (float*)(C.ws + WS_MOD);
    for (int item = C.vcu; item < 128; item += C.G) {
        const int l = 0, cb = item / 8, rg = item % 8, r0 = rg * 17;
        __syncthreads();
        for (int idx = C.tid; idx < 17 * 1024; idx += NTHR) { const int r = idx >> 10, k = idx & 1023, bi = r0 + r;
            const float c = bi < 8 ? C.in[I_CP][bi * DM + k] : C.in[I_CS][(bi - 8) * DM + k]; cs[k * 20 + r] = silu_f(c); }
        __syncthreads();
        const int cl = C.tid & 127, col = cb * 128 + cl, kq = C.tid >> 7;
        const float* w = C.in[I_WADA] + (size_t)l * DM * 6144 + col;
        float acc[17];
#pragma unroll
        for (int r = 0; r < 17; ++r) acc[r] = 0.f;
        float wa[8], wq[8];
#define MOD_LDW(wv, kb) do { _Pragma("unroll") for (int u = 0; u < 8; ++u) wv[u] = w[(size_t)((kb) + u) * 6144]; } while (0)
#define MOD_FMA(wv, kb) do { _Pragma("unroll") for (int u = 0; u < 8; ++u) { const LAS f32x4* c4 = (const LAS f32x4*)(cs + ((kb) + u) * 20); const f32x4 a = c4[0], b = c4[1], c = c4[2], d = c4[3]; const float e = cs[((kb) + u) * 20 + 16]; const float x = wv[u]; \
                acc[0] += a[0] * x; acc[1] += a[1] * x; acc[2] += a[2] * x; acc[3] += a[3] * x; acc[4] += b[0] * x; acc[5] += b[1] * x; acc[6] += b[2] * x; acc[7] += b[3] * x; \
                acc[8] += c[0] * x; acc[9] += c[1] * x; acc[10] += c[2] * x; acc[11] += c[3] * x; acc[12] += d[0] * x; acc[13] += d[1] * x; acc[14] += d[2] * x; acc[15] += d[3] * x; acc[16] += e * x; } } while (0)
        MOD_LDW(wa, kq * 256);
#pragma unroll 1
        for (int k0 = kq * 256; k0 < kq * 256 + 256; k0 += 16) {
            MOD_LDW(wq, k0 + 8); __builtin_amdgcn_sched_barrier(0);
            MOD_FMA(wa, k0); __builtin_amdgcn_sched_barrier(0);
            if (k0 + 16 < kq * 256 + 256) MOD_LDW(wa, k0 + 16);
            __builtin_amdgcn_sched_barrier(0);
            MOD_FMA(wq, k0 + 8); __builtin_amdgcn_sched_barrier(0); }
#undef MOD_LDW
#undef MOD_FMA
        LAS float* redw = red + ((kq - 1) * 17) * 128 + cl; LAS float* redr = red + cl; asm volatile("" : "+v"(redw), "+v"(redr));
        if (kq > 0) {
#pragma unroll
            for (int r = 0; r < 17; ++r) redw[r * 128] = acc[r]; }
        __syncthreads();
        if (kq == 0) { const float bv = C.in[I_BADA][l * 6144 + col];
#pragma unroll
            for (int r = 0; r < 17; ++r) mod[((size_t)l * NBC + r0 + r) * 6144 + col] = acc[r] + redr[r * 128] + redr[(17 + r) * 128] + redr[(34 + r) * 128] + bv; }
    }
    __syncthreads();
}
__device__ __forceinline__ void load_bf16_row(const bf16* p, int lane, f32x4 (&v)[4]) {
    const GAS v2u* q = (const GAS v2u*)p + lane;
#pragma unroll
    for (int j = 0; j < 4; ++j) { const v2u w = q[64 * j]; v[j] = (f32x4){blo(w.x), bhi(w.x), blo(w.y), bhi(w.y)}; }
}
__device__ __forceinline__ void load_f32_row(const float* p, int lane, f32x4 (&v)[4]) {
    const GAS f32x4* q = (const GAS f32x4*)p + lane;
#pragma unroll
    for (int j = 0; j < 4; ++j) v[j] = q[64 * j];
}
__device__ __forceinline__ void store_f32_row(float* p, int lane, const f32x4 (&v)[4]) {
    GAS f32x4* q = (GAS f32x4*)p + lane;
#pragma unroll
    for (int j = 0; j < 4; ++j) q[64 * j] = v[j];
}
__device__ __forceinline__ void store_bf16_row(bf16* p, int lane, const f32x4 (&v)[4]) {
    GAS v2u* q = (GAS v2u*)p + lane;
#pragma unroll
    for (int j = 0; j < 4; ++j) { v2u w; w.x = pk2(v[j][0], v[j][1]); w.y = pk2(v[j][2], v[j][3]); q[64 * j] = w; }
}
__device__ __forceinline__ void store_fp8_row(unsigned char* p, int lane, const f32x4 (&v)[4]) {
    GAS unsigned* q = (GAS unsigned*)p + lane;
#pragma unroll
    for (int j = 0; j < 4; ++j) { unsigned w = 0u; w = __builtin_amdgcn_cvt_pk_fp8_f32(v[j][0], v[j][1], w, false); w = __builtin_amdgcn_cvt_pk_fp8_f32(v[j][2], v[j][3], w, true); q[64 * j] = w; }
}
__device__ __forceinline__ float row_rstd(const f32x4 (&v)[4]) {
    float s = 0.f;
#pragma unroll
    for (int j = 0; j < 4; ++j) s += (v[j][0] * v[j][0] + v[j][1] * v[j][1]) + (v[j][2] * v[j][2] + v[j][3] * v[j][3]);
    return rsqrtf(wave_sum(s) * (1.f / DM) + EPS);
}
__device__ __forceinline__ void mod_norm_store(const Ctx& C, const f32x4 (&x)[4], const float* g, const float* sc, const float* sh, bf16* hrow, unsigned char* h8row) {
    const float rstd = row_rstd(x); f32x4 gv[4], scv[4], shv[4], h[4];
    load_f32_row(g, C.lane, gv); load_f32_row(sc, C.lane, scv); load_f32_row(sh, C.lane, shv);
#pragma unroll
    for (int j = 0; j < 4; ++j) h[j] = x[j] * rstd * gv[j] * (1.f + scv[j]) + shv[j];
    store_bf16_row(hrow, C.lane, h); store_fp8_row(h8row, C.lane, h);
}
__device__ __forceinline__ void phase_prenorm0(const Ctx& C) {
    const float* mod = (const float*)(C.ws + WS_MOD); bf16* H = (bf16*)(C.ws + WS_H);
    const int gw = C.vcu * NWAVES + C.wave, NGW = C.G * NWAVES;
    for (int row = gw; row < T_ALL; row += NGW) {
        const float* src = row < T_P ? C.in[I_XP] + (size_t)row * DM : C.in[I_XS] + (size_t)(row - T_P) * DM;
        f32x4 x[4]; load_f32_row(src, C.lane, x);
        const float* mb = mod + (size_t)bidx_of_row(row) * 6144;
        mod_norm_store(C, x, C.in[I_GPREM], mb + 1 * DM, mb + 0 * DM, H + (size_t)row * DM, (unsigned char*)(C.out + (size_t)row * DM) + 2048);
    }
}
__device__ __forceinline__ void rows_core(const Ctx& C, int row, const f32x4 (&s)[4], f32x4 (&x)[4], const f32x4 (&gtv)[4], bool do_h, const f32x4 (&gpsc)[4], const f32x4 (&sh)[4], bool st, bool xf32, bool h8) {
    const float rstd = row_rstd(s);
#pragma unroll
    for (int j = 0; j < 4; ++j) x[j] = x[j] + gtv[j] * (s[j] * rstd);
    if (st) { if (xf32) store_f32_row(C.out + (size_t)row * DM, C.lane, x); else store_bf16_row((bf16*)(C.out + (size_t)row * DM), C.lane, x); }
    if (do_h) { const float r2 = row_rstd(x); f32x4 h[4];
#pragma unroll
        for (int j = 0; j < 4; ++j) h[j] = x[j] * r2 * gpsc[j] + sh[j];
        store_bf16_row(st ? (bf16*)(C.ws + WS_H) + (size_t)row * DM : (bf16*)(C.ws + WS_SCR) + (size_t)row * DM, C.lane, h);
        if (h8 && st) store_fp8_row((unsigned char*)(C.out + (size_t)row * DM) + 2048, C.lane, h); }
}
__device__ __forceinline__ const float* xrow_ptr(const Ctx& C, int row, bool from_inputs) { return from_inputs ? (row < T_P ? C.in[I_XP] + (size_t)row * DM : C.in[I_XS] + (size_t)(row - T_P) * DM) : C.out + (size_t)row * DM; }
__device__ __forceinline__ void phase_rows(const Ctx& C, const bf16* src, int l, int gt_i, const float* gpost, bool do_h, const float* gpre, int lh, int sc_i, int sh_i, bool st = true, bool x_in = false, bool xf32 = false, bool h8 = false) {
    const float* mod = (const float*)(C.ws + WS_MOD);
    const int gw = C.vcu * NWAVES + C.wave, NGW = C.G * NWAVES;
    for (int grp = gw; grp < T_P / 8 + T_S; grp += NGW) {
        const int row0 = grp < T_P / 8 ? grp * 8 : T_P + (grp - T_P / 8), nr = grp < T_P / 8 ? 8 : 1, bi = bidx_of_row(row0);
        f32x4 s0[4], x0[4], s1[4], x1[4], s2[4], x2[4], s3[4], x3[4];
#define ROW_LD(S, X, j) do { load_bf16_row(src + (size_t)(row0 + (j)) * DM, C.lane, S); if (x_in) load_f32_row(xrow_ptr(C, row0 + (j), true), C.lane, X); else load_bf16_row((const bf16*)(C.out + (size_t)(row0 + (j)) * DM), C.lane, X); } while (0)
        ROW_LD(s0, x0, 0);
        if (nr == 8) { ROW_LD(s1, x1, 1); ROW_LD(s2, x2, 2); ROW_LD(s3, x3, 3); }
        f32x4 gtv[4], gpsc[4], sh[4];
        { f32x4 a[4], bq[4]; load_f32_row(mod + ((size_t)l * NBC + bi) * 6144 + gt_i * DM, C.lane, a); load_f32_row(gpost, C.lane, bq);
#pragma unroll
          for (int j = 0; j < 4; ++j) gtv[j] = a[j] * bq[j];
          const float* mb = mod + ((size_t)lh * NBC + bi) * 6144; load_f32_row(gpre, C.lane, a); load_f32_row(mb + sc_i * DM, C.lane, bq); load_f32_row(mb + sh_i * DM, C.lane, sh);
#pragma unroll
          for (int j = 0; j < 4; ++j) gpsc[j] = a[j] * (1.f + bq[j]); }
        __builtin_amdgcn_sched_barrier(0);
        if (nr == 8) {
            rows_core(C, row0 + 0, s0, x0, gtv, do_h, gpsc, sh, st, xf32, h8); __builtin_amdgcn_sched_barrier(0); ROW_LD(s0, x0, 4); __builtin_amdgcn_sched_barrier(0);
            rows_core(C, row0 + 1, s1, x1, gtv, do_h, gpsc, sh, st, xf32, h8); __builtin_amdgcn_sched_barrier(0); ROW_LD(s1, x1, 5); __builtin_amdgcn_sched_barrier(0);
            rows_core(C, row0 + 2, s2, x2, gtv, do_h, gpsc, sh, st, xf32, h8); __builtin_amdgcn_sched_barrier(0); ROW_LD(s2, x2, 6); __builtin_amdgcn_sched_barrier(0);
            rows_core(C, row0 + 3, s3, x3, gtv, do_h, gpsc, sh, st, xf32, h8); __builtin_amdgcn_sched_barrier(0); ROW_LD(s3, x3, 7); __builtin_amdgcn_sched_barrier(0);
            rows_core(C, row0 + 4, s0, x0, gtv, do_h, gpsc, sh, st, xf32, h8); __builtin_amdgcn_sched_barrier(0);
            rows_core(C, row0 + 5, s1, x1, gtv, do_h, gpsc, sh, st, xf32, h8); __builtin_amdgcn_sched_barrier(0);
            rows_core(C, row0 + 6, s2, x2, gtv, do_h, gpsc, sh, st, xf32, h8); __builtin_amdgcn_sched_barrier(0);
            rows_core(C, row0 + 7, s3, x3, gtv, do_h, gpsc, sh, st, xf32, h8);
        } else rows_core(C, row0, s0, x0, gtv, do_h, gpsc, sh, st, xf32, h8);
#undef ROW_LD
    }
}

typedef __bf16 bf16x2_t __attribute__((ext_vector_type(2)));
typedef float f32x2 __attribute__((ext_vector_type(2)));
__device__ __forceinline__ unsigned pkbf(float a, float b) { f32x2 v = {a, b}; return __builtin_bit_cast(unsigned, __builtin_convertvector(v, bf16x2_t)); }
__device__ __forceinline__ bf16 f2b(float a) { return (bf16)(pkbf(a, 0.f) & 0xffffu); }
#define MFMA32(a, b, c) __builtin_amdgcn_mfma_f32_32x32x16_bf16((a), (b), (c), 0, 0, 0)
__device__ __forceinline__ int crow(int i, int h) { return (i & 3) + 8 * (i >> 2) + 4 * h; }
__device__ __forceinline__ int swap23(int k) { return (k & ~12) | ((k & 4) << 1) | ((k & 8) >> 1); }
template <int S> __device__ __forceinline__ bf16x8 pack_step(const f32x16& x) {
    v4u p; p.x = pkbf(x[8 * S], x[8 * S + 1]); p.y = pkbf(x[8 * S + 2], x[8 * S + 3]); p.z = pkbf(x[8 * S + 4], x[8 * S + 5]); p.w = pkbf(x[8 * S + 6], x[8 * S + 7]);
    return __builtin_bit_cast(bf16x8, p);
}
__device__ __forceinline__ f32x16 zero16() { f32x16 z;
#pragma unroll
    for (int i = 0; i < 16; ++i) z[i] = 0.f; return z; }
__device__ __forceinline__ bf16x8 ldg8(const bf16* p) { return *(const GAS bf16x8*)p; }
constexpr size_t WS_SMALL = 47 * MiB;
constexpr size_t SM_ECUM = 0, SM_ELAST = 2048 * 64 * 4, SM_GDEC = SM_ELAST + 2048 * 4;
constexpr size_t SCR_GDN = WS_SCR, GDN_UNIT = 73728;
constexpr size_t SCR_SSD = WS_SCR + 72 * MiB, SSD_UNIT = 147456;
constexpr size_t WS_SSQ = 465 * MiB;
static_assert(SCR_GDN + (size_t)1024 * GDN_UNIT <= SCR_SSD && SCR_SSD + (size_t)512 * SSD_UNIT <= WS_SSQ && WS_SSQ + (size_t)T_ALL * 8 * 4 <= WS_END, "scratch map");

__device__ __forceinline__ LAS unsigned char* lds_v(const Ctx& C) { unsigned a = (unsigned)(size_t)C.lds; asm volatile("" : "+v"(a)); return (LAS unsigned char*)(size_t)a; }
__device__ __forceinline__ void sample_gla(const Ctx& C_, int l, int b, int h) {
    Ctx C = C_; asm volatile("v_mbcnt_lo_u32_b32 %0, -1, 0\n\tv_mbcnt_hi_u32_b32 %0, -1, %0" : "=v"(C.lane)); C.tid = C.wave * 64 + C.lane;
    LAS float* L = (LAS float*)lds_v(C); LAS float *sq = L, *sk = L + 512, *sv = L + 1024, *sa = L + 1536, *sgr = L + 2048, *red = L + 2560;
    const bf16* U = (const bf16*)(C.ws + WS_U); bf16* YS0 = (bf16*)(C.ws + WS_YS);
    const int r0 = T_P + 4 * b;
    const int kg = C.tid >> 5, vq = C.tid & 31;
    const size_t soff = (((size_t)l * 128 + b) * 4 + h) * 16384 + (size_t)(kg * 8) * 128 + 4 * vq;
    const float* sin = C.in[I_SGLA] + soff; f32x4 S[8];
#pragma unroll
    for (int i = 0; i < 8; ++i) S[i] = *(const GAS f32x4*)(sin + i * 128);
    float gn0 = 0.f, gn1 = 0.f; if (C.wave < 4) { const float* gn = C.in[I_GGLAN] + l * 128; gn0 = gn[C.lane]; gn1 = gn[C.lane + 64]; }
    LBAR();
    { const int t = C.tid >> 7, i = C.tid & 127; const bf16* ur = U + (size_t)(r0 + t) * NU;
      sq[t * 128 + i] = bf2f(ur[C_GQ + h * 128 + i]) * 0.08838834764831845f; sk[t * 128 + i] = bf2f(ur[C_GK + h * 128 + i]); sv[t * 128 + i] = bf2f(ur[C_GV + h * 128 + i]); sgr[t * 128 + i] = bf2f(ur[C_GR + h * 128 + i]);
      float acc = C.in[I_BGG][l * 512 + h * 128 + i]; const float* wg = C.in[I_WGG] + (size_t)l * 16 * 512 + h * 128 + i;
#pragma unroll
      for (int r = 0; r < 16; ++r) acc += bf2f(ur[C_GLR + r]) * wg[r * 512];
      sa[t * 128 + i] = __expf(logsigmoid_f(acc) * 0.0625f); }
    LBAR();
    f32x4 ra[4][2], rk[4][2], rq[4][2], rvv[4];
#pragma unroll
    for (int t = 0; t < 4; ++t) { rvv[t] = *(const LAS f32x4*)(sv + t * 128 + 4 * vq);
#pragma unroll
        for (int q = 0; q < 2; ++q) { ra[t][q] = *(const LAS f32x4*)(sa + t * 128 + kg * 8 + 4 * q); rk[t][q] = *(const LAS f32x4*)(sk + t * 128 + kg * 8 + 4 * q); rq[t][q] = *(const LAS f32x4*)(sq + t * 128 + kg * 8 + 4 * q); } }
#pragma unroll
    for (int t = 0; t < 4; ++t) { f32x4 po = {0.f, 0.f, 0.f, 0.f};
#pragma unroll
        for (int i = 0; i < 8; ++i) { S[i] = S[i] * ra[t][i >> 2][i & 3] + rk[t][i >> 2][i & 3] * rvv[t]; po += rq[t][i >> 2][i & 3] * S[i]; }
        *(LAS f32x4*)(red + (t * 16 + kg) * 128 + 4 * vq) = po; }
    float* sout = C.out + O_SGLA + soff;
#pragma unroll
    for (int i = 0; i < 8; ++i) *(GAS f32x4*)(sout + i * 128) = S[i];
    LBAR();
    if (C.wave < 4) { const int t = C.wave; float o0 = 0.f, o1 = 0.f;
#pragma unroll
        for (int g2 = 0; g2 < 16; ++g2) { o0 += red[(t * 16 + g2) * 128 + C.lane]; o1 += red[(t * 16 + g2) * 128 + C.lane + 64]; }
        const float rstd = rsqrtf(wave_sum(o0 * o0 + o1 * o1) * (1.f / 128.f) + EPS);
        bf16* yr = YS0 + (size_t)(r0 + t) * 512 + h * 128;
        yr[C.lane] = f2b(o0 * rstd * gn0 * silu_f(sgr[t * 128 + C.lane])); yr[C.lane + 64] = f2b(o1 * rstd * gn1 * silu_f(sgr[t * 128 + C.lane + 64])); }
}
__device__ __forceinline__ void sample_ssd(const Ctx& C_, int l, int b, int g) {
    Ctx C = C_; asm volatile("v_mbcnt_lo_u32_b32 %0, -1, 0\n\tv_mbcnt_hi_u32_b32 %0, -1, %0" : "=v"(C.lane)); C.tid = C.wave * 64 + C.lane;
    LAS float* L = (LAS float*)lds_v(C); LAS float *xin = L, *cx = L + 3584, *dts = L + 5632, *dAs = L + 5648, *ysr = L + 5664;
    const bf16* U = (const bf16*)(C.ws + WS_U); bf16* YS1 = (bf16*)(C.ws + WS_YS) + (size_t)T_ALL * 512;
    const int r0 = T_P + 4 * b;
    const int pg = C.tid >> 5, nq = C.tid & 31;
    f32x4 SS[4][4]; float wvh[4], bvh, dtr = 0.f, zz[4] = {0.f, 0.f, 0.f, 0.f};
#pragma unroll
    for (int hh = 0; hh < 4; ++hh) { const float* sin = C.in[I_SSSD] + ((((size_t)l * 128 + b) * 8 + g * 4 + hh) * 64 + pg * 4) * 128 + 4 * nq;
#pragma unroll
        for (int i = 0; i < 4; ++i) SS[hh][i] = *(const GAS f32x4*)(sin + i * 128); }
    { const int c = C.tid; const int ch = c < 256 ? g * 256 + c : (c < 384 ? 512 + g * 128 + (c - 256) : 768 + g * 128 + (c - 384)); bvh = C.in[I_BSC][l * 1024 + ch];
#pragma unroll
      for (int j = 0; j < 4; ++j) wvh[j] = C.in[I_WSC][((size_t)l * 4 + j) * 1024 + ch]; }
    if (C.tid < 16) dtr = bf2f(U[(size_t)(r0 + (C.tid >> 2)) * NU + C_SDT + g * 4 + (C.tid & 3)]);
    if (C.wave < 4) {
#pragma unroll
        for (int j = 0; j < 4; ++j) zz[j] = bf2f(U[(size_t)(r0 + C.wave) * NU + C_SZ + g * 256 + C.lane + 64 * j]); }
    LBAR();
    { const int c = C.tid; const int ch = c < 256 ? g * 256 + c : (c < 384 ? 512 + g * 128 + (c - 256) : 768 + g * 128 + (c - 384));
      float xr[7];
#pragma unroll
      for (int j = 0; j < 3; ++j) xr[j] = C.in[I_CSSD][(((size_t)l * 128 + b) * 3 + j) * 1024 + ch];
#pragma unroll
      for (int j = 0; j < 4; ++j) xr[3 + j] = bf2f(U[(size_t)(r0 + j) * NU + C_SXBC + ch]);
#pragma unroll
      for (int j = 0; j < 7; ++j) xin[j * 512 + c] = xr[j];
#pragma unroll
      for (int j = 4; j < 7; ++j) C.out[O_SCS + (((size_t)l * 128 + b) * 3 + (j - 4)) * 1024 + ch] = xr[j]; }
    if (C.tid < 16) { const int hd = g * 4 + (C.tid & 3); const float dt = softplus_f(dtr + C.in[I_SDTB][l * 8 + hd]);
        dts[C.tid] = dt; dAs[C.tid] = __expf(-dt * __expf(C.in[I_SALOG][l * 8 + hd])); }
    LBAR();
    { const int c = C.tid; const int ch = c < 256 ? g * 256 + c : (c < 384 ? 512 + g * 128 + (c - 256) : 768 + g * 128 + (c - 384)); float xr[7];
#pragma unroll
      for (int j = 0; j < 7; ++j) xr[j] = xin[j * 512 + c];
#pragma unroll
      for (int t = 0; t < 4; ++t) { float y = bvh;
#pragma unroll
          for (int j = 0; j < 4; ++j) y += xr[t + j] * wvh[j];
          cx[t * 512 + c] = silu_f(y); } }
    LBAR();
#pragma unroll
    for (int hh = 0; hh < 4; ++hh) { const int hd = g * 4 + hh; const float Dv = C.in[I_SD][l * 8 + hd];
        const size_t soff = ((((size_t)l * 128 + b) * 8 + hd) * 64 + pg * 4) * 128 + 4 * nq; f32x4 (&S)[4] = SS[hh];
#pragma unroll
        for (int t = 0; t < 4; ++t) { const float dA = dAs[t * 4 + hh], dt = dts[t * 4 + hh]; const f32x4 B4 = *(const LAS f32x4*)(cx + t * 512 + 256 + 4 * nq), C4 = *(const LAS f32x4*)(cx + t * 512 + 384 + 4 * nq);
#pragma unroll
            for (int i = 0; i < 4; ++i) { const float xv = cx[t * 512 + hh * 64 + pg * 4 + i]; S[i] = S[i] * dA + (dt * xv) * B4;
                float y = (S[i][0] * C4[0] + S[i][1] * C4[1]) + (S[i][2] * C4[2] + S[i][3] * C4[3]);
                y += SWZ_XOR(y, 1); y += SWZ_XOR(y, 2); y += SWZ_XOR(y, 4); y += SWZ_XOR(y, 8); y += SWZ_XOR(y, 16);
                if (nq == 0) ysr[t * 256 + hh * 64 + pg * 4 + i] = y + Dv * xv; } }
        float* sout = C.out + O_SSSD + soff;
#pragma unroll
        for (int i = 0; i < 4; ++i) *(GAS f32x4*)(sout + i * 128) = S[i]; }
    LBAR();
    if (C.wave < 4) { const int t = C.wave; bf16* yr = YS1 + (size_t)(r0 + t) * 512 + g * 256; float* SSQ = (float*)(C.ws + WS_SSQ);
#pragma unroll
        for (int j = 0; j < 4; ++j) { const int c = C.lane + 64 * j; const float v = ysr[t * 256 + c] * silu_f(zz[j]);
            yr[c] = f2b(v); const float s2 = wave_sum(v * v); if (C.lane == 0) SSQ[(size_t)(r0 + t) * 8 + g * 4 + j] = s2; } }
}
__device__ __forceinline__ void sample_gdn(const Ctx& C_, int l, int b, int h) {
    Ctx C = C_; asm volatile("v_mbcnt_lo_u32_b32 %0, -1, 0\n\tv_mbcnt_hi_u32_b32 %0, -1, %0" : "=v"(C.lane)); C.tid = C.wave * 64 + C.lane;
    LAS float* L = (LAS float*)lds_v(C);
    LAS float *xin = L, *cq = L + 2688, *ck = L + 3200, *cv = L + 3712, *sc = L + 4224;
    LAS float *gg = sc, *be = sc + 4, *cum = sc + 8, *kk = sc + 16, *qk = sc + 32;
    LAS float *Uv = L + 4288, *Wk = L + 4800, *qe = L + 5312, *ke = L + 5824, *vn = L + 6336, *ob = L + 6848, *red = L + 7360;
    const bf16* U = (const bf16*)(C.ws + WS_U); bf16* YS2 = (bf16*)(C.ws + WS_YS) + (size_t)2 * T_ALL * 512;
    const int r0 = T_P + 4 * b;
    const int kg = C.tid >> 5, vq = C.tid & 31;
    const size_t soff = (((size_t)l * 128 + b) * 4 + h) * 16384 + (size_t)(kg * 8) * 128 + 4 * vq;
    const float* sin = C.in[I_SGDN] + soff; f32x4 S[8];
#pragma unroll
    for (int i = 0; i < 8; ++i) S[i] = *(const GAS f32x4*)(sin + i * 128);
    float dav = 0.f, dbv = 0.f, gn0 = 0.f, gn1 = 0.f, dg0 = 0.f, dg1 = 0.f;
    if (C.tid < 4) { dav = bf2f(U[(size_t)(r0 + C.tid) * NU + C_DA + h]); dbv = bf2f(U[(size_t)(r0 + C.tid) * NU + C_DB + h]); }
    if (C.wave < 4) { const float* gn = C.in[I_GGDNN] + l * 128; const bf16* ur = U + (size_t)(r0 + C.wave) * NU + C_DG + h * 128; gn0 = gn[C.lane]; gn1 = gn[C.lane + 64]; dg0 = bf2f(ur[C.lane]); dg1 = bf2f(ur[C.lane + 64]); }
    LBAR();
    float xr[7], wv[4];
    const int cch = C.tid < 384 ? C.tid : 0, gch = (cch >> 7) * 512 + h * 128 + (cch & 127);
    if (C.tid < 384) {
#pragma unroll
        for (int j = 0; j < 3; ++j) xr[j] = C.in[I_CGDN][(((size_t)l * 128 + b) * 3 + j) * 1536 + gch];
#pragma unroll
        for (int j = 0; j < 4; ++j) { xr[3 + j] = bf2f(U[(size_t)(r0 + j) * NU + C_DQKV + gch]); wv[j] = C.in[I_WGC][((size_t)l * 4 + j) * 1536 + gch]; }
#pragma unroll
        for (int j = 4; j < 7; ++j) C.out[O_SCD + (((size_t)l * 128 + b) * 3 + (j - 4)) * 1536 + gch] = xr[j]; }
    if (C.wave == 0) { const float A = __expf(C.in[I_GALOG][l * 4 + h]), db = C.in[I_GDTB][l * 4 + h]; const float g = -A * softplus_f(dav + db);
        const float g0 = __int_as_float(__builtin_amdgcn_readlane(__float_as_int(g), 0)), g1 = __int_as_float(__builtin_amdgcn_readlane(__float_as_int(g), 1)), g2 = __int_as_float(__builtin_amdgcn_readlane(__float_as_int(g), 2));
        if (C.lane < 4) { const float cs = g + (C.lane > 0 ? g0 : 0.f) + (C.lane > 1 ? g1 : 0.f) + (C.lane > 2 ? g2 : 0.f); gg[C.lane] = g; cum[C.lane] = cs; be[C.lane] = sigmoid_f(dbv); } }
    LBAR();
    if (C.tid < 384) { const int w = cch >> 7, d = cch & 127;
#pragma unroll
        for (int t = 0; t < 4; ++t) { float y = 0.f;
#pragma unroll
            for (int j = 0; j < 4; ++j) y += xr[t + j] * wv[j];
            (w == 0 ? cq : (w == 1 ? ck : cv))[t * 128 + d] = silu_f(y); } }
    LBAR();
    { LAS float* vec = (C.wave < 4 ? cq : ck) + (C.wave & 3) * 128; const float a0 = vec[C.lane], a1 = vec[C.lane + 64];
      const float inv = rsqrtf(wave_sum(a0 * a0 + a1 * a1) + EPS) * (C.wave < 4 ? 0.08838834764831845f : 1.f); vec[C.lane] = a0 * inv; vec[C.lane + 64] = a1 * inv; }
    LBAR();
#pragma unroll
    for (int i = 0; i < 4; ++i) { const int d = C.wave * 4 + i, t = (d >> 2) & 3, s = d & 3; const LAS float* a = (d < 16 ? ck : cq) + t * 128; const LAS float* bb = ck + s * 128;
        const float v = wave_sum(a[C.lane] * bb[C.lane] + a[C.lane + 64] * bb[C.lane + 64]); if (C.lane == 0) (d < 16 ? kk : qk)[t * 4 + s] = v; }
    LBAR();
    { const int w = C.tid >> 7, i = C.tid & 127;
      if (w == 0) { float u[4];
#pragma unroll
          for (int t = 0; t < 4; ++t) { float x = cv[t * 128 + i] * be[t];
#pragma unroll
              for (int s = 0; s < 4; ++s) if (s < t) x -= be[t] * be[s] * kk[t * 4 + s] * __expf(cum[t] - cum[s]) * u[s];
              u[t] = x; Uv[t * 128 + i] = x; } }
      else if (w == 1) { float u[4];
#pragma unroll
          for (int t = 0; t < 4; ++t) { float x = ck[t * 128 + i] * be[t] * __expf(cum[t]);
#pragma unroll
              for (int s = 0; s < 4; ++s) if (s < t) x -= be[t] * be[s] * kk[t * 4 + s] * __expf(cum[t] - cum[s]) * u[s];
              u[t] = x; Wk[t * 128 + i] = x; } }
      else if (w == 2) {
#pragma unroll
          for (int t = 0; t < 4; ++t) qe[t * 128 + i] = cq[t * 128 + i] * __expf(cum[t]); }
      else {
#pragma unroll
          for (int t = 0; t < 4; ++t) ke[t * 128 + i] = ck[t * 128 + i] * __expf(cum[3] - cum[t]); } }
    LBAR();
    { f32x4 av[8][2];
#pragma unroll
      for (int vec = 0; vec < 8; ++vec) { const LAS float* a = (vec < 4 ? Wk : qe) + (vec & 3) * 128 + kg * 8; av[vec][0] = *(const LAS f32x4*)a; av[vec][1] = *(const LAS f32x4*)(a + 4); }
#pragma unroll
      for (int vec = 0; vec < 8; ++vec) { f32x4 po = {0.f, 0.f, 0.f, 0.f};
#pragma unroll
          for (int i = 0; i < 8; ++i) po += av[vec][i >> 2][i & 3] * S[i];
          *(LAS f32x4*)(red + (vec * 16 + kg) * 128 + 4 * vq) = po; } }
    LBAR();
    float qs = 0.f; { const int t = C.tid >> 7, v = C.tid & 127; float ws = 0.f;
#pragma unroll
        for (int g2 = 0; g2 < 16; ++g2) { ws += red[(t * 16 + g2) * 128 + v]; qs += red[((4 + t) * 16 + g2) * 128 + v]; }
        vn[t * 128 + v] = Uv[t * 128 + v] - ws; }
    LBAR();
    { const int t = C.tid >> 7, v = C.tid & 127; float o = qs;
#pragma unroll
        for (int s = 0; s < 4; ++s) if (s <= t) o += qk[t * 4 + s] * __expf(cum[t] - cum[s]) * vn[s * 128 + v];
        ob[t * 128 + v] = o; }
    { const float dl = __expf(cum[3]);
      f32x4 kq[4][2], vq4[4];
#pragma unroll
      for (int s = 0; s < 4; ++s) { kq[s][0] = *(const LAS f32x4*)(ke + s * 128 + kg * 8); kq[s][1] = *(const LAS f32x4*)(ke + s * 128 + kg * 8 + 4); vq4[s] = *(const LAS f32x4*)(vn + s * 128 + 4 * vq); }
#pragma unroll
      for (int i = 0; i < 8; ++i) { S[i] = S[i] * dl;
#pragma unroll
          for (int s = 0; s < 4; ++s) S[i] += kq[s][i >> 2][i & 3] * vq4[s]; }
      float* sout = C.out + O_SGDN + soff;
#pragma unroll
      for (int i = 0; i < 8; ++i) *(GAS f32x4*)(sout + i * 128) = S[i]; }
    LBAR();
    if (C.wave < 4) { const int t = C.wave; const float o0 = ob[t * 128 + C.lane], o1 = ob[t * 128 + C.lane + 64];
        const float rstd = rsqrtf(wave_sum(o0 * o0 + o1 * o1) * (1.f / 128.f) + EPS);
        bf16* yr = YS2 + (size_t)(r0 + t) * 512 + h * 128;
        yr[C.lane] = f2b(o0 * rstd * gn0 * silu_f(dg0)); yr[C.lane + 64] = f2b(o1 * rstd * gn1 * silu_f(dg1)); }
}
constexpr int LDK = 136, LDC = 72;
__device__ __forceinline__ void m1_gla(const Ctx& C_, int l, int b, int c, int h, bool st) {
    Ctx C = C_; asm volatile("v_mbcnt_lo_u32_b32 %0, -1, 0\n\tv_mbcnt_hi_u32_b32 %0, -1, %0" : "=v"(C.lane)); C.tid = C.wave * 64 + C.lane;
    LAS unsigned char* lds = lds_v(C);
    LAS float* fL = (LAS float*)lds;
    LAS bf16* sQD = (LAS bf16*)(lds + 32768); LAS bf16* sKD = (LAS bf16*)(lds + 32768 + 64 * LDK * 2);
    LAS float* segs = (LAS float*)(lds + 32768 + 2 * 64 * LDK * 2); LAS float* sWg = segs + 512; LAS float* sBg = sWg + 2048;
    LAS bf16* oKL = (LAS bf16*)(lds + 81920); LAS bf16* oVT = (LAS bf16*)(lds + 100352); LAS bf16* oA = (LAS bf16*)(lds + 118784);
    bf16* U = (bf16*)(C.ws + WS_U); bf16* YS0 = (bf16*)(C.ws + WS_YS);
    const int t0 = b * SEQ + c * CH, t = C.tid >> 3, cg = C.tid & 7, k0 = cg * 16;
    float wg4[4], bg1 = 0.f;
#pragma unroll
    for (int i = 0; i < 4; ++i) { const int idx = C.tid + i * NTHR; wg4[i] = C.in[I_WGG][(size_t)l * 16 * 512 + (idx >> 7) * 512 + h * 128 + (idx & 127)]; }
    if (C.tid < 128) bg1 = C.in[I_BGG][l * 512 + h * 128 + C.tid];
    bf16* urow = U + (size_t)(t0 + t) * NU;
    const v4u ga = *(const GAS v4u*)(urow + C_GLR), gb = *(const GAS v4u*)(urow + C_GLR + 8);
    v4u rq[2], rk[2], rv[2], rg[2];
#pragma unroll
    for (int i = 0; i < 2; ++i) { rq[i] = *(const GAS v4u*)(urow + C_GQ + h * 128 + k0 + 8 * i); rk[i] = *(const GAS v4u*)(urow + C_GK + h * 128 + k0 + 8 * i);
        rv[i] = *(const GAS v4u*)(urow + C_GV + h * 128 + k0 + 8 * i); rg[i] = *(const GAS v4u*)(urow + C_GR + h * 128 + k0 + 8 * i); }
    __builtin_amdgcn_sched_barrier(0);
    LBAR();
    float glr[16];
#pragma unroll
    for (int i = 0; i < 4; ++i) { glr[2 * i] = blo(ga[i]); glr[2 * i + 1] = bhi(ga[i]); glr[8 + 2 * i] = blo(gb[i]); glr[8 + 2 * i + 1] = bhi(gb[i]); }
#pragma unroll
    for (int i = 0; i < 4; ++i) sWg[C.tid + i * NTHR] = wg4[i];
    if (C.tid < 128) sBg[C.tid] = bg1;
    VM_WAIT();
    __syncthreads();
    { float la[16]; f32x4 wq[3][4];
#pragma unroll
      for (int q = 0; q < 4; ++q) { const f32x4 bq = *(const LAS f32x4*)(sBg + k0 + 4 * q); la[4 * q] = bq[0]; la[4 * q + 1] = bq[1]; la[4 * q + 2] = bq[2]; la[4 * q + 3] = bq[3];
          wq[0][q] = *(const LAS f32x4*)(sWg + k0 + 4 * q); wq[1][q] = *(const LAS f32x4*)(sWg + 128 + k0 + 4 * q); }
#pragma unroll
      for (int r = 0; r < 16; ++r) {
          if (r + 2 < 16) {
#pragma unroll
              for (int q = 0; q < 4; ++q) wq[(r + 2) % 3][q] = *(const LAS f32x4*)(sWg + (r + 2) * 128 + k0 + 4 * q); }
          __builtin_amdgcn_sched_barrier(0);
#pragma unroll
          for (int j = 0; j < 16; ++j) la[j] += glr[r] * wq[r % 3][j >> 2][j & 3];
          __builtin_amdgcn_sched_barrier(0); }
#pragma unroll
      for (int j = 0; j < 16; ++j) la[j] = logsigmoid_f(la[j]) * 0.0625f;
#pragma unroll
      for (int j = 0; j < 4; ++j) *(LAS f32x4*)(fL + t * 128 + k0 + 4 * j) = (f32x4){la[4 * j], la[4 * j + 1], la[4 * j + 2], la[4 * j + 3]}; }
    LBAR();
    { const int seg = C.tid >> 7, k = C.tid & 127; float pre[16], s = 0.f;
#pragma unroll
      for (int i = 0; i < 16; ++i) { s += fL[(seg * 16 + i) * 128 + k]; pre[i] = s; }
      segs[seg * 128 + k] = s;
      LBAR();
      const float s0 = segs[k], s1 = segs[128 + k], s2 = segs[256 + k]; const float run = ((seg > 0 ? s0 : 0.f) + (seg > 1 ? s1 : 0.f)) + (seg > 2 ? s2 : 0.f);
#pragma unroll
      for (int i = 0; i < 16; ++i) fL[(seg * 16 + i) * 128 + k] = run + pre[i]; }
    LBAR();
    { float qd[16], kl[16], kd[16]; const float* gn = C.in[I_GGLAN] + l * 128; float ggv[16];
#pragma unroll
      for (int j = 0; j < 16; ++j) { const float bb = fL[t * 128 + k0 + j], bl = fL[63 * 128 + k0 + j];
          const unsigned wq = rq[j >> 3][(j >> 1) & 3], wk = rk[j >> 3][(j >> 1) & 3], wg = rg[j >> 3][(j >> 1) & 3];
          const float qv = (j & 1) ? bhi(wq) : blo(wq), kv = (j & 1) ? bhi(wk) : blo(wk), gv = (j & 1) ? bhi(wg) : blo(wg);
          qd[j] = qv * 0.08838834764831845f * __expf(bb); kd[j] = kv * __expf(-bb); kl[j] = kv * __expf(bl - bb); ggv[j] = gn[k0 + j] * silu_f(gv); }
      v4u w0, w1;
      w0.x = pkbf(qd[0], qd[1]); w0.y = pkbf(qd[2], qd[3]); w0.z = pkbf(qd[4], qd[5]); w0.w = pkbf(qd[6], qd[7]); w1.x = pkbf(qd[8], qd[9]); w1.y = pkbf(qd[10], qd[11]); w1.z = pkbf(qd[12], qd[13]); w1.w = pkbf(qd[14], qd[15]);
      *(LAS v4u*)(sQD + t * LDK + k0) = w0; *(LAS v4u*)(sQD + t * LDK + k0 + 8) = w1;
      { v4u g0, g1; g0.x = w0.x; g0.y = w0.y; g0.z = w1.x; g0.w = w1.y; g1.x = w0.z; g1.y = w0.w; g1.z = w1.z; g1.w = w1.w;
        if (st) { *(GAS v4u*)(urow + C_GQ + h * 128 + k0) = g0; *(GAS v4u*)(urow + C_GQ + h * 128 + k0 + 8) = g1; } }
      w0.x = pkbf(kd[0], kd[1]); w0.y = pkbf(kd[2], kd[3]); w0.z = pkbf(kd[4], kd[5]); w0.w = pkbf(kd[6], kd[7]); w1.x = pkbf(kd[8], kd[9]); w1.y = pkbf(kd[10], kd[11]); w1.z = pkbf(kd[12], kd[13]); w1.w = pkbf(kd[14], kd[15]);
      *(LAS v4u*)(sKD + t * LDK + k0) = w0; *(LAS v4u*)(sKD + t * LDK + k0 + 8) = w1;
#pragma unroll
      for (int j = 0; j < 16; ++j) { const int k = k0 + j, tsw = t ^ (cg << 3); oKL[k * LDC + tsw] = f2b(kl[j]);
          const unsigned wv = rv[j >> 3][(j >> 1) & 3]; oVT[k * LDC + tsw] = (bf16)((j & 1) ? (wv >> 16) : (wv & 0xffffu)); }
      v4u y0, y1; y0.x = pkbf(ggv[0], ggv[1]); y0.y = pkbf(ggv[2], ggv[3]); y0.z = pkbf(ggv[4], ggv[5]); y0.w = pkbf(ggv[6], ggv[7]); y1.x = pkbf(ggv[8], ggv[9]); y1.y = pkbf(ggv[10], ggv[11]); y1.z = pkbf(ggv[12], ggv[13]); y1.w = pkbf(ggv[14], ggv[15]);
      bf16* yr = YS0 + (size_t)(t0 + t) * 512 + h * 128 + k0; if (st) { *(GAS v4u*)yr = y0; *(GAS v4u*)(yr + 8) = y1; } }
    if (C.tid < 128 && st) { const int k = C.tid; ((float*)(U + (size_t)(t0 + (k >> 5)) * NU + C_GR + h * 128 + 64))[k & 31] = __expf(fL[63 * 128 + k]); }
    LBAR();
    if (C.wave < 4) { const int tt = C.wave & 1, st = C.wave >> 1, r = C.lane & 31, hl = C.lane >> 5; f32x16 acc = zero16();
        if (st <= tt) {
#pragma unroll
            for (int ks = 0; ks < 8; ++ks) { const bf16x8 a = *(const LAS bf16x8*)(sQD + (32 * tt + r) * LDK + 16 * ks + 8 * hl), bb = *(const LAS bf16x8*)(sKD + (32 * st + r) * LDK + 16 * ks + 8 * hl); acc = MFMA32(a, bb, acc); } }
#pragma unroll
        for (int i = 0; i < 16; ++i) { const int tr = 32 * tt + crow(i, hl), s = 32 * st + r; oA[tr * LDC + s] = f2b(s <= tr ? acc[i] : 0.f); } }
    LBAR();
    if (st)
#pragma unroll
    for (int it = 0; it < 5; ++it) { const int idx = it * NTHR + C.tid;
        if (it < 2) { const int k = idx >> 3, c8 = idx & 7; *(GAS v4u*)(U + (size_t)(t0 + (k >> 1)) * NU + C_GK + h * 128 + (k & 1) * 64 + c8 * 8) = *(const LAS v4u*)(oKL + k * LDC + ((c8 ^ (k >> 4)) & 7) * 8); }
        else if (it < 4) { const int q = idx - 1024, k = q >> 3, c8 = q & 7; *(GAS v4u*)(U + (size_t)(t0 + (k >> 1)) * NU + C_GV + h * 128 + (k & 1) * 64 + c8 * 8) = *(const LAS v4u*)(oVT + k * LDC + ((c8 ^ (k >> 4)) & 7) * 8); }
        else { const int q = idx - 2048, tr = q >> 3, c8 = q & 7; *(GAS v4u*)(U + (size_t)(t0 + tr) * NU + C_GR + h * 128 + c8 * 8) = *(const LAS v4u*)(oA + tr * LDC + c8 * 8); } }
}
template <int I> struct InvRowH {
    static __device__ __forceinline__ void run(float (&x)[32], f32x4 (&cur)[8], f32x4 (&nxt)[8], const LAS float* sAb, LAS bf16* sXw, int col, bool keep) {
        if constexpr (I < 31) {
#pragma unroll
            for (int j4 = 0; j4 < (I + 4) / 4; ++j4) nxt[j4] = *(const LAS f32x4*)(sAb + (I + 1) * 64 + 4 * j4); }
        __builtin_amdgcn_sched_barrier(0);
        float a0 = (I == col) ? 1.f : 0.f, a1 = 0.f, a2 = 0.f, a3 = 0.f;
#pragma unroll
        for (int j4 = 0; j4 < (I + 3) / 4; ++j4) { const f32x4 av = cur[j4];
            if (4 * j4 + 0 < I) a0 -= av[0] * x[4 * j4 + 0]; if (4 * j4 + 1 < I) a1 -= av[1] * x[4 * j4 + 1]; if (4 * j4 + 2 < I) a2 -= av[2] * x[4 * j4 + 2]; if (4 * j4 + 3 < I) a3 -= av[3] * x[4 * j4 + 3]; }
        x[I] = (a0 + a1) + (a2 + a3); sXw[I * LDC] = f2b(keep ? x[I] : 0.f);
        __builtin_amdgcn_sched_barrier(0);
        if constexpr (I < 31) InvRowH<I + 1>::run(x, nxt, cur, sAb, sXw, col, keep);
    }
};
__device__ __forceinline__ void m1_gdn(const Ctx& C_, int l, int b, int c, int h) {
    Ctx C = C_; asm volatile("v_mbcnt_lo_u32_b32 %0, -1, 0\n\tv_mbcnt_hi_u32_b32 %0, -1, %0" : "=v"(C.lane)); C.tid = C.wave * 64 + C.lane;
    LAS unsigned char* lds = lds_v(C);
    LAS float* sA = (LAS float*)lds;
    LAS bf16* sX = (LAS bf16*)(lds + 16384);
    LAS float* sG = (LAS float*)(lds + 25600); LAS float *sCum = sG + 64, *sBe = sG + 128;
    LAS bf16* sK = (LAS bf16*)(lds + 26624); LAS bf16* sQ = sK + 64 * LDK;
    LAS bf16* sVT = (LAS bf16*)(lds + 61440); LAS bf16* sKT = sVT + 128 * LDC;
    LAS bf16* oKeT = (LAS bf16*)(lds + 98304); LAS bf16* oW = (LAS bf16*)(lds + 116736); LAS bf16* oAqk = (LAS bf16*)(lds + 134144);
    const bf16* U = (const bf16*)(C.ws + WS_U); bf16* YS2 = (bf16*)(C.ws + WS_YS) + (size_t)2 * T_ALL * 512;
    unsigned char* scr = C.ws + SCR_GDN + (size_t)((b * NCH + c) * 4 + h) * GDN_UNIT;
    bf16* gW = (bf16*)scr; bf16* gQe = (bf16*)(scr + 16384); bf16* gKeT = (bf16*)(scr + 32768); bf16* gUT = (bf16*)(scr + 49152); bf16* gAqk = (bf16*)(scr + 65536);
    const int t0 = b * SEQ + c * CH, t = C.tid >> 3, cg = C.tid & 7, d0 = cg * 16, w8 = C.wave * 8;
    float dar = 0.f, dbr = 0.f;
    if (C.tid < 64) { const bf16* ur = U + (size_t)(t0 + C.tid) * NU; dar = bf2f(ur[C_DA + h]); dbr = bf2f(ur[C_DB + h]); }
    float q0[8], q1[8], k0[8], k1[8], v0[8], v1[8]; v4u dg0, dg1;
    {   unsigned uq[11], uk[11], uv[11]; f32x2 wq[4], wk[4], wv[4];
#pragma unroll
        for (int i = 0; i < 11; ++i) { const int tr = c * CH + w8 - 3 + i; const bf16* ur = U + (size_t)(b * SEQ + (tr >= 0 ? tr : 0)) * NU + C_DQKV + h * 128;
            uq[i] = *(const GAS unsigned*)(ur + 2 * C.lane); uk[i] = *(const GAS unsigned*)(ur + 512 + 2 * C.lane); uv[i] = *(const GAS unsigned*)(ur + 1024 + 2 * C.lane); }
#pragma unroll
        for (int tap = 0; tap < 4; ++tap) { const float* w = C.in[I_WGC] + ((size_t)l * 4 + tap) * 1536 + h * 128;
            wq[tap] = *(const GAS f32x2*)(w + 2 * C.lane); wk[tap] = *(const GAS f32x2*)(w + 512 + 2 * C.lane); wv[tap] = *(const GAS f32x2*)(w + 1024 + 2 * C.lane); }
        { const bf16* ur = U + (size_t)(t0 + t) * NU + C_DG + h * 128 + d0; dg0 = *(const GAS v4u*)ur; dg1 = *(const GAS v4u*)(ur + 8); }
        __builtin_amdgcn_sched_barrier(0);
        LBAR();
#pragma unroll
        for (int i = 0; i < 3; ++i) if (c * CH + w8 - 3 + i < 0) { uq[i] = 0u; uk[i] = 0u; uv[i] = 0u; }
        float r[16];
#pragma unroll
        for (int i = 0; i < 8; ++i) { float a0 = 0.f, a1 = 0.f, b0 = 0.f, b1 = 0.f, c0 = 0.f, c1 = 0.f;
#pragma unroll
            for (int tap = 0; tap < 4; ++tap) { a0 += blo(uq[i + tap]) * wq[tap][0]; a1 += bhi(uq[i + tap]) * wq[tap][1]; b0 += blo(uk[i + tap]) * wk[tap][0]; b1 += bhi(uk[i + tap]) * wk[tap][1];
                c0 += blo(uv[i + tap]) * wv[tap][0]; c1 += bhi(uv[i + tap]) * wv[tap][1]; }
            q0[i] = silu_f(a0); q1[i] = silu_f(a1); k0[i] = silu_f(b0); k1[i] = silu_f(b1); v0[i] = silu_f(c0); v1[i] = silu_f(c1);
            r[i] = q0[i] * q0[i] + q1[i] * q1[i]; r[8 + i] = k0[i] * k0[i] + k1[i] * k1[i]; }
#define GDN_HALVE(SH, N) do { const bool hi_ = (C.lane & (SH)) != 0; _Pragma("unroll") for (int j = 0; j < (N) / 2; ++j) { const float send_ = hi_ ? r[j] : r[j + (N) / 2]; const float keep_ = hi_ ? r[j + (N) / 2] : r[j]; r[j] = keep_ + SWZ_XOR(send_, SH); } } while (0)
        GDN_HALVE(16, 16); GDN_HALVE(8, 8); GDN_HALVE(4, 4); GDN_HALVE(2, 2);
#undef GDN_HALVE
        r[0] += SWZ_XOR(r[0], 1);
#pragma unroll
        for (int i = 0; i < 8; ++i) {
            const float sq = __int_as_float(__builtin_amdgcn_readlane(__float_as_int(r[0]), 2 * i)) + __int_as_float(__builtin_amdgcn_readlane(__float_as_int(r[0]), 2 * i + 32));
            const float sk = __int_as_float(__builtin_amdgcn_readlane(__float_as_int(r[0]), 2 * (8 + i))) + __int_as_float(__builtin_amdgcn_readlane(__float_as_int(r[0]), 2 * (8 + i) + 32));
            const float iq = rsqrtf(sq + EPS) * 0.08838834764831845f, ik = rsqrtf(sk + EPS);
            q0[i] *= iq; q1[i] *= iq; k0[i] *= ik; k1[i] *= ik; } }
    if (C.tid < 64) { const int tt = C.tid; const float A = __expf(C.in[I_GALOG][l * 4 + h]);
        const float g = -A * softplus_f(dar + C.in[I_GDTB][l * 4 + h]); const float cs = wave_incl_scan(sG + 192, g, tt);
        sG[tt] = g; sCum[tt] = cs; sBe[tt] = sigmoid_f(dbr); }
#pragma unroll
    for (int i = 0; i < 8; ++i) { *(LAS unsigned*)(sK + (w8 + i) * LDK + 2 * C.lane) = pkbf(k0[i], k1[i]); *(LAS unsigned*)(sQ + (w8 + i) * LDK + 2 * C.lane) = pkbf(q0[i], q1[i]); }
    LBAR();
    {
        const f32x4 cA = *(const LAS f32x4*)(sCum + w8), cB = *(const LAS f32x4*)(sCum + w8 + 4), bA = *(const LAS f32x4*)(sBe + w8), bB = *(const LAS f32x4*)(sBe + w8 + 4); const float cl = sCum[63];
        float eq[8], ekl[8], bt[8], ekb[8];
#pragma unroll
        for (int i = 0; i < 8; ++i) { const float ct = i < 4 ? cA[i & 3] : cB[i & 3]; bt[i] = i < 4 ? bA[i & 3] : bB[i & 3]; eq[i] = __expf(ct); ekl[i] = __expf(cl - ct); ekb[i] = bt[i] * eq[i]; }
#pragma unroll
        for (int i = 0; i < 8; ++i) *(GAS unsigned*)(gQe + (w8 + i) * 128 + swap23(2 * C.lane)) = pkbf(q0[i] * eq[i], q1[i] * eq[i]);
        const int tb = 16 * (C.wave >> 1) + 4 * (C.wave & 1);
        { v2u a; a.x = pkbf(k0[0] * ekl[0], k0[1] * ekl[1]); a.y = pkbf(k0[2] * ekl[2], k0[3] * ekl[3]); *(LAS v2u*)(oKeT + (2 * C.lane) * LDC + tb) = a;
          a.x = pkbf(k0[4] * ekl[4], k0[5] * ekl[5]); a.y = pkbf(k0[6] * ekl[6], k0[7] * ekl[7]); *(LAS v2u*)(oKeT + (2 * C.lane) * LDC + tb + 8) = a;
          a.x = pkbf(k1[0] * ekl[0], k1[1] * ekl[1]); a.y = pkbf(k1[2] * ekl[2], k1[3] * ekl[3]); *(LAS v2u*)(oKeT + (2 * C.lane + 1) * LDC + tb) = a;
          a.x = pkbf(k1[4] * ekl[4], k1[5] * ekl[5]); a.y = pkbf(k1[6] * ekl[6], k1[7] * ekl[7]); *(LAS v2u*)(oKeT + (2 * C.lane + 1) * LDC + tb + 8) = a; }
        { v4u o; o.x = pkbf(v0[0] * bt[0], v0[1] * bt[1]); o.y = pkbf(v0[2] * bt[2], v0[3] * bt[3]); o.z = pkbf(v0[4] * bt[4], v0[5] * bt[5]); o.w = pkbf(v0[6] * bt[6], v0[7] * bt[7]); *(LAS v4u*)(sVT + (2 * C.lane) * LDC + w8) = o;
          o.x = pkbf(v1[0] * bt[0], v1[1] * bt[1]); o.y = pkbf(v1[2] * bt[2], v1[3] * bt[3]); o.z = pkbf(v1[4] * bt[4], v1[5] * bt[5]); o.w = pkbf(v1[6] * bt[6], v1[7] * bt[7]); *(LAS v4u*)(sVT + (2 * C.lane + 1) * LDC + w8) = o;
          o.x = pkbf(k0[0] * ekb[0], k0[1] * ekb[1]); o.y = pkbf(k0[2] * ekb[2], k0[3] * ekb[3]); o.z = pkbf(k0[4] * ekb[4], k0[5] * ekb[5]); o.w = pkbf(k0[6] * ekb[6], k0[7] * ekb[7]); *(LAS v4u*)(sKT + (2 * C.lane) * LDC + w8) = o;
          o.x = pkbf(k1[0] * ekb[0], k1[1] * ekb[1]); o.y = pkbf(k1[2] * ekb[2], k1[3] * ekb[3]); o.z = pkbf(k1[4] * ekb[4], k1[5] * ekb[5]); o.w = pkbf(k1[6] * ekb[6], k1[7] * ekb[7]); *(LAS v4u*)(sKT + (2 * C.lane + 1) * LDC + w8) = o; }
        const float* gn = C.in[I_GGDNN] + l * 128; const v4u a = dg0, bq = dg1; float gg[16];
#pragma unroll
        for (int i = 0; i < 4; ++i) { gg[2 * i] = gn[d0 + 2 * i] * silu_f(blo(a[i])); gg[2 * i + 1] = gn[d0 + 2 * i + 1] * silu_f(bhi(a[i])); gg[8 + 2 * i] = gn[d0 + 8 + 2 * i] * silu_f(blo(bq[i])); gg[8 + 2 * i + 1] = gn[d0 + 8 + 2 * i + 1] * silu_f(bhi(bq[i])); }
        v4u y0, y1; y0.x = pkbf(gg[0], gg[1]); y0.y = pkbf(gg[2], gg[3]); y0.z = pkbf(gg[4], gg[5]); y0.w = pkbf(gg[6], gg[7]); y1.x = pkbf(gg[8], gg[9]); y1.y = pkbf(gg[10], gg[11]); y1.z = pkbf(gg[12], gg[13]); y1.w = pkbf(gg[14], gg[15]);
        bf16* yr = YS2 + (size_t)(t0 + t) * 512 + h * 128 + d0; *(GAS v4u*)yr = y0; *(GAS v4u*)(yr + 8) = y1; }
    {
        const int which = C.wave >> 2, tt = C.wave & 1, st = (C.wave >> 1) & 1, r = C.lane & 31, hl = C.lane >> 5; f32x16 acc = zero16();
        if (st <= tt) { const LAS bf16* Am = which ? sQ : sK;
#pragma unroll
            for (int ks = 0; ks < 8; ++ks) { const bf16x8 a = *(const LAS bf16x8*)(Am + (32 * tt + r) * LDK + 16 * ks + 8 * hl), bb = *(const LAS bf16x8*)(sK + (32 * st + r) * LDK + 16 * ks + 8 * hl); acc = MFMA32(a, bb, acc); } }
        const int s = 32 * st + r; const float cs = sCum[s], bs = sBe[s];
#pragma unroll
        for (int i = 0; i < 16; ++i) { const int tr = 32 * tt + crow(i, hl); const float e = __expf(sCum[tr] - cs);
            if (which == 0) sA[tr * 64 + s] = (s < tr) ? acc[i] * e * bs * sBe[tr] : 0.f;
            else oAqk[tr * LDC + swap23(s)] = f2b((s <= tr) ? acc[i] * e : 0.f); } }
    if (C.tid == 0) ((float*)(C.ws + WS_SMALL + SM_GDEC))[(b * NCH + c) * 4 + h] = __expf(sCum[63]);
    LBAR();
    f32x16 Pm = zero16();
    if (C.wave < 2) {
        float x[32]; f32x4 ra[8], rb[8]; const int off = 32 * C.wave, r = C.lane & 31, hl = C.lane >> 5;
        InvRowH<0>::run(x, ra, rb, sA + off * 64 + off, sX + off * LDC + C.lane, r, hl == C.wave);
        if (C.wave == 0) {
#pragma unroll
            for (int s = 0; s < 2; ++s) { const f32x4 al = *(const LAS f32x4*)(sA + (32 + r) * 64 + 16 * s + 8 * hl), ah = *(const LAS f32x4*)(sA + (32 + r) * 64 + 16 * s + 8 * hl + 4);
                v4u av, bv; av.x = pkbf(al[0], al[1]); av.y = pkbf(al[2], al[3]); av.z = pkbf(ah[0], ah[1]); av.w = pkbf(ah[2], ah[3]);
                bv.x = hl ? pkbf(x[16 * s + 8], x[16 * s + 9]) : pkbf(x[16 * s], x[16 * s + 1]); bv.y = hl ? pkbf(x[16 * s + 10], x[16 * s + 11]) : pkbf(x[16 * s + 2], x[16 * s + 3]);
                bv.z = hl ? pkbf(x[16 * s + 12], x[16 * s + 13]) : pkbf(x[16 * s + 4], x[16 * s + 5]); bv.w = hl ? pkbf(x[16 * s + 14], x[16 * s + 15]) : pkbf(x[16 * s + 6], x[16 * s + 7]);
                Pm = MFMA32(__builtin_bit_cast(bf16x8, av), __builtin_bit_cast(bf16x8, bv), Pm); } } }
    LBAR();
    if (C.wave == 0) {
        const int r = C.lane & 31, hl = C.lane >> 5; f32x16 R = zero16();
#pragma unroll
        for (int s = 0; s < 2; ++s) { const v2u a0 = *(const LAS v2u*)(sX + (32 + r) * LDC + 32 + 16 * s + 4 * hl), a1 = *(const LAS v2u*)(sX + (32 + r) * LDC + 32 + 16 * s + 8 + 4 * hl);
            v4u av, bv; av.x = a0.x; av.y = a0.y; av.z = a1.x; av.w = a1.y;
            bv.x = pkbf(Pm[8 * s], Pm[8 * s + 1]); bv.y = pkbf(Pm[8 * s + 2], Pm[8 * s + 3]); bv.z = pkbf(Pm[8 * s + 4], Pm[8 * s + 5]); bv.w = pkbf(Pm[8 * s + 6], Pm[8 * s + 7]);
            R = MFMA32(__builtin_bit_cast(bf16x8, av), __builtin_bit_cast(bf16x8, bv), R); }
#pragma unroll
        for (int i = 0; i < 16; ++i) sX[(32 + crow(i, hl)) * LDC + r] = f2b(-R[i]); }
    LBAR();
    {
        const int which = C.wave >> 2, nt = C.wave & 3, r = C.lane & 31, hl = C.lane >> 5; const LAS bf16* Bm = which ? sKT : sVT; f32x16 acc[2] = {zero16(), zero16()};
#pragma unroll
        for (int ks = 0; ks < 4; ++ks) { const bf16x8 bb = *(const LAS bf16x8*)(Bm + (32 * nt + r) * LDC + 16 * ks + 8 * hl);
#pragma unroll
            for (int tt = 0; tt < 2; ++tt) { const bf16x8 a = *(const LAS bf16x8*)(sX + (32 * tt + r) * LDC + 16 * ks + 8 * hl); acc[tt] = MFMA32(a, bb, acc[tt]); } }
        const int n = 32 * nt + r;
        if (which == 0) {
#pragma unroll
            for (int tt = 0; tt < 2; ++tt) { v4u w0, w1; w0.x = pkbf(acc[tt][0], acc[tt][1]); w0.y = pkbf(acc[tt][2], acc[tt][3]); w0.z = pkbf(acc[tt][4], acc[tt][5]); w0.w = pkbf(acc[tt][6], acc[tt][7]);
                w1.x = pkbf(acc[tt][8], acc[tt][9]); w1.y = pkbf(acc[tt][10], acc[tt][11]); w1.z = pkbf(acc[tt][12], acc[tt][13]); w1.w = pkbf(acc[tt][14], acc[tt][15]);
                bf16* p = gUT + n * 64 + hl * 32 + tt * 16; *(GAS v4u*)p = w0; *(GAS v4u*)(p + 8) = w1; } }
        else { const int np = swap23(n);
#pragma unroll
            for (int tt = 0; tt < 2; ++tt)
#pragma unroll
                for (int i = 0; i < 16; ++i) oW[(32 * tt + crow(i, hl)) * LDK + np] = f2b(acc[tt][i]); } }
    LBAR();
#pragma unroll
    for (int it = 0; it < 5; ++it) { const int idx = it * NTHR + C.tid;
        if (it < 2) *(GAS v4u*)(gKeT + idx * 8) = *(const LAS v4u*)(oKeT + (idx >> 3) * LDC + (idx & 7) * 8);
        else if (it < 4) { const int q = idx - 1024; *(GAS v4u*)(gW + q * 8) = *(const LAS v4u*)(oW + (q >> 4) * LDK + (q & 15) * 8); }
        else { const int q = idx - 2048; *(GAS v4u*)(gAqk + q * 8) = *(const LAS v4u*)(oAqk + (q >> 3) * LDC + (q & 7) * 8); } }
}
__device__ __forceinline__ void m1_ssd(const Ctx& C_, int l, int b, int c, int g) {
    Ctx C = C_; asm volatile("v_mbcnt_lo_u32_b32 %0, -1, 0\n\tv_mbcnt_hi_u32_b32 %0, -1, %0" : "=v"(C.lane)); C.tid = C.wave * 64 + C.lane;
    LAS unsigned char* lds = lds_v(C);
    LAS bf16* sC = (LAS bf16*)lds; LAS bf16* sB = sC + 64 * LDK;
    LAS float* sCB = (LAS float*)(lds + 34816);
    LAS float* sDt = (LAS float*)(lds + 51200); LAS float* sCu = sDt + 256; LAS float* sWv = sCu + 256;
    LAS bf16* oXT = (LAS bf16*)(lds + 54272); LAS bf16* oBW = (LAS bf16*)(lds + 91136);
    const bf16* U = (const bf16*)(C.ws + WS_U); bf16* YS1 = (bf16*)(C.ws + WS_YS) + (size_t)T_ALL * 512;
    unsigned char* scr = C.ws + SCR_SSD + (size_t)((b * NCH + c) * 2 + g) * SSD_UNIT;
    bf16* gC = (bf16*)scr;
    const int t0 = b * SEQ + c * CH, t = C.tid >> 3, cg = C.tid & 7, d0 = cg * 16, w8 = C.wave * 8;
    unsigned ua[11], ub[11]; f32x2 wa[5], wbq[5]; float x0[8], x1[8]; float dtraw = 0.f; v4u zr4[4];
#define SSD_CHB(P) ((P) < 2 ? g * 256 + (P) * 128 : ((P) == 2 ? 512 + g * 128 : 768 + g * 128))
#define SSD_LD(uu, wq, P) do { \
        _Pragma("unroll") for (int i = 0; i < 11; ++i) { const int tr = c * CH + w8 - 3 + i; const bf16* ur = U + (size_t)(b * SEQ + (tr >= 0 ? tr : 0)) * NU + C_SXBC + SSD_CHB(P); uu[i] = *(const GAS unsigned*)(ur + 2 * C.lane); } \
        _Pragma("unroll") for (int tap = 0; tap < 4; ++tap) wq[tap] = *(const GAS f32x2*)(C.in[I_WSC] + ((size_t)l * 4 + tap) * 1024 + SSD_CHB(P) + 2 * C.lane); \
        wq[4] = *(const GAS f32x2*)(C.in[I_BSC] + l * 1024 + SSD_CHB(P) + 2 * C.lane); } while (0)
    if (C.tid < 256) dtraw = bf2f(U[(size_t)(t0 + (C.tid & 63)) * NU + C_SDT + g * 4 + (C.tid >> 6)]);
    SSD_LD(ua, wa, 0); SSD_LD(ub, wbq, 1);
    { const bf16* zr = U + (size_t)(t0 + t) * NU + C_SZ + g * 256 + cg * 32;
#pragma unroll
      for (int q = 0; q < 4; ++q) zr4[q] = *(const GAS v4u*)(zr + 8 * q); }
    __builtin_amdgcn_sched_barrier(0);
    LBAR();
    if (C.tid < 256) { const int hh = C.tid >> 6, tt = C.tid & 63, hd = g * 4 + hh; const float A = -__expf(C.in[I_SALOG][l * 8 + hd]);
        const float dt = softplus_f(dtraw + C.in[I_SDTB][l * 8 + hd]); const float cs = wave_incl_scan(sCu + 256 + hh * 64, dt * A, tt);
        const float c63 = __int_as_float(__builtin_amdgcn_readlane(__float_as_int(cs), 63));
        sDt[hh * 64 + tt] = dt; sCu[hh * 64 + tt] = cs; sWv[hh * 64 + tt] = __expf(c63 - cs) * dt;
        ((float*)(C.ws + WS_SMALL + SM_ECUM))[(size_t)((b * NCH + c) * 8 + hd) * 64 + tt] = __expf(cs);
        if (tt == 63) ((float*)(C.ws + WS_SMALL + SM_ELAST))[(b * NCH + c) * 8 + hd] = __expf(cs); }
    LBAR();
    {
#define SSD_CONV(uu, wq) do { \
        _Pragma("unroll") for (int i = 0; i < 3; ++i) if (c * CH + w8 - 3 + i < 0) uu[i] = 0u;        \
        _Pragma("unroll") for (int i = 0; i < 8; ++i) { float a0 = wq[4][0], a1 = wq[4][1]; \
            _Pragma("unroll") for (int tap = 0; tap < 4; ++tap) { a0 += blo(uu[i + tap]) * wq[tap][0]; a1 += bhi(uu[i + tap]) * wq[tap][1]; } \
            x0[i] = silu_f(a0); x1[i] = silu_f(a1); } } while (0)
        SSD_CONV(ua, wa);
        { const int hh = C.lane >> 5, p = (2 * C.lane) & 63; v4u o0, o1; o0.x = pkbf(x0[0], x0[1]); o0.y = pkbf(x0[2], x0[3]); o0.z = pkbf(x0[4], x0[5]); o0.w = pkbf(x0[6], x0[7]); o1.x = pkbf(x1[0], x1[1]); o1.y = pkbf(x1[2], x1[3]); o1.z = pkbf(x1[4], x1[5]); o1.w = pkbf(x1[6], x1[7]);
          *(LAS v4u*)(oXT + (hh * 64 + p) * LDC + w8) = o0; *(LAS v4u*)(oXT + (hh * 64 + p + 1) * LDC + w8) = o1; }
        __builtin_amdgcn_sched_barrier(0);
        SSD_LD(ua, wa, 2); __builtin_amdgcn_sched_barrier(0);
        SSD_CONV(ub, wbq);
        { const int hh = 2 + (C.lane >> 5), p = (2 * C.lane) & 63; v4u o0, o1; o0.x = pkbf(x0[0], x0[1]); o0.y = pkbf(x0[2], x0[3]); o0.z = pkbf(x0[4], x0[5]); o0.w = pkbf(x0[6], x0[7]); o1.x = pkbf(x1[0], x1[1]); o1.y = pkbf(x1[2], x1[3]); o1.z = pkbf(x1[4], x1[5]); o1.w = pkbf(x1[6], x1[7]);
          *(LAS v4u*)(oXT + (hh * 64 + p) * LDC + w8) = o0; *(LAS v4u*)(oXT + (hh * 64 + p + 1) * LDC + w8) = o1; }
        __builtin_amdgcn_sched_barrier(0);
        SSD_LD(ub, wbq, 3); __builtin_amdgcn_sched_barrier(0);
        SSD_CONV(ua, wa);
#pragma unroll
        for (int i = 0; i < 8; ++i) *(LAS unsigned*)(sB + (w8 + i) * LDK + 2 * C.lane) = pkbf(x0[i], x1[i]);
#pragma unroll 1
        for (int rnd = 0; rnd < 2; ++rnd) {
#pragma unroll
            for (int h2 = 0; h2 < 2; ++h2) { const int hh = 2 * rnd + h2; const f32x4 wl = *(const LAS f32x4*)(sWv + hh * 64 + w8), wh = *(const LAS f32x4*)(sWv + hh * 64 + w8 + 4); v4u o0, o1;
                o0.x = pkbf(x0[0] * wl[0], x0[1] * wl[1]); o0.y = pkbf(x0[2] * wl[2], x0[3] * wl[3]); o0.z = pkbf(x0[4] * wh[0], x0[5] * wh[1]); o0.w = pkbf(x0[6] * wh[2], x0[7] * wh[3]);
                o1.x = pkbf(x1[0] * wl[0], x1[1] * wl[1]); o1.y = pkbf(x1[2] * wl[2], x1[3] * wl[3]); o1.z = pkbf(x1[4] * wh[0], x1[5] * wh[1]); o1.w = pkbf(x1[6] * wh[2], x1[7] * wh[3]);
                *(LAS v4u*)(oBW + (h2 * 128 + 2 * C.lane) * LDC + w8) = o0; *(LAS v4u*)(oBW + (h2 * 128 + 2 * C.lane + 1) * LDC + w8) = o1; }
            LBAR();
#pragma unroll
            for (int it = 0; it < 4; ++it) { const int idx = it * NTHR + C.tid, h2 = idx >> 10, q = idx & 1023;
                *(GAS v4u*)((bf16*)(scr + 16384 + (size_t)(2 * rnd + h2) * 32768 + 8192) + q * 8) = *(const LAS v4u*)(oBW + (h2 * 128 + (q >> 3)) * LDC + (q & 7) * 8); }
            LBAR(); }
        SSD_CONV(ub, wbq);
#pragma unroll
        for (int i = 0; i < 8; ++i) { const unsigned pv = pkbf(x0[i], x1[i]); *(LAS unsigned*)(sC + (w8 + i) * LDK + 2 * C.lane) = pv; *(GAS unsigned*)(gC + (w8 + i) * 128 + swap23(2 * C.lane)) = pv; }
#undef SSD_CHB
#undef SSD_LD
#undef SSD_CONV
    }
    {
        bf16* yr = YS1 + (size_t)(t0 + t) * 512 + g * 256 + cg * 32;
#pragma unroll
        for (int q = 0; q < 4; ++q) { const v4u a = zr4[q]; v4u o;
#pragma unroll
            for (int i = 0; i < 4; ++i) o[i] = pkbf(silu_f(blo(a[i])), silu_f(bhi(a[i])));
            *(GAS v4u*)(yr + 8 * q) = o; } }
    LBAR();
    if (C.wave < 4) { const int tt = C.wave & 1, st = C.wave >> 1, r = C.lane & 31, hl = C.lane >> 5; f32x16 acc = zero16();
        if (st <= tt) {
#pragma unroll
            for (int ks = 0; ks < 8; ++ks) { const bf16x8 a = *(const LAS bf16x8*)(sC + (32 * tt + r) * LDK + 16 * ks + 8 * hl), bb = *(const LAS bf16x8*)(sB + (32 * st + r) * LDK + 16 * ks + 8 * hl); acc = MFMA32(a, bb, acc); } }
#pragma unroll
        for (int i = 0; i < 16; ++i) sCB[(32 * tt + crow(i, hl)) * 64 + 32 * st + r] = acc[i]; }
    LBAR();
    { const int s0 = cg * 8; f32x4 cb[2], cu[4][2], dq[4][2]; float ctv[4], Dv[4];
      cb[0] = *(const LAS f32x4*)(sCB + t * 64 + s0); cb[1] = *(const LAS f32x4*)(sCB + t * 64 + s0 + 4);
#pragma unroll
      for (int hh = 0; hh < 4; ++hh) { cu[hh][0] = *(const LAS f32x4*)(sCu + hh * 64 + s0); cu[hh][1] = *(const LAS f32x4*)(sCu + hh * 64 + s0 + 4); dq[hh][0] = *(const LAS f32x4*)(sDt + hh * 64 + s0); dq[hh][1] = *(const LAS f32x4*)(sDt + hh * 64 + s0 + 4);
          ctv[hh] = sCu[hh * 64 + t]; Dv[hh] = C.in[I_SD][l * 8 + g * 4 + hh]; }
#pragma unroll
      for (int hh = 0; hh < 4; ++hh) { float m[8];
#pragma unroll
          for (int j = 0; j < 8; ++j) { const int s = s0 + j; m[j] = (s <= t) ? cb[j >> 2][j & 3] * __expf(ctv[hh] - cu[hh][j >> 2][j & 3]) * dq[hh][j >> 2][j & 3] + (s == t ? Dv[hh] : 0.f) : 0.f; }
          v4u o; o.x = pkbf(m[0], m[1]); o.y = pkbf(m[2], m[3]); o.z = pkbf(m[4], m[5]); o.w = pkbf(m[6], m[7]);
          *(GAS v4u*)((bf16*)(scr + 16384 + (size_t)hh * 32768) + t * 64 + s0) = o; } }
#pragma unroll
    for (int it = 0; it < 4; ++it) { const int idx = it * NTHR + C.tid, hh = idx >> 9, q = idx & 511;
        *(GAS v4u*)((bf16*)(scr + 16384 + (size_t)hh * 32768 + 24576) + q * 8) = *(const LAS v4u*)(oXT + (hh * 64 + (q >> 3)) * LDC + (q & 7) * 8); }
}
#define HR_STAGE(SH, N) _Pragma("unroll") for (int idx = 0; idx < (N) / 2; ++idx) { const float keep = up##SH ? v[idx + (N) / 2] : v[idx], send = up##SH ? v[idx] : v[idx + (N) / 2]; v[idx] = keep + __int_as_float(__builtin_amdgcn_ds_swizzle(__float_as_int(send), 0x1f | ((SH) << 10))); }
__device__ __forceinline__ float half_reduce32(float (&v)[32], int lane) {
    const bool up16 = lane & 16, up8 = lane & 8, up4 = lane & 4, up2 = lane & 2, up1 = lane & 1;
    HR_STAGE(16, 32) HR_STAGE(8, 16) HR_STAGE(4, 8) HR_STAGE(2, 4) HR_STAGE(1, 2)
    return v[0];
}
__device__ __forceinline__ void rows_rstd_a(LAS float* xch, int par, int wave, int lane, float (&v)[32]) {
    const float tot = half_reduce32(v, lane);
    xch[par * 512 + wave * 64 + lane] = tot;
}
template <int NWG, int NCOLS> __device__ __forceinline__ void rows_rstd_b(LAS float* xch, int par, int wave, int lane, float (&rs)[32]) {
    const int slot = lane;
    LAS float* part = xch + par * 512;
    LBAR();
    const int w0 = (wave / NWG) * NWG; float s = 0.f;
#pragma unroll
    for (int j = 0; j < NWG; ++j) s += part[(w0 + j) * 64 + slot];
    LAS float* bc = xch + 1024 + wave * 64;
    bc[slot] = rsqrtf(s * (1.f / NCOLS) + EPS);
    asm volatile("s_waitcnt lgkmcnt(0)" ::: "memory");
#pragma unroll
    for (int q = 0; q < 8; ++q) { const f32x4 x = *(const LAS f32x4*)(bc + (lane & 32) + 4 * q); rs[4 * q] = x[0]; rs[4 * q + 1] = x[1]; rs[4 * q + 2] = x[2]; rs[4 * q + 3] = x[3]; }
}
__device__ __forceinline__ void scale_rows4(f32x16& a, const float* vec32, int hl) {
#pragma unroll
    for (int q = 0; q < 4; ++q) { const f32x4 d = *(const GAS f32x4*)(vec32 + 8 * q + 4 * hl); a[4 * q] *= d[0]; a[4 * q + 1] *= d[1]; a[4 * q + 2] *= d[2]; a[4 * q + 3] *= d[3]; }
}
constexpr int SB_STRIDE = 63488, OB_OFF = 126976, DEC_OFF = 144384;
#define LDF(base, row, ld, col) (*(const LAS bf16x8*)((base) + (row) * (ld) + (col)))
__device__ __forceinline__ void stage_out(LAS bf16* ob, const f32x16 (&o)[2], int col, int hl) {
#pragma unroll
    for (int i = 0; i < 32; ++i) ob[(32 * (i >> 4) + crow(i & 15, hl)) * LDK + col] = f2b(o[i >> 4][i & 15]);
}
__device__ __forceinline__ void load_gates(const bf16* ys, int lt, v4u (&g)[4]) {
    const bf16* yp = ys + (size_t)(lt >> 2) * 512 + (lt & 3) * 32;
#pragma unroll
    for (int q = 0; q < 4; ++q) g[q] = *(const GAS v4u*)(yp + 8 * q);
}
__device__ __forceinline__ void finish_rows_norm(const LAS bf16* ob, bf16* ys, int lt, bool st, const v4u (&g)[4]) {
    const int t = lt >> 2, cb = (lt & 3) * 32; float x[32]; float ss = 0.f;
    bf16* yp = ys + (size_t)t * 512 + cb;
#pragma unroll
    for (int q = 0; q < 4; ++q) { const v4u w = *(const LAS v4u*)(ob + t * LDK + cb + 8 * q);
#pragma unroll
        for (int e = 0; e < 4; ++e) { x[8 * q + 2 * e] = blo(w[e]); x[8 * q + 2 * e + 1] = bhi(w[e]); } }
#pragma unroll
    for (int j = 0; j < 32; ++j) ss += x[j] * x[j];
    ss += SWZ_XOR(ss, 1); ss += SWZ_XOR(ss, 2);
    const float rstd = rsqrtf(ss * (1.f / 128.f) + EPS);
#pragma unroll
    for (int q = 0; q < 4; ++q) { v4u o;
#pragma unroll
        for (int e = 0; e < 4; ++e) o[e] = pkbf(x[8 * q + 2 * e] * rstd * blo(g[q][e]), x[8 * q + 2 * e + 1] * rstd * bhi(g[q][e]));
        if (st) *(GAS v4u*)(yp + 8 * q) = o; }
}
__device__ __forceinline__ void gla_scan(const Ctx& C_, int l, int b, int h, bool st) {
    Ctx C = C_; asm volatile("v_mbcnt_lo_u32_b32 %0, -1, 0\n\tv_mbcnt_hi_u32_b32 %0, -1, %0" : "=v"(C.lane)); C.tid = C.wave * 64 + C.lane;
    LAS unsigned char* lds = lds_v(C); LAS bf16* ob = (LAS bf16*)(lds + OB_OFF);
    const bf16* U = (const bf16*)(C.ws + WS_U); bf16* YS0 = (bf16*)(C.ws + WS_YS);
    LBAR();
    if (C.wave >= 4) {
        int lt = C.tid - 256; v4u srA[14], srB[14], dA = {0u, 0u, 0u, 0u}, dB = {0u, 0u, 0u, 0u};
        const unsigned char* ub = (const unsigned char*)(U + (size_t)(b * SEQ) * NU + h * 128);
        LAS float* dcl = (LAS float*)(lds + DEC_OFF);
#define GLA_LOAD(sr, dreg, c) do { const unsigned char* cb = ub + (size_t)(c) * CH * NU * 2; _Pragma("unroll") for (int j = 0; j < 14; ++j) { const int idx = j * 256 + lt; \
            if (j < 4) { const int ur = idx >> 4, c16 = idx & 15; sr[j] = *(const GAS v4u*)(cb + (size_t)ur * (NU * 2) + C_GQ * 2 + c16 * 16); } \
            else if (j < 6) { const int q = idx - 1024, ur = q >> 3, c16 = q & 7; sr[j] = *(const GAS v4u*)(cb + (size_t)ur * (NU * 2) + C_GR * 2 + c16 * 16); } \
            else if (j < 10) { const int q = idx - 1536, ur = q >> 4, c16 = q & 15; sr[j] = *(const GAS v4u*)(cb + (size_t)ur * (NU * 2) + C_GK * 2 + c16 * 16); } \
            else { const int q = idx - 2560, ur = q >> 4, c16 = q & 15; sr[j] = *(const GAS v4u*)(cb + (size_t)ur * (NU * 2) + C_GV * 2 + c16 * 16); } } \
            if (lt < 32) dreg = *(const GAS v4u*)(ub + (size_t)((c) * CH + (lt >> 3)) * (NU * 2) + (C_GR + 64) * 2 + (lt & 7) * 16); } while (0)
#define GLA_WRITE(sr, dreg, buf) do { LAS unsigned char* B = lds + (buf) * SB_STRIDE; _Pragma("unroll") for (int j = 0; j < 14; ++j) { const int idx = j * 256 + lt; \
            if (j < 4) { const int ur = idx >> 4, c16 = idx & 15; *(LAS v4u*)(B + ur * 272 + c16 * 16) = sr[j]; } \
            else if (j < 6) { const int q = idx - 1024, ur = q >> 3, c16 = q & 7; *(LAS v4u*)(B + 17408 + ur * 144 + c16 * 16) = sr[j]; } \
            else if (j < 10) { const int q = idx - 1536, ur = q >> 4, c16 = q & 15; *(LAS v4u*)(B + 26624 + (2 * ur + (c16 >> 3)) * 144 + (c16 & 7) * 16) = sr[j]; } \
            else { const int q = idx - 2560, ur = q >> 4, c16 = q & 15; *(LAS v4u*)(B + 45056 + (2 * ur + (c16 >> 3)) * 144 + (c16 & 7) * 16) = sr[j]; } } \
            if (lt < 32) *(LAS v4u*)(dcl + (buf) * 128 + lt * 4) = dreg; } while (0)
        GLA_LOAD(srA, dA, 0); GLA_WRITE(srA, dA, 0); GLA_LOAD(srB, dB, 1); GLA_LOAD(srA, dA, 2);
        v4u gg[4]; load_gates(YS0 + (size_t)(b * SEQ) * 512 + h * 128, lt, gg);
        LBAR();
#pragma unroll 1
        for (int c = 0; c < NCH; c += 2) { asm volatile("" : "+v"(lt));
            if (c > 0) { finish_rows_norm(ob, YS0 + (size_t)(b * SEQ + (c - 1) * CH) * 512 + h * 128, lt, st, gg); load_gates(YS0 + (size_t)(b * SEQ + c * CH) * 512 + h * 128, lt, gg); }
            GLA_WRITE(srB, dB, 1); if (c + 3 < NCH) GLA_LOAD(srB, dB, c + 3);
            LBAR(); LBAR();
            finish_rows_norm(ob, YS0 + (size_t)(b * SEQ + c * CH) * 512 + h * 128, lt, st, gg); load_gates(YS0 + (size_t)(b * SEQ + (c + 1) * CH) * 512 + h * 128, lt, gg);
            if (c + 2 < NCH) { GLA_WRITE(srA, dA, 0); if (c + 4 < NCH) GLA_LOAD(srA, dA, c + 4); }
            LBAR(); LBAR(); }
        finish_rows_norm(ob, YS0 + (size_t)(b * SEQ + (NCH - 1) * CH) * 512 + h * 128, lt, st, gg);
#undef GLA_LOAD
#undef GLA_WRITE
        return;
    }
    const int vs = C.wave & 3; int lane_ = C.lane;
    f32x16 S[4] = {zero16(), zero16(), zero16(), zero16()};
    LBAR();
#pragma unroll 1
    for (int c = 0; c < NCH; ++c) {
        asm volatile("" : "+v"(lane_)); const int r = lane_ & 31, hl = lane_ >> 5, v = 32 * vs + r;
        LAS unsigned char* B = lds + (c & 1) * SB_STRIDE;
        const LAS bf16* qdl = (const LAS bf16*)B; const LAS bf16* al = (const LAS bf16*)(B + 17408); const LAS bf16* kll = (const LAS bf16*)(B + 26624); const LAS bf16* vtl = (const LAS bf16*)(B + 45056);
        const LAS float* dcl = (const LAS float*)(lds + DEC_OFF) + (c & 1) * 128;
        f32x16 o[2] = {zero16(), zero16()};
#define SB0() __builtin_amdgcn_sched_barrier(0)
#define LDW(f, T, kt) do { f[0] = LDF(T, r, LDK, 32 * (kt) + 8 * hl); f[1] = LDF(T, r, LDK, 32 * (kt) + 16 + 8 * hl); f[2] = LDF(T, 32 + r, LDK, 32 * (kt) + 8 * hl); f[3] = LDF(T, 32 + r, LDK, 32 * (kt) + 16 + 8 * hl); } while (0)
#define MMW(f, acc) do { acc[0] = MFMA32(f[0], b0, acc[0]); acc[0] = MFMA32(f[1], b1, acc[0]); acc[1] = MFMA32(f[2], b0, acc[1]); acc[1] = MFMA32(f[3], b1, acc[1]); } while (0)
#define LDA2(f, T, ka, kb) do { f[0] = LDF(T, r, LDC, 16 * (ka) + 8 * hl); f[1] = LDF(T, 32 + r, LDC, 16 * (ka) + 8 * hl); f[2] = LDF(T, r, LDC, 16 * (kb) + 8 * hl); f[3] = LDF(T, 32 + r, LDC, 16 * (kb) + 8 * hl); } while (0)
#define MMA2(f, bq, ka, kb, acc) do { acc[0] = MFMA32(f[0], bq[ka], acc[0]); acc[1] = MFMA32(f[1], bq[ka], acc[1]); acc[0] = MFMA32(f[2], bq[kb], acc[0]); acc[1] = MFMA32(f[3], bq[kb], acc[1]); } while (0)
#define LDR4(f, T, row) do { f[0] = LDF(T, (row) + r, LDC, 8 * hl); f[1] = LDF(T, (row) + r, LDC, 16 + 8 * hl); f[2] = LDF(T, (row) + r, LDC, 32 + 8 * hl); f[3] = LDF(T, (row) + r, LDC, 48 + 8 * hl); } while (0)
#define MMR4(f, bq, acc) do { acc = MFMA32(f[0], bq[0], acc); acc = MFMA32(f[1], bq[1], acc); acc = MFMA32(f[2], bq[2], acc); acc = MFMA32(f[3], bq[3], acc); } while (0)
#define LDD(d, kt) do { _Pragma("unroll") for (int q = 0; q < 4; ++q) d[q] = *(const LAS f32x4*)(dcl + 32 * (kt) + 8 * q + 4 * hl); } while (0)
#define MULD(d, kt) do { _Pragma("unroll") for (int q = 0; q < 4; ++q) { S[kt][4 * q] *= d[q][0]; S[kt][4 * q + 1] *= d[q][1]; S[kt][4 * q + 2] *= d[q][2]; S[kt][4 * q + 3] *= d[q][3]; } } while (0)
        bf16x8 fA[4], fB[4], bv[4]; f32x4 dA[4], dB[4];
        LDW(fA, qdl, 0);
#pragma unroll
        for (int ks = 0; ks < 4; ++ks) bv[ks] = LDF(vtl, v, LDC, 16 * ks + 8 * hl);
        SB0();
        { bf16x8 b0 = pack_step<0>(S[0]), b1 = pack_step<1>(S[0]);
          LDW(fB, qdl, 1); SB0(); MMW(fA, o); SB0();
          b0 = pack_step<0>(S[1]); b1 = pack_step<1>(S[1]);
          LDW(fA, qdl, 2); SB0(); MMW(fB, o); SB0();
          b0 = pack_step<0>(S[2]); b1 = pack_step<1>(S[2]);
          LDW(fB, qdl, 3); SB0(); MMW(fA, o); SB0();
          b0 = pack_step<0>(S[3]); b1 = pack_step<1>(S[3]);
          LDA2(fA, al, 0, 1); SB0(); MMW(fB, o); SB0(); }
        LDA2(fB, al, 2, 3); SB0(); MMA2(fA, bv, 0, 1, o); SB0();
        LDR4(fA, kll, 0); LDD(dA, 0); SB0(); MMA2(fB, bv, 2, 3, o); SB0();
        LDR4(fB, kll, 32); LDD(dB, 1); SB0(); MULD(dA, 0); MMR4(fA, bv, S[0]); SB0();
        LDR4(fA, kll, 64); LDD(dA, 2); SB0(); MULD(dB, 1); MMR4(fB, bv, S[1]); SB0();
        LDR4(fB, kll, 96); LDD(dB, 3); SB0(); MULD(dA, 2); MMR4(fA, bv, S[2]); SB0();
        MULD(dB, 3); MMR4(fB, bv, S[3]); SB0();
#undef LDW
#undef MMW
#undef LDD
#undef MULD
        LBAR();
        stage_out(ob, o, v, hl);
        LBAR();
    }
    const int r = lane_ & 31, hl = lane_ >> 5, v = 32 * vs + r;
    float* so = C.out + O_PGLA + ((((size_t)l * 8 + b) * 4 + h) * 128) * 128 + v;
#pragma unroll
    for (int kt = 0; kt < 4; ++kt)
#pragma unroll
        for (int i = 0; i < 16; ++i) if (st) so[(size_t)(32 * kt + crow(i, hl)) * 128] = S[kt][i];
}
__device__ __forceinline__ void gdn_scan(const Ctx& C_, int l, int b, int h, bool st) {
    Ctx C = C_; asm volatile("v_mbcnt_lo_u32_b32 %0, -1, 0\n\tv_mbcnt_hi_u32_b32 %0, -1, %0" : "=v"(C.lane)); C.tid = C.wave * 64 + C.lane;
    LAS unsigned char* lds = lds_v(C); LAS bf16* ob = (LAS bf16*)(lds + OB_OFF);
    const unsigned char* sbase = C.ws + SCR_GDN + (size_t)((b * NCH) * 4 + h) * GDN_UNIT;
    bf16* YS2 = (bf16*)(C.ws + WS_YS) + (size_t)2 * T_ALL * 512;
    LBAR();
    if (C.wave >= 4) {
        int lt = C.tid - 256; v4u srA[14], srB[14];
#define GDN_LOAD(sr, c) do { const unsigned char* cb = sbase + (size_t)(c) * 4 * GDN_UNIT; _Pragma("unroll") for (int j = 0; j < 14; ++j) { const int idx = j * 256 + lt; \
            sr[j] = *(const GAS v4u*)(cb + (j < 12 ? idx * 16 : 65536 + (idx - 3072) * 16)); } } while (0)
#define GDN_WRITE(sr, buf) do { LAS unsigned char* B = lds + (buf) * SB_STRIDE; _Pragma("unroll") for (int j = 0; j < 14; ++j) { const int idx = j * 256 + lt; \
            if (j < 4) { *(LAS v4u*)(B + (idx >> 4) * 272 + (idx & 15) * 16) = sr[j]; } \
            else if (j < 8) { const int q = idx - 1024; *(LAS v4u*)(B + 17408 + (q >> 4) * 272 + (q & 15) * 16) = sr[j]; } \
            else if (j < 12) { const int q = idx - 2048; *(LAS v4u*)(B + 34816 + (q >> 3) * 144 + (q & 7) * 16) = sr[j]; } \
            else { const int q = idx - 3072; *(LAS v4u*)(B + 53248 + (q >> 3) * 144 + (q & 7) * 16) = sr[j]; } } } while (0)
        GDN_LOAD(srA, 0); GDN_WRITE(srA, 0); GDN_LOAD(srB, 1); GDN_LOAD(srA, 2);
        v4u gg[4]; load_gates(YS2 + (size_t)(b * SEQ) * 512 + h * 128, lt, gg);
        LBAR();
#pragma unroll 1
        for (int c = 0; c < NCH; c += 2) { asm volatile("" : "+v"(lt));
            if (c > 0) { finish_rows_norm(ob, YS2 + (size_t)(b * SEQ + (c - 1) * CH) * 512 + h * 128, lt, st, gg); load_gates(YS2 + (size_t)(b * SEQ + c * CH) * 512 + h * 128, lt, gg); }
            GDN_WRITE(srB, 1); if (c + 3 < NCH) GDN_LOAD(srB, c + 3);
            LBAR(); LBAR();
            finish_rows_norm(ob, YS2 + (size_t)(b * SEQ + c * CH) * 512 + h * 128, lt, st, gg); load_gates(YS2 + (size_t)(b * SEQ + (c + 1) * CH) * 512 + h * 128, lt, gg);
            if (c + 2 < NCH) { GDN_WRITE(srA, 0); if (c + 4 < NCH) GDN_LOAD(srA, c + 4); }
            LBAR(); LBAR(); }
        finish_rows_norm(ob, YS2 + (size_t)(b * SEQ + (NCH - 1) * CH) * 512 + h * 128, lt, st, gg);
#undef GDN_LOAD
#undef GDN_WRITE
        return;
    }
    const int vs = C.wave & 3; int lane_ = C.lane;
    f32x16 S[4] = {zero16(), zero16(), zero16(), zero16()};
    const float* gdec = (const float*)(C.ws + WS_SMALL + SM_GDEC) + (b * NCH) * 4 + h; float decn = gdec[0];
    v4u un0, un1, un2, un3; { const bf16* up = (const bf16*)(sbase + 49152) + (32 * vs + (lane_ & 31)) * 64 + (lane_ >> 5) * 32; un0 = *(const GAS v4u*)up; un1 = *(const GAS v4u*)(up + 8); un2 = *(const GAS v4u*)(up + 16); un3 = *(const GAS v4u*)(up + 24); }
    LBAR();
#pragma unroll 1
    for (int c = 0; c < NCH; ++c) {
        asm volatile("" : "+v"(lane_)); const int r = lane_ & 31, hl = lane_ >> 5, v = 32 * vs + r;
        LAS unsigned char* B = lds + (c & 1) * SB_STRIDE;
        const LAS bf16* wl = (const LAS bf16*)B; const LAS bf16* qel = (const LAS bf16*)(B + 17408); const LAS bf16* ketl = (const LAS bf16*)(B + 34816); const LAS bf16* aqkl = (const LAS bf16*)(B + 53248);
        const int cn = c + 1 < NCH ? c + 1 : c; const bf16* gUT = (const bf16*)(sbase + (size_t)cn * 4 * GDN_UNIT + 49152);
        const float dec = decn; decn = gdec[cn * 4];
        f32x16 ws[2] = {zero16(), zero16()}, qs[2] = {zero16(), zero16()};
        const v4u u0 = un0, u1 = un1, u2 = un2, u3 = un3;
        un0 = *(const GAS v4u*)(gUT + v * 64 + hl * 32); un1 = *(const GAS v4u*)(gUT + v * 64 + hl * 32 + 8); un2 = *(const GAS v4u*)(gUT + v * 64 + hl * 32 + 16); un3 = *(const GAS v4u*)(gUT + v * 64 + hl * 32 + 24);
#define LDW(f, T, kt) do { f[0] = LDF(T, r, LDK, 32 * (kt) + 8 * hl); f[1] = LDF(T, r, LDK, 32 * (kt) + 16 + 8 * hl); f[2] = LDF(T, 32 + r, LDK, 32 * (kt) + 8 * hl); f[3] = LDF(T, 32 + r, LDK, 32 * (kt) + 16 + 8 * hl); } while (0)
#define MMW(f, acc) do { acc[0] = MFMA32(f[0], b0, acc[0]); acc[0] = MFMA32(f[1], b1, acc[0]); acc[1] = MFMA32(f[2], b0, acc[1]); acc[1] = MFMA32(f[3], b1, acc[1]); } while (0)
#define LDK2(f, ka, kb, ts) do { f[0] = LDF(ketl, 32 * (ka) + r, LDC, 32 * (ts) + 8 * hl); f[1] = LDF(ketl, 32 * (ka) + r, LDC, 32 * (ts) + 16 + 8 * hl); f[2] = LDF(ketl, 32 * (kb) + r, LDC, 32 * (ts) + 8 * hl); f[3] = LDF(ketl, 32 * (kb) + r, LDC, 32 * (ts) + 16 + 8 * hl); } while (0)
#define MMK2(f, ka, kb) do { S[ka] = MFMA32(f[0], n0, S[ka]); S[ka] = MFMA32(f[1], n1, S[ka]); S[kb] = MFMA32(f[2], n0, S[kb]); S[kb] = MFMA32(f[3], n1, S[kb]); } while (0)
        bf16x8 fA[4], fB[4];
        LDW(fA, wl, 0); SB0();
        { bf16x8 b0 = pack_step<0>(S[0]), b1 = pack_step<1>(S[0]);
          LDW(fB, qel, 0); SB0(); MMW(fA, ws); SB0(); LDW(fA, wl, 1); SB0(); MMW(fB, qs); SB0();
          b0 = pack_step<0>(S[1]); b1 = pack_step<1>(S[1]);
          LDW(fB, qel, 1); SB0(); MMW(fA, ws); SB0(); LDW(fA, wl, 2); SB0(); MMW(fB, qs); SB0();
          b0 = pack_step<0>(S[2]); b1 = pack_step<1>(S[2]);
          LDW(fB, qel, 2); SB0(); MMW(fA, ws); SB0(); LDW(fA, wl, 3); SB0(); MMW(fB, qs); SB0();
          b0 = pack_step<0>(S[3]); b1 = pack_step<1>(S[3]);
          LDW(fB, qel, 3); SB0(); MMW(fA, ws); SB0();
          fA[0] = LDF(aqkl, r, LDC, 8 * hl); fA[1] = LDF(aqkl, r, LDC, 16 + 8 * hl); fA[2] = LDF(aqkl, 32 + r, LDC, 8 * hl); fA[3] = LDF(aqkl, 32 + r, LDC, 16 + 8 * hl); SB0();
          MMW(fB, qs); SB0(); }
        f32x16 vn[2];
#pragma unroll
        for (int i = 0; i < 4; ++i) { vn[0][2 * i] = blo(u0[i]) - ws[0][2 * i]; vn[0][2 * i + 1] = bhi(u0[i]) - ws[0][2 * i + 1]; vn[0][8 + 2 * i] = blo(u1[i]) - ws[0][8 + 2 * i]; vn[0][8 + 2 * i + 1] = bhi(u1[i]) - ws[0][8 + 2 * i + 1];
            vn[1][2 * i] = blo(u2[i]) - ws[1][2 * i]; vn[1][2 * i + 1] = bhi(u2[i]) - ws[1][2 * i + 1]; vn[1][8 + 2 * i] = blo(u3[i]) - ws[1][8 + 2 * i]; vn[1][8 + 2 * i + 1] = bhi(u3[i]) - ws[1][8 + 2 * i + 1]; }
#pragma unroll
        for (int kt = 0; kt < 4; ++kt) S[kt] = S[kt] * dec;
        SB0();
        { bf16x8 n0 = pack_step<0>(vn[0]), n1 = pack_step<1>(vn[0]);
          LDK2(fB, 0, 1, 0); SB0(); qs[0] = MFMA32(fA[0], n0, qs[0]); qs[0] = MFMA32(fA[1], n1, qs[0]); qs[1] = MFMA32(fA[2], n0, qs[1]); qs[1] = MFMA32(fA[3], n1, qs[1]); SB0();
          LDK2(fA, 2, 3, 0); SB0(); MMK2(fB, 0, 1); SB0();
          fB[0] = LDF(aqkl, 32 + r, LDC, 32 + 8 * hl); fB[1] = LDF(aqkl, 32 + r, LDC, 48 + 8 * hl); fB[2] = LDF(ketl, r, LDC, 32 + 8 * hl); fB[3] = LDF(ketl, r, LDC, 48 + 8 * hl); SB0();
          MMK2(fA, 2, 3); SB0();
          n0 = pack_step<0>(vn[1]); n1 = pack_step<1>(vn[1]);
          LDK2(fA, 1, 2, 1); SB0(); qs[1] = MFMA32(fB[0], n0, qs[1]); qs[1] = MFMA32(fB[1], n1, qs[1]); S[0] = MFMA32(fB[2], n0, S[0]); S[0] = MFMA32(fB[3], n1, S[0]); SB0();
          fB[0] = LDF(ketl, 96 + r, LDC, 32 + 8 * hl); fB[1] = LDF(ketl, 96 + r, LDC, 48 + 8 * hl); SB0(); MMK2(fA, 1, 2); SB0();
          S[3] = MFMA32(fB[0], n0, S[3]); S[3] = MFMA32(fB[1], n1, S[3]); }
#undef LDW
#undef MMW
#undef LDK2
#undef MMK2
        LBAR();
        stage_out(ob, qs, v, hl);
        LBAR();
    }
    const int r = lane_ & 31, hl = lane_ >> 5, v = 32 * vs + r;
    float* so = C.out + O_PGDN + ((((size_t)l * 8 + b) * 4 + h) * 128) * 128 + v;
#pragma unroll
    for (int kt = 0; kt < 4; ++kt)
#pragma unroll
        for (int i = 0; i < 16; ++i) if (st) so[(size_t)(32 * kt + crow(i, hl)) * 128] = S[kt][i];
}
__device__ __forceinline__ void ssd_load_gates(const bf16* ys, int lt, v4u& g0, v4u& g1) { const bf16* yp = ys + (size_t)(lt >> 2) * 512 + (lt & 3) * 16; g0 = *(const GAS v4u*)yp; g1 = *(const GAS v4u*)(yp + 8); }
__device__ __forceinline__ void ssd_finish_rows(const LAS bf16* ob, bf16* ys, float* ssq, int lt, bool st, const v4u g0, const v4u g1) {
    const int t = lt >> 2, cb = (lt & 3) * 16; bf16* yp = ys + (size_t)t * 512 + cb; float x[16], ss = 0.f;
    const v4u w0 = *(const LAS v4u*)(ob + t * LDK + cb), w1 = *(const LAS v4u*)(ob + t * LDK + cb + 8);
#pragma unroll
    for (int e = 0; e < 4; ++e) { x[2 * e] = blo(w0[e]) * blo(g0[e]); x[2 * e + 1] = bhi(w0[e]) * bhi(g0[e]); x[8 + 2 * e] = blo(w1[e]) * blo(g1[e]); x[8 + 2 * e + 1] = bhi(w1[e]) * bhi(g1[e]); }
#pragma unroll
    for (int j = 0; j < 16; ++j) ss += x[j] * x[j];
    ss += SWZ_XOR(ss, 1); ss += SWZ_XOR(ss, 2);
    v4u o0, o1;
#pragma unroll
    for (int e = 0; e < 4; ++e) { o0[e] = pkbf(x[2 * e], x[2 * e + 1]); o1[e] = pkbf(x[8 + 2 * e], x[8 + 2 * e + 1]); }
    if (st) { *(GAS v4u*)yp = o0; *(GAS v4u*)(yp + 8) = o1; if ((lt & 3) == 0) ssq[(size_t)t * 8] = ss; }
}
__device__ __forceinline__ void ssd_scan(const Ctx& C_, int l, int b, int hd, bool st) {
    Ctx C = C_; asm volatile("v_mbcnt_lo_u32_b32 %0, -1, 0\n\tv_mbcnt_hi_u32_b32 %0, -1, %0" : "=v"(C.lane)); C.tid = C.wave * 64 + C.lane;
    LAS unsigned char* lds = lds_v(C); LAS bf16* ob = (LAS bf16*)(lds + OB_OFF);
    const int g = hd >> 2, hh = hd & 3;
    const unsigned char* sbase = C.ws + SCR_SSD + (size_t)((b * NCH) * 2 + g) * SSD_UNIT;
    bf16* YS1 = (bf16*)(C.ws + WS_YS) + (size_t)T_ALL * 512 + g * 256;
    float* SSQ = (float*)(C.ws + WS_SSQ);
    LBAR();
    if (C.wave >= 4) {
        int lt = C.tid - 256; v4u srA[12], srB[12], eA = {0u, 0u, 0u, 0u}, eB = {0u, 0u, 0u, 0u};
        LAS float* ecl = (LAS float*)(lds + DEC_OFF);
        const float* ecg = (const float*)(C.ws + WS_SMALL + SM_ECUM) + (size_t)((b * NCH) * 8 + hd) * 64;
#define SSD_LOAD(sr, ereg, c) do { const unsigned char* cb = sbase + (size_t)(c) * 2 * SSD_UNIT; _Pragma("unroll") for (int j = 0; j < 12; ++j) { const int idx = j * 256 + lt; \
            sr[j] = *(const GAS v4u*)(cb + (j < 4 ? idx * 16 : 16384 + hh * 32768 + (idx - 1024) * 16)); } \
            if (lt < 16) ereg = *(const GAS v4u*)(ecg + (size_t)(c) * 512 + lt * 4); } while (0)
#define SSD_WRITE(sr, ereg, buf) do { LAS unsigned char* B = lds + (buf) * SB_STRIDE; _Pragma("unroll") for (int j = 0; j < 12; ++j) { const int idx = j * 256 + lt; \
            if (j < 4) { *(LAS v4u*)(B + (idx >> 4) * 272 + (idx & 15) * 16) = sr[j]; } \
            else if (j < 6) { const int q = idx - 1024; *(LAS v4u*)(B + 17408 + (q >> 3) * 144 + (q & 7) * 16) = sr[j]; } \
            else if (j < 10) { const int q = idx - 1536; *(LAS v4u*)(B + 26624 + (q >> 3) * 144 + (q & 7) * 16) = sr[j]; } \
            else { const int q = idx - 2560; *(LAS v4u*)(B + 45056 + (q >> 3) * 144 + (q & 7) * 16) = sr[j]; } } \
            if (lt < 16) *(LAS v4u*)(ecl + (buf) * 64 + lt * 4) = ereg; } while (0)
        SSD_LOAD(srA, eA, 0); SSD_WRITE(srA, eA, 0); SSD_LOAD(srB, eB, 1); SSD_LOAD(srA, eA, 2);
        v4u g0, g1; ssd_load_gates(YS1 + (size_t)(b * SEQ) * 512 + hh * 64, lt, g0, g1);
        LBAR();
#pragma unroll 1
        for (int c = 0; c < NCH; c += 2) { asm volatile("" : "+v"(lt));
            if (c > 0) { const int t0 = b * SEQ + (c - 1) * CH; ssd_finish_rows(ob, YS1 + (size_t)t0 * 512 + hh * 64, SSQ + (size_t)t0 * 8 + hd, lt, st, g0, g1); ssd_load_gates(YS1 + (size_t)(t0 + CH) * 512 + hh * 64, lt, g0, g1); }
            SSD_WRITE(srB, eB, 1); if (c + 3 < NCH) SSD_LOAD(srB, eB, c + 3);
            LBAR(); LBAR();
            { const int t0 = b * SEQ + c * CH; ssd_finish_rows(ob, YS1 + (size_t)t0 * 512 + hh * 64, SSQ + (size_t)t0 * 8 + hd, lt, st, g0, g1); ssd_load_gates(YS1 + (size_t)(t0 + CH) * 512 + hh * 64, lt, g0, g1); }
            if (c + 2 < NCH) { SSD_WRITE(srA, eA, 0); if (c + 4 < NCH) SSD_LOAD(srA, eA, c + 4); }
            LBAR(); LBAR(); }
        { const int t0 = b * SEQ + (NCH - 1) * CH; ssd_finish_rows(ob, YS1 + (size_t)t0 * 512 + hh * 64, SSQ + (size_t)t0 * 8 + hd, lt, st, g0, g1); }
#undef SSD_LOAD
#undef SSD_WRITE
        return;
    }
    if (C.wave >= 2) {
        LBAR();
#pragma unroll 1
        for (int c = 0; c < NCH; ++c) { LBAR(); LBAR(); }
        return;
    }
    const int ps = C.wave & 1; int lane_ = C.lane;
    f32x16 Sn[4] = {zero16(), zero16(), zero16(), zero16()};
    const float* gel = (const float*)(C.ws + WS_SMALL + SM_ELAST) + (b * NCH) * 8 + hd; float eln = gel[0];
    LBAR();
#pragma unroll 1
    for (int c = 0; c < NCH; ++c) {
        asm volatile("" : "+v"(lane_)); const int r = lane_ & 31, hl = lane_ >> 5, p = 32 * ps + r;
        LAS unsigned char* B = lds + (c & 1) * SB_STRIDE;
        const LAS bf16* cl = (const LAS bf16*)B; const LAS bf16* ml = (const LAS bf16*)(B + 17408); const LAS bf16* bwl = (const LAS bf16*)(B + 26624); const LAS bf16* xtl = (const LAS bf16*)(B + 45056);
        const LAS float* ecl = (const LAS float*)(lds + DEC_OFF) + (c & 1) * 64; const float elast = eln; eln = gel[(c + 1 < NCH ? c + 1 : c) * 8];
        f32x16 y[2] = {zero16(), zero16()};
#define LDW(f, T, kt) do { f[0] = LDF(T, r, LDK, 32 * (kt) + 8 * hl); f[1] = LDF(T, r, LDK, 32 * (kt) + 16 + 8 * hl); f[2] = LDF(T, 32 + r, LDK, 32 * (kt) + 8 * hl); f[3] = LDF(T, 32 + r, LDK, 32 * (kt) + 16 + 8 * hl); } while (0)
#define MMW(f, acc) do { acc[0] = MFMA32(f[0], b0, acc[0]); acc[0] = MFMA32(f[1], b1, acc[0]); acc[1] = MFMA32(f[2], b0, acc[1]); acc[1] = MFMA32(f[3], b1, acc[1]); } while (0)
        bf16x8 fA[4], fB[4], bx[4]; f32x4 ec[8];
        LDW(fA, cl, 0);
#pragma unroll
        for (int ks = 0; ks < 4; ++ks) bx[ks] = LDF(xtl, p, LDC, 16 * ks + 8 * hl);
#pragma unroll
        for (int q = 0; q < 8; ++q) ec[q] = *(const LAS f32x4*)(ecl + 32 * (q >> 2) + 8 * (q & 3) + 4 * hl);
        SB0();
        { bf16x8 b0 = pack_step<0>(Sn[0]), b1 = pack_step<1>(Sn[0]);
          LDW(fB, cl, 1); SB0(); MMW(fA, y); SB0();
          b0 = pack_step<0>(Sn[1]); b1 = pack_step<1>(Sn[1]);
          LDW(fA, cl, 2); SB0(); MMW(fB, y); SB0();
          b0 = pack_step<0>(Sn[2]); b1 = pack_step<1>(Sn[2]);
          LDW(fB, cl, 3); SB0(); MMW(fA, y); SB0();
          b0 = pack_step<0>(Sn[3]); b1 = pack_step<1>(Sn[3]);
          LDA2(fA, ml, 0, 1); SB0(); MMW(fB, y); SB0(); }
#pragma unroll
        for (int q = 0; q < 8; ++q) { y[q >> 2][4 * (q & 3)] *= ec[q][0]; y[q >> 2][4 * (q & 3) + 1] *= ec[q][1]; y[q >> 2][4 * (q & 3) + 2] *= ec[q][2]; y[q >> 2][4 * (q & 3) + 3] *= ec[q][3]; }
        SB0();
        LDA2(fB, ml, 2, 3); SB0(); MMA2(fA, bx, 0, 1, y); SB0();
#pragma unroll
        for (int nt = 0; nt < 4; ++nt) Sn[nt] = Sn[nt] * elast;
        LDR4(fA, bwl, 0); SB0(); MMA2(fB, bx, 2, 3, y); SB0();
        LDR4(fB, bwl, 32); SB0(); MMR4(fA, bx, Sn[0]); SB0();
        LDR4(fA, bwl, 64); SB0(); MMR4(fB, bx, Sn[1]); SB0();
        LDR4(fB, bwl, 96); SB0(); MMR4(fA, bx, Sn[2]); SB0();
        MMR4(fB, bx, Sn[3]); SB0();
#undef LDW
#undef MMW
#undef LDA2
#undef MMA2
#undef LDR4
#undef MMR4
        LBAR();
        stage_out(ob, y, p, hl);
        LBAR();
    }
    const int r = lane_ & 31, hl = lane_ >> 5, p = 32 * ps + r;
    float* so = C.out + O_PSSD + ((((size_t)l * 8 + b) * 8 + hd) * 64 + p) * 128;
#pragma unroll
    for (int nt = 0; nt < 4; ++nt)
#pragma unroll
        for (int i = 0; i < 16; ++i) if (st) so[32 * nt + crow(i, hl)] = Sn[nt][i];
}
struct TailStore { bf16* O; int ldc; bool sig, gates;
    __device__ __forceinline__ void operator()(int row, int col, const float (&v)[4]) const { float x[4];
        if (gates) col = col >= 2048 ? col - 1024 : ((col & 128) ? 2048 : 0) + (col >> 8) * 128 + (col & 127);
#pragma unroll
        for (int e = 0; e < 4; ++e) x[e] = sig ? fmaxf(sigmoid_f(v[e]), 1e-30f) : v[e];
        v2u w; w.x = pkbf(x[0], x[1]); w.y = pkbf(x[2], x[3]); *(GAS v2u*)(O + (size_t)row * ldc + col) = w; } };
struct TailBranch { const bf16* G; int goff; bf16* O; const float* ssq; int grp; bool first;
    __device__ __forceinline__ void operator()(int row, int col, const float (&v)[4]) const {
        float rsc = 1.f; if (ssq) { const f32x4 q4 = *(const GAS f32x4*)(ssq + (size_t)row * 8 + grp * 4); rsc = rsqrtf(((q4[0] + q4[1]) + (q4[2] + q4[3])) * (1.f / 256.f) + EPS); }
        const v2u g = *(const GAS v2u*)(G + (size_t)row * NG + goff + col); bf16* op = O + (size_t)row * DM + col; float x[4] = {v[0] * blo(g.x) * rsc, v[1] * bhi(g.x) * rsc, v[2] * blo(g.y) * rsc, v[3] * bhi(g.y) * rsc};
        if (!first) { const v2u o = __builtin_nontemporal_load((const v2u*)op);
            x[0] += blo(o.x); x[1] += bhi(o.x); x[2] += blo(o.y); x[3] += bhi(o.y); }
        v2u w; w.x = pkbf(x[0], x[1]); w.y = pkbf(x[2], x[3]); *(GAS v2u*)op = w; } };
template <int K, int LD = K, class Epi> __device__ __forceinline__ void tail_gemm(const Ctx& C_, const bf16* A  , const bf16* Bt  , int N, const Epi& E) {
    Ctx C = C_; asm volatile("v_mbcnt_lo_u32_b32 %0, -1, 0\n\tv_mbcnt_hi_u32_b32 %0, -1, %0" : "=v"(C.lane)); C.tid = C.wave * 64 + C.lane;
    LAS float* red = (LAS float*)lds_v(C);
    constexpr int kw = K >> 3, nst = kw >> 4; const int r = C.lane & 31, hl = C.lane >> 5, nitems = 8 * (N >> 5);
    for (int it = C.vcu; it < nitems; it += C.G) {
        const int rb = it & 7, cb = it >> 3;
        const bf16* ap0 = A + (size_t)(rb * 64 + r) * LD + C.wave * kw + 8 * hl; const bf16* ap1 = ap0 + (size_t)32 * LD; const bf16* bp = Bt + (size_t)(cb * 32 + r) * LD + C.wave * kw + 8 * hl;
        f32x16 acc0 = zero16(), acc1 = zero16();
#pragma unroll
        for (int k0 = 0; k0 < nst; k0 += 8) { constexpr int NB8 = 8; bf16x8 fa0[NB8], fa1[NB8], fbb[NB8];
#pragma unroll
            for (int j = 0; j < NB8; ++j) if (k0 + j < nst) { fa0[j] = ldg8(ap0 + 16 * (k0 + j)); fa1[j] = ldg8(ap1 + 16 * (k0 + j)); fbb[j] = ldg8(bp + 16 * (k0 + j)); }
            __builtin_amdgcn_sched_barrier(0);
#pragma unroll
            for (int j = 0; j < NB8; ++j) if (k0 + j < nst) { acc0 = MFMA32(fa0[j], fbb[j], acc0); acc1 = MFMA32(fa1[j], fbb[j], acc1); }
            __builtin_amdgcn_sched_barrier(0); }
        LBAR();
#pragma unroll
        for (int i = 0; i < 16; ++i) { red[((C.wave * 2 + 0) * 16 + i) * 64 + C.lane] = acc0[i]; red[((C.wave * 2 + 1) * 16 + i) * 64 + C.lane] = acc1[i]; }
        LBAR();
        { const int row = C.tid >> 3, c4 = (C.tid & 7) * 4, tt = row >> 5, rr = row & 31, hs = (rr >> 2) & 1, i = (rr & 3) + 4 * (rr >> 3); float v[4] = {0.f, 0.f, 0.f, 0.f};
#pragma unroll
          for (int w = 0; w < 8; ++w) { const f32x4 x = *(const LAS f32x4*)(red + ((w * 2 + tt) * 16 + i) * 64 + 32 * hs + c4); v[0] += x[0]; v[1] += x[1]; v[2] += x[2]; v[3] += x[3]; }
          E(T_P + rb * 64 + row, cb * 32 + c4, v); }
    }
    LBAR();
}
__device__ __forceinline__ void tail_branch_chain(const Ctx& C_, const bf16* YSb, const bf16* Wb, const bf16* G, const float* ssq, bf16* O) {
    Ctx C = C_; asm volatile("v_mbcnt_lo_u32_b32 %0, -1, 0\n\tv_mbcnt_hi_u32_b32 %0, -1, %0" : "=v"(C.lane)); C.tid = C.wave * 64 + C.lane;
    LAS float* red = (LAS float*)lds_v(C);
    const int r = C.lane & 31, hl = C.lane >> 5;
    for (int it = C.vcu; it < 256; it += C.G) {
        const int rb = it & 7, cb = it >> 3;
        const bf16* a0 = YSb + (size_t)(T_P + rb * 64 + r) * 512 + 8 * hl; const bf16* b0 = Wb + (size_t)(cb * 32 + r) * 512 + 8 * hl;
        const int row = C.tid >> 3, c4 = (C.tid & 7) * 4, tt = row >> 5, rr = row & 31, hs = (rr >> 2) & 1, ii = (rr & 3) + 4 * (rr >> 3); const size_t grow = (size_t)(T_P + rb * 64 + row); const int col = cb * 32 + c4;
        bf16x8 fa[8], fb[4], ga[8], gb[4];
#define TBC_LD(A, B, ap, bp, kw, n) do { _Pragma("unroll") for (int j = 0; j < (n); ++j) { A[j] = ldg8((ap) + C.wave * (kw) + 16 * j); A[4 + j] = ldg8((ap) + (size_t)32 * 512 + C.wave * (kw) + 16 * j); B[j] = ldg8((bp) + C.wave * (kw) + 16 * j); } } while (0)
#define TBC_MM(A, B, n) do { acc0 = zero16(); acc1 = zero16(); _Pragma("unroll") for (int j = 0; j < (n); ++j) { acc0 = MFMA32(A[j], B[j], acc0); acc1 = MFMA32(A[4 + j], B[j], acc1); } } while (0)
#define TBC_RED(v) do { LBAR(); _Pragma("unroll") for (int i = 0; i < 16; ++i) { red[((C.wave * 2 + 0) * 16 + i) * 64 + C.lane] = acc0[i]; red[((C.wave * 2 + 1) * 16 + i) * 64 + C.lane] = acc1[i]; } LBAR(); \
            v[0] = 0.f; v[1] = 0.f; v[2] = 0.f; v[3] = 0.f; _Pragma("unroll") for (int w = 0; w < 8; ++w) { const f32x4 x = *(const LAS f32x4*)(red + ((w * 2 + tt) * 16 + ii) * 64 + 32 * hs + c4); v[0] += x[0]; v[1] += x[1]; v[2] += x[2]; v[3] += x[3]; } } while (0)
        TBC_LD(fa, fb, a0, b0, 64, 4);
        const v2u g_gla = *(const GAS v2u*)(G + grow * NG + col), g_ssd = *(const GAS v2u*)(G + grow * NG + 1024 + col), g_gdn = *(const GAS v2u*)(G + grow * NG + 2048 + col);
        const f32x4 qa = *(const GAS f32x4*)(ssq + grow * 8), qb = *(const GAS f32x4*)(ssq + grow * 8 + 4);
        __builtin_amdgcn_sched_barrier(0);
        f32x16 acc0, acc1; float v[4], tot[4];
        TBC_LD(ga, gb, a0 + (size_t)2 * T_ALL * 512, b0 + (size_t)DM * 512, 64, 4); __builtin_amdgcn_sched_barrier(0);
        TBC_MM(fa, fb, 4); TBC_RED(v);
        tot[0] = v[0] * blo(g_gla.x); tot[1] = v[1] * bhi(g_gla.x); tot[2] = v[2] * blo(g_gla.y); tot[3] = v[3] * bhi(g_gla.y);
        __builtin_amdgcn_sched_barrier(0);
        TBC_LD(fa, fb, a0 + (size_t)T_ALL * 512, b0 + (size_t)2 * DM * 512, 32, 2); __builtin_amdgcn_sched_barrier(0);
        TBC_MM(ga, gb, 4); TBC_RED(v);
        tot[0] += v[0] * blo(g_gdn.x); tot[1] += v[1] * bhi(g_gdn.x); tot[2] += v[2] * blo(g_gdn.y); tot[3] += v[3] * bhi(g_gdn.y);
        __builtin_amdgcn_sched_barrier(0);
        TBC_LD(ga, gb, a0 + (size_t)T_ALL * 512 + 256, b0 + (size_t)2 * DM * 512 + 256, 32, 2); __builtin_amdgcn_sched_barrier(0);
        const float rs0 = rsqrtf(((qa[0] + qa[1]) + (qa[2] + qa[3])) * (1.f / 256.f) + EPS), rs1 = rsqrtf(((qb[0] + qb[1]) + (qb[2] + qb[3])) * (1.f / 256.f) + EPS);
        TBC_MM(fa, fb, 2); TBC_RED(v);
        tot[0] += v[0] * (blo(g_ssd.x) * rs0); tot[1] += v[1] * (bhi(g_ssd.x) * rs0); tot[2] += v[2] * (blo(g_ssd.y) * rs0); tot[3] += v[3] * (bhi(g_ssd.y) * rs0);
        __builtin_amdgcn_sched_barrier(0);
        TBC_MM(ga, gb, 2); TBC_RED(v);
        tot[0] += v[0] * (blo(g_ssd.x) * rs1); tot[1] += v[1] * (bhi(g_ssd.x) * rs1); tot[2] += v[2] * (blo(g_ssd.y) * rs1); tot[3] += v[3] * (bhi(g_ssd.y) * rs1);
        v2u w; w.x = pkbf(tot[0], tot[1]); w.y = pkbf(tot[2], tot[3]); *(GAS v2u*)(O + grow * DM + col) = w;
#undef TBC_LD
#undef TBC_MM
#undef TBC_RED
    }
    LBAR();
}
constexpr size_t MOD_S_OFF = SCR_GDN;
__device__ __forceinline__ void mod_prepare(const Ctx& C) {
    bf16* Shi = (bf16*)(C.ws + MOD_S_OFF); bf16* Slo = Shi + 160 * 1024;
    for (int idx = C.vcu * NTHR + C.tid; idx < 160 * 1024; idx += C.G * NTHR) { const int bi = idx >> 10, k = idx & 1023; float v = 0.f;
        if (bi < NBC) v = silu_f(bi < 8 ? C.in[I_CP][bi * DM + k] : C.in[I_CS][(bi - 8) * DM + k]);
        const unsigned p = pkbf(v, 0.f); Shi[idx] = (bf16)(p & 0xffffu); Slo[idx] = f2b(v - blo(p)); }
}
__device__ __forceinline__ void mod_mfma(const Ctx& C_) {
    Ctx C = C_; asm volatile("v_mbcnt_lo_u32_b32 %0, -1, 0\n\tv_mbcnt_hi_u32_b32 %0, -1, %0" : "=v"(C.lane)); C.tid = C.wave * 64 + C.lane;
    const bf16* Shi = (const bf16*)(C.ws + MOD_S_OFF); const bf16* Slo = Shi + 160 * 1024; float* mod = (float*)(C.ws + WS_MOD);
    LAS float* red = (LAS float*)lds_v(C);
    const int r = C.lane & 31, hl = C.lane >> 5, kb = C.wave * 128 + 8 * hl;
    for (int item = C.vcu; item < 320; item += C.G) {
        const int l = item < 128 ? 0 : 1, nt = item < 128 ? 64 + item : item - 128;
        const float* W = C.in[I_WADA] + (size_t)l * DM * 6144 + 32 * nt + r;
        bf16x8 bh[8], bl[8];
#pragma unroll
        for (int half = 0; half < 2; ++half) { float wv[4][8];
#pragma unroll
          for (int ks = 0; ks < 4; ++ks)
#pragma unroll
              for (int j = 0; j < 8; ++j) wv[ks][j] = W[(size_t)(kb + 16 * (4 * half + ks) + j) * 6144];
#pragma unroll
          for (int ks = 0; ks < 4; ++ks) { v4u ph, pl;
#pragma unroll
              for (int q = 0; q < 4; ++q) { ph[q] = pkbf(wv[ks][2 * q], wv[ks][2 * q + 1]); pl[q] = pkbf(wv[ks][2 * q] - blo(ph[q]), wv[ks][2 * q + 1] - bhi(ph[q])); }
              bh[4 * half + ks] = __builtin_bit_cast(bf16x8, ph); bl[4 * half + ks] = __builtin_bit_cast(bf16x8, pl); }
          __builtin_amdgcn_sched_barrier(0); }
        const unsigned soff = (unsigned)(r * 1024 + kb) * 2u;
#pragma unroll 1
        for (int t = 0; t < 5; ++t) { bf16x8 ah[8], al[8]; const char* sh = (const char*)Shi + (size_t)t * 65536 + soff; const char* sl = (const char*)Slo + (size_t)t * 65536 + soff;
#pragma unroll
            for (int ks = 0; ks < 8; ++ks) { ah[ks] = *(const GAS bf16x8*)(sh + 32 * ks); al[ks] = *(const GAS bf16x8*)(sl + 32 * ks); }
            f32x16 acc = zero16();
#pragma unroll
            for (int ks = 0; ks < 8; ++ks) { acc = MFMA32(ah[ks], bh[ks], acc); acc = MFMA32(al[ks], bh[ks], acc); acc = MFMA32(ah[ks], bl[ks], acc); }
            LBAR();
#pragma unroll
            for (int i = 0; i < 16; ++i) red[(C.wave * 16 + i) * 64 + C.lane] = acc[i];
            LBAR();
#pragma unroll
            for (int h2 = 0; h2 < 2; ++h2) { const int e = C.tid + 512 * h2, i = e >> 6, ln = e & 63, bi = 32 * t + crow(i, ln >> 5), n = 32 * nt + (ln & 31); float s = 0.f;
#pragma unroll
                for (int w = 0; w < 8; ++w) s += red[(w * 16 + i) * 64 + ln];
                if (bi < NBC) mod[((size_t)l * NBC + bi) * 6144 + n] = s + C.in[I_BADA][l * 6144 + n]; } }
    }
    LBAR();
}
constexpr size_t WS_RSD = WS_SSQ + MiB;
__device__ __forceinline__ void rstd_table(const Ctx& C) {
    const float* ssq = (const float*)(C.ws + WS_SSQ); float* rsd = (float*)(C.ws + WS_RSD);
    for (int row = C.vcu * NTHR + C.tid; row < T_P; row += C.G * NTHR) { const f32x4 qa = *(const GAS f32x4*)(ssq + (size_t)row * 8), qb = *(const GAS f32x4*)(ssq + (size_t)row * 8 + 4);
        f32x2 o; o[0] = rsqrtf(((qa[0] + qa[1]) + (qa[2] + qa[3])) * (1.f / 256.f) + EPS); o[1] = rsqrtf(((qb[0] + qb[1]) + (qb[2] + qb[3])) * (1.f / 256.f) + EPS); *(GAS f32x2*)(rsd + (size_t)row * 2) = o; }
}
__device__ __forceinline__ void mixer_precompute(const Ctx& C, int l, bool dry) {
    const bf16* U = (const bf16*)(C.ws + WS_U);
    for (int idx = C.vcu * NTHR + C.tid; idx < 8 * 3 * 2560; idx += C.G * NTHR) { const int bj = idx / 2560, ch = idx % 2560, b = bj / 3, j = bj % 3; const size_t row = (size_t)(b * SEQ + SEQ - 3 + j) * NU;
        if (ch < 1024) C.out[O_PCS + ((size_t)(l * 8 + b) * 3 + j) * 1024 + ch] = bf2f(U[row + C_SXBC + ch]);
        else C.out[O_PCD + ((size_t)(l * 8 + b) * 3 + j) * 1536 + (ch - 1024)] = bf2f(U[row + C_DQKV + (ch - 1024)]); }
    for (int u = C.vcu; u < 2560; u += C.G) {
        const bool st = !dry || C.G == 77777;
        if (u < 1024) { if (!dry || (PROBE_PRE & 1)) m1_gdn(C, l, u >> 7, (u >> 2) & 31, u & 3); }
        else if (u < 2048) { if (!dry || (PROBE_PRE & 4)) { const int q = u - 1024; m1_gla(C, l, q >> 7, (q >> 2) & 31, q & 3, st); } }
        else { if (!dry || (PROBE_PRE & 2)) { const int q = u - 2048; m1_ssd(C, l, q >> 6, (q >> 1) & 31, q & 1); } }
    }
}
__device__ __forceinline__ void mixer_scan_and_sample(const Ctx& C, int l, bool dry) {
    const int bx = blockIdx.x;
    const bool st = !dry || C.G == 77777;
    if (!dry || PROBE_SCAN != 2) {
    if (bx < 32) gdn_scan(C, l, bx >> 2, bx & 3, st);
    else if (bx < 64) gla_scan(C, l, (bx - 32) >> 2, bx & 3, st);
    else if (bx < 128) ssd_scan(C, l, (bx - 64) >> 3, bx & 7, st); }
    if (dry && PROBE_SCAN == 3) return;
    unsigned* ctr = (unsigned*)(C.ws + WS_CTL) + 8192 + (l * 2 + (dry ? 1 : 0)) * 64;
    volatile LAS unsigned* slot = (volatile LAS unsigned*)(C.lds + MISC_OFF) + 16;
    LBAR();
    if (C.tid == 0) slot[0] = __hip_atomic_fetch_add(ctr, 1u, __ATOMIC_RELAXED, __HIP_MEMORY_SCOPE_AGENT);
    LBAR();
    unsigned u = slot[0];
    while (u < 1280u) {
        unsigned nxt = 0; if (C.tid == 0) nxt = __hip_atomic_fetch_add(ctr, 1u, __ATOMIC_RELAXED, __HIP_MEMORY_SCOPE_AGENT);
        if (u < 512u) sample_gdn(C, l, (int)u >> 2, (int)u & 3);
        else if (u < 1024u) sample_gla(C, l, (int)(u - 512u) >> 2, (int)u & 3);
        else sample_ssd(C, l, (int)(u - 1024u) >> 1, (int)u & 1);
        LBAR();
        if (C.tid == 0) slot[0] = nxt;
        LBAR();
        u = slot[0];
    }
}

constexpr int N_PHASES = 22;
__global__ void __launch_bounds__(NTHR, 2) mega_fwd(Args args) {
    extern __shared__ __attribute__((aligned(16))) unsigned char lds_raw[];
    Ctx C;
    C.lds = (LAS unsigned char*)lds_raw;
    C.tid = threadIdx.x; C.lane = C.tid & 63; C.wave = __builtin_amdgcn_readfirstlane(C.tid >> 6);
    C.G = gridDim.x; { const int bx = blockIdx.x; C.vcu = (C.G % 8 == 0) ? (bx % 8) * (C.G / 8) + bx / 8 : bx; }
    C.in = args.in; C.out = args.out; C.ws = args.ws;
    volatile LAS unsigned* MISC = (volatile LAS unsigned*)(C.lds + MISC_OFF);
    for (int u = C.tid; u < (LDS_BYTES - LDSCTL_OFF) / 4; u += NTHR) ((LAS unsigned*)(C.lds + LDSCTL_OFF))[u] = 0u;
    __syncthreads();
    int lo = args.ph_lo, hi = args.ph_hi, zoff = 0;
    const bool single = (hi - lo) > 1;
    XcdBarrier bar; bar.bar = (unsigned*)(C.ws + WS_CTL) + CW_BAR; bar.x = 0; bar.st = nullptr;
    if (single) bar = xcd_barrier_post((unsigned*)(C.ws + WS_CTL) + CW_BAR, MISC + 8, C.tid == 0);
#define IN(k) (lo <= (k) && (k) < hi)
#define SEAM(k) do { asm volatile("v_mbcnt_lo_u32_b32 %0, -1, 0\n\tv_mbcnt_hi_u32_b32 %0, -1, %0" : "=v"(C.lane)); C.tid = C.wave * 64 + C.lane;     asm volatile("" : "+s"(C.vcu), "+s"(C.wave), "+s"(lo), "+s"(hi)); asm volatile("" : "+s"(zoff)); C.in = args.in + zoff; C.ws = args.ws + zoff; C.out = args.out + zoff; if (IN(k) && IN((k) + 1)) { if ((k) == 0 && C.G == 77777) cg::this_grid().sync();   xcd_barrier(bar, C.tid == 0); } } while (0)
#define wb (C.ws + WS_W)
#define H ((bf16*)(C.ws + WS_H))
#define YS ((bf16*)(C.ws + WS_YS))
#define U ((bf16*)(C.ws + WS_U))
#define Gt ((bf16*)(C.ws + WS_G))
#define MERGED ((bf16*)(C.ws + WS_MERGED))
#define MIX ((bf16*)(C.ws + WS_MIX))
#define HID ((bf16*)(C.ws + WS_HID))
#define Fo ((bf16*)(C.ws + WS_F))

    if (IN(0)) _Pragma("unroll 1") for (int rep = 0; rep < 1 + PROBE_PRO; ++rep) { mod_prepare(C); compute_mod(C); convert_weights(C, 0, true); } SEAM(0);
    if (IN(1)) { mod_mfma(C); phase_prenorm0(C); } SEAM(1);
    { constexpr int l = 0;
        const int pb = 2 + 10 * l;
        if (IN(pb + 0)) _Pragma("unroll 1") for (int rep = 0; rep < 1 + ((PROBE_GEMM & 1) != 0); ++rep) {
            pg8::Gemm g{H, (const bf16*)(wb + W_IN), T_ALL, NU, DM, 0, 0}; pg8::StaticOrder S; S.init(T_ALL, NU, C.G, (int)blockIdx.x);
            pg8::EpiStore<0> E{U, NU}; pg8::gemm_phase<pg8::EpiStore<0>, pg8::StaticOrder, true, true>(C.lds, g, S, E, C.wave); }
        SEAM(pb + 0);
        if (IN(pb + 1)) _Pragma("unroll 1") for (int rep = (PROBE_PRE != 0); rep >= 0; --rep) { mixer_precompute(C, l, rep != 0); }
        SEAM(pb + 1);
        if (IN(pb + 2)) _Pragma("unroll 1") for (int rep = (PROBE_SCAN != 0); rep >= 0; --rep) { mixer_scan_and_sample(C, l, rep != 0); }
        SEAM(pb + 2);
        if (IN(pb + 3)) _Pragma("unroll 1") for (int rep = 0; rep < 1 + ((PROBE_GEMM & 2) != 0); ++rep) {
            const unsigned char* a8 = (const unsigned char*)C.out + 2048; const unsigned char* b8 = (const unsigned char*)C.out + 3072; asm volatile("" : "+s"(a8)); asm volatile("" : "+s"(b8));
            pg8::Gemm g{(const bf16*)a8, (const bf16*)b8, T_P, NG, 512, 0, 0, 2048}; pg8::StaticOrder S; S.init(T_P, NG, C.G, (int)blockIdx.x);
            pg8::EpiGates E{Gt, NG, 1.f / 32.f}; pg8::gemm_phase<pg8::EpiGates, pg8::StaticOrder, true, true, false, true>(C.lds, g, S, E, C.wave);
            if (rep == 0) { TailStore TE{Gt, NG, true, true}; tail_gemm<DM>(C, H + (size_t)T_P * DM, (const bf16*)(wb + W_G), NG, TE); rstd_table(C); convert_f2_fp8(C, l); } }
        SEAM(pb + 3);
        if (IN(pb + 4)) _Pragma("unroll 1") for (int rep = 0; rep < 1 + ((PROBE_GEMM & 4) != 0); ++rep) {
            { pg8::Gemm g{YS, (const bf16*)(wb + W_B), T_P, DM, 512, 0, 0, 512}; pg8::Chain4Order S; S.init(T_P, DM, C.G, (int)blockIdx.x);
              pg8::EpiChain E{Gt, NG, MERGED, DM, (const float*)(C.ws + WS_RSD), (long)2 * T_ALL * 512, (long)T_ALL * 512, (long)DM * 512, (long)2 * DM * 512};
              pg8::gemm_phase<pg8::EpiChain, pg8::Chain4Order, true, true>(C.lds, g, S, E, C.wave); }
            if (rep == 0) tail_branch_chain(C, YS, (const bf16*)(wb + W_B), Gt, (const float*)(C.ws + WS_SSQ), MERGED); }
        SEAM(pb + 4);
        if (IN(pb + 5)) _Pragma("unroll 1") for (int rep = 0; rep < 1 + ((PROBE_GEMM & 8) != 0); ++rep) {
            pg8::Gemm g{MERGED, (const bf16*)(wb + W_O), T_P, DM, DM, 0, 0}; pg8::StaticOrder S; S.init(T_P, DM, C.G, (int)blockIdx.x);
            pg8::EpiStore<0> E{MIX, DM}; pg8::gemm_phase<pg8::EpiStore<0>, pg8::StaticOrder, true, true>(C.lds, g, S, E, C.wave);
            if (rep == 0) { TailStore TE{MIX, DM, false, false}; tail_gemm<DM>(C, MERGED + (size_t)T_P * DM, (const bf16*)(wb + W_O), DM, TE); } }
        SEAM(pb + 5);
        if (IN(pb + 6)) _Pragma("unroll 1") for (int rep = PROBE_ROWS; rep >= 0; --rep) { phase_rows(C, MIX, l, 2, C.in[I_GPOSTM] + l * DM, true, C.in[I_GPREF] + l * DM, l, 4, 3, rep == 0 || C.G == 77777, l == 0); }
        SEAM(pb + 6);
        if (IN(pb + 7)) _Pragma("unroll 1") for (int rep = 0; rep < 1 + ((PROBE_GEMM & 16) != 0); ++rep) {
            pg8::Gemm g{H, (const bf16*)(wb + W_F1), T_ALL, NF1, DM, 0, 0}; pg8::StaticOrder S; S.init(T_ALL, NF1, C.G, (int)blockIdx.x);
            pg8::EpiSwiGLU E{C.ws + WS_HID, (bf16*)(C.ws + WS_HIDS), FH, 8.f}; pg8::gemm_phase<pg8::EpiSwiGLU, pg8::StaticOrder, true, true>(C.lds, g, S, E, C.wave); }
        SEAM(pb + 7);
        if (IN(pb + 8)) _Pragma("unroll 1") for (int rep = 0; rep < 1 + ((PROBE_GEMM & 32) != 0); ++rep) {
            pg8::Gemm g{(const bf16*)(C.ws + WS_HID), (const bf16*)(C.ws + WS_F2Q), T_P, DM, FH / 2, 0, 0}; pg8::StaticOrder S; S.init(T_P, DM, C.G, (int)blockIdx.x);
            pg8::EpiStore<0, true> E{Fo, DM, 1.f / 256.f}; pg8::gemm_phase<pg8::EpiStore<0, true>, pg8::StaticOrder, true, true, false, true>(C.lds, g, S, E, C.wave);
            if (rep == 0) { TailStore TE{Fo, DM, false, false}; tail_gemm<FH>(C, (const bf16*)(C.ws + WS_HIDS), (const bf16*)(wb + W_F2), DM, TE); } }
        SEAM(pb + 8);
        if (IN(pb + 9)) { phase_rows(C, Fo, l, 5, C.in[I_GPOSTF] + l * DM, l == 0, C.in[I_GPREM] + DM, 1, 1, 0, true, false, l == 1, l == 0); if (l == 0) convert_weights(C, 1); }
        if (l == 0) SEAM(pb + 9);
        }
    { constexpr int l = 1;
        const int pb = 2 + 10 * l;
        if (IN(pb + 0)) _Pragma("unroll 1") for (int rep = 0; rep < 1 + ((PROBE_GEMM & 1) != 0); ++rep) {
            pg8::Gemm g{H, (const bf16*)(wb + W_IN), T_ALL, NU, DM, 0, 0}; pg8::StaticOrder S; S.init(T_ALL, NU, C.G, (int)blockIdx.x);
            pg8::EpiStore<0> E{U, NU}; pg8::gemm_phase<pg8::EpiStore<0>, pg8::StaticOrder, true, true>(C.lds, g, S, E, C.wave); }
        SEAM(pb + 0);
        if (IN(pb + 1)) _Pragma("unroll 1") for (int rep = (PROBE_PRE != 0); rep >= 0; --rep) { mixer_precompute(C, l, rep != 0); }
        SEAM(pb + 1);
        if (IN(pb + 2)) _Pragma("unroll 1") for (int rep = (PROBE_SCAN != 0); rep >= 0; --rep) { mixer_scan_and_sample(C, l, rep != 0); }
        SEAM(pb + 2);
        if (IN(pb + 3)) _Pragma("unroll 1") for (int rep = 0; rep < 1 + ((PROBE_GEMM & 2) != 0); ++rep) {
            const unsigned char* a8 = (const unsigned char*)C.out + 2048; const unsigned char* b8 = (const unsigned char*)C.out + 3072; asm volatile("" : "+s"(a8)); asm volatile("" : "+s"(b8));
            pg8::Gemm g{(const bf16*)a8, (const bf16*)b8, T_P, NG, 512, 0, 0, 2048}; pg8::StaticOrder S; S.init(T_P, NG, C.G, (int)blockIdx.x);
            pg8::EpiGates E{Gt, NG, 1.f / 32.f}; pg8::gemm_phase<pg8::EpiGates, pg8::StaticOrder, true, true, false, true>(C.lds, g, S, E, C.wave);
            if (rep == 0) { TailStore TE{Gt, NG, true, true}; tail_gemm<DM>(C, H + (size_t)T_P * DM, (const bf16*)(wb + W_G), NG, TE); rstd_table(C); convert_f2_fp8(C, l); } }
        SEAM(pb + 3);
        if (IN(pb + 4)) _Pragma("unroll 1") for (int rep = 0; rep < 1 + ((PROBE_GEMM & 4) != 0); ++rep) {
            { pg8::Gemm g{YS, (const bf16*)(wb + W_B), T_P, DM, 512, 0, 0, 512}; pg8::Chain4Order S; S.init(T_P, DM, C.G, (int)blockIdx.x);
              pg8::EpiChain E{Gt, NG, MERGED, DM, (const float*)(C.ws + WS_RSD), (long)2 * T_ALL * 512, (long)T_ALL * 512, (long)DM * 512, (long)2 * DM * 512};
              pg8::gemm_phase<pg8::EpiChain, pg8::Chain4Order, true, true>(C.lds, g, S, E, C.wave); }
            if (rep == 0) tail_branch_chain(C, YS, (const bf16*)(wb + W_B), Gt, (const float*)(C.ws + WS_SSQ), MERGED); }
        SEAM(pb + 4);
        if (IN(pb + 5)) _Pragma("unroll 1") for (int rep = 0; rep < 1 + ((PROBE_GEMM & 8) != 0); ++rep) {
            pg8::Gemm g{MERGED, (const bf16*)(wb + W_O), T_P, DM, DM, 0, 0}; pg8::StaticOrder S; S.init(T_P, DM, C.G, (int)blockIdx.x);
            pg8::EpiStore<0> E{MIX, DM}; pg8::gemm_phase<pg8::EpiStore<0>, pg8::StaticOrder, true, true>(C.lds, g, S, E, C.wave);
            if (rep == 0) { TailStore TE{MIX, DM, false, false}; tail_gemm<DM>(C, MERGED + (size_t)T_P * DM, (const bf16*)(wb + W_O), DM, TE); } }
        SEAM(pb + 5);
        if (IN(pb + 6)) _Pragma("unroll 1") for (int rep = PROBE_ROWS; rep >= 0; --rep) { phase_rows(C, MIX, l, 2, C.in[I_GPOSTM] + l * DM, true, C.in[I_GPREF] + l * DM, l, 4, 3, rep == 0 || C.G == 77777, l == 0); }
        SEAM(pb + 6);
        if (IN(pb + 7)) _Pragma("unroll 1") for (int rep = 0; rep < 1 + ((PROBE_GEMM & 16) != 0); ++rep) {
            pg8::Gemm g{H, (const bf16*)(wb + W_F1), T_ALL, NF1, DM, 0, 0}; pg8::StaticOrder S; S.init(T_ALL, NF1, C.G, (int)blockIdx.x);
            pg8::EpiSwiGLU E{C.ws + WS_HID, (bf16*)(C.ws + WS_HIDS), FH, 8.f}; pg8::gemm_phase<pg8::EpiSwiGLU, pg8::StaticOrder, true, true>(C.lds, g, S, E, C.wave); }
        SEAM(pb + 7);
        if (IN(pb + 8)) _Pragma("unroll 1") for (int rep = 0; rep < 1 + ((PROBE_GEMM & 32) != 0); ++rep) {
            pg8::Gemm g{(const bf16*)(C.ws + WS_HID), (const bf16*)(C.ws + WS_F2Q), T_P, DM, FH / 2, 0, 0}; pg8::StaticOrder S; S.init(T_P, DM, C.G, (int)blockIdx.x);
            pg8::EpiStore<0, true> E{Fo, DM, 1.f / 256.f}; pg8::gemm_phase<pg8::EpiStore<0, true>, pg8::StaticOrder, true, true, false, true>(C.lds, g, S, E, C.wave);
            if (rep == 0) { TailStore TE{Fo, DM, false, false}; tail_gemm<FH>(C, (const bf16*)(C.ws + WS_HIDS), (const bf16*)(wb + W_F2), DM, TE); } }
        SEAM(pb + 8);
        if (IN(pb + 9)) { phase_rows(C, Fo, l, 5, C.in[I_GPOSTF] + l * DM, l == 0, C.in[I_GPREM] + DM, 1, 1, 0, true, false, l == 1, l == 0); if (l == 0) convert_weights(C, 1); }
        if (l == 0) SEAM(pb + 9);
        }
#undef IN
#undef SEAM
#undef wb
#undef H
#undef YS
#undef U
#undef Gt
#undef MERGED
#undef MIX
#undef HID
#undef Fo
}

extern "C" void kernel_launch(void* const* d_in, const int* in_sizes, int n_in, void* d_out, int out_size, void* d_ws, size_t ws_size, hipStream_t stream) {
    static int grid = 0;
    if (grid == 0) {
        if (n_in != 33 || (size_t)out_size != O_END || ws_size < WS_END) { fprintf(stderr, "kernel_launch: unexpected shapes: n_in %d out %d ws %zu (need %zu)\n", n_in, out_size, ws_size, (size_t)WS_END); grid = -1; return; }
        int dev = 0, cus = 0, per_cu = 0;
        if (hipGetDevice(&dev) != hipSuccess || hipDeviceGetAttribute(&cus, hipDeviceAttributeMultiprocessorCount, dev) != hipSuccess) { grid = -1; return; }
        if (hipFuncSetAttribute((const void*)mega_fwd, hipFuncAttributeMaxDynamicSharedMemorySize, LDS_BYTES) != hipSuccess) { fprintf(stderr, "kernel_launch: hipFuncSetAttribute failed\n"); grid = -1; return; }
        if (hipOccupancyMaxActiveBlocksPerMultiprocessor(&per_cu, (const void*)mega_fwd, NTHR, LDS_BYTES) != hipSuccess || per_cu < 1) { fprintf(stderr, "kernel_launch: occupancy query says %d\n", per_cu); per_cu = 1; }
        (void)hipGetLastError();
        grid = cus;
    }
    if (grid < 0) return;
    (void)hipMemsetAsync((char*)d_ws + WS_CTL, 0, CTL_ZERO_BYTES, stream);
    Args a{};
    for (int i = 0; i < 33; ++i) a.in[i] = (const float*)d_in[i];
    a.out = (float*)d_out; a.ws = (unsigned char*)d_ws;
#if MK_MULTI
    for (int p = 0; p < N_PHASES; ++p) { a.ph_lo = p; a.ph_hi = p + 1; hipLaunchKernelGGL(mega_fwd, dim3(grid), dim3(NTHR), LDS_BYTES, stream, a); }
#else
    a.ph_lo = 0; a.ph_hi = N_PHASES;
    void* kargs[] = {&a};
    hipError_t e = hipLaunchCooperativeKernel((const void*)mega_fwd, dim3(grid), dim3(NTHR), kargs, LDS_BYTES, stream);
    if (e != hipSuccess) fprintf(stderr, "kernel_launch: cooperative launch failed: %s (grid %d)\n", hipGetErrorString(e), grid);
#endif
}
```
